# Optimizing an MI355X kernel written in HIP

```python
import jax
import jax.numpy as jnp
from jax import lax
import numpy as np


D_MODEL = 2048
BATCH = 8
SEQ = 2048
DEPTH = 2

NSA_HEADS = 16
NSA_KV_GROUPS = 4
HEADS_PER_GROUP = NSA_HEADS // NSA_KV_GROUPS
HEAD_DIM = 128
NSA_WIDTH = NSA_HEADS * HEAD_DIM
KV_WIDTH = NSA_KV_GROUPS * HEAD_DIM
CMP_LEN = 32
CMP_STRIDE = 16
SLC_LEN = 64
SLC_TOP_N = 16
SLC_LOCAL = 2
FORCE_BONUS = 1e4
WINDOW = 512
WIN_Q_BLOCK = 128
SLC_Q_BLOCK = 32

LRU_WIDTH = 2048
LRU_BLOCKS = 16
LRU_BLOCK_DIM = LRU_WIDTH // LRU_BLOCKS
LRU_C = 8.0
LRU_CONV = 4

D_FF = 3 * D_MODEL
FFN_CONV = 3

IN_WIDTH = NSA_WIDTH + 6 * KV_WIDTH + 3 * NSA_HEADS + 2 * LRU_WIDTH + 2 * D_MODEL
NORM_EPS = 1e-6

kernel_name = "nsa_rglru_gated_hybrid_block"


def rmsnorm(x, g):
    x32 = x.astype(jnp.float32)
    inv = lax.rsqrt(jnp.mean(x32 * x32, axis=-1, keepdims=True) + NORM_EPS)
    return (x32 * inv).astype(x.dtype) * g


def causal_dwconv(x, w, b):
    k = w.shape[0]
    t = x.shape[1]
    xp = jnp.pad(x, ((0, 0), (k - 1, 0), (0, 0)))
    out = b
    for j in range(k):
        out = out + xp[:, j:j + t] * w[j]
    return out


def masked_softmax(s, mask):
    s = jnp.where(mask, s.astype(jnp.float32), -jnp.inf)
    m = jnp.max(s, axis=-1, keepdims=True)
    m = jnp.where(jnp.isfinite(m), m, 0.0)
    p = jnp.exp(s - m)
    return p / jnp.maximum(jnp.sum(p, axis=-1, keepdims=True), 1e-30)


def _split_points():
    sizes = (NSA_WIDTH,) + (KV_WIDTH,) * 6 + (3 * NSA_HEADS, LRU_WIDTH, LRU_WIDTH, D_MODEL, D_MODEL)
    return [int(v) for v in np.cumsum(sizes)[:-1]]


def compress_blocks(kv, pos, w1, w2):
    t = kv.shape[1]
    n_cmp = (t - CMP_LEN) // CMP_STRIDE + 1
    idx = jnp.arange(n_cmp)[:, None] * CMP_STRIDE + jnp.arange(CMP_LEN)[None, :]
    blocks = kv[:, idx] + pos[None, None, :, None, :]
    hid = jax.nn.gelu(jnp.einsum('bnlgd,lde->bnge', blocks, w1))
    return jnp.einsum('bnge,ef->bngf', hid, w2)


def selected_attention(q, k, v, sel):
    bn, t, g, hg, hd = q.shape
    n_slc = t // SLC_LEN
    n_top = sel.shape[-1]
    nc = t // SLC_Q_BLOCK
    kb = k.reshape(bn, n_slc, SLC_LEN, g, hd).transpose(0, 3, 1, 2, 4)
    vb = v.reshape(bn, n_slc, SLC_LEN, g, hd).transpose(0, 3, 1, 2, 4)
    b_ix = jnp.arange(bn)[:, None, None, None]
    g_ix = jnp.arange(g)[None, :, None, None]
    off = jnp.arange(SLC_LEN)
    m_tok = n_top * SLC_LEN

    def chunk(args):
        q_c, sel_c, start = args
        k_g = kb[b_ix, g_ix, sel_c].reshape(bn, g, SLC_Q_BLOCK, m_tok, hd)
        v_g = vb[b_ix, g_ix, sel_c].reshape(bn, g, SLC_Q_BLOCK, m_tok, hd)
        key_pos = (sel_c[..., None] * SLC_LEN + off).reshape(bn, g, SLC_Q_BLOCK, m_tok)
        q_pos = start + jnp.arange(SLC_Q_BLOCK)
        mask = key_pos <= q_pos[None, None, :, None]
        s = jnp.einsum('bqghd,bgqmd->bghqm', q_c, k_g)
        p = masked_softmax(s, mask[:, :, None])
        return jnp.einsum('bghqm,bgqmd->bqghd', p.astype(v_g.dtype), v_g)

    q_chunks = jnp.moveaxis(q.reshape(bn, nc, SLC_Q_BLOCK, g, hg, hd), 1, 0)
    sel_chunks = jnp.moveaxis(sel.reshape(bn, g, nc, SLC_Q_BLOCK, n_top), 2, 0)
    starts = jnp.arange(nc) * SLC_Q_BLOCK
    out = lax.map(chunk, (q_chunks, sel_chunks, starts))
    return jnp.moveaxis(out, 0, 1).reshape(bn, t, g, hg, hd)


def window_attention(q, k, v):
    bn, t, g, hg, hd = q.shape
    nb = t // WIN_Q_BLOCK
    n_prev = WINDOW // WIN_Q_BLOCK

    def band(z):
        zp = jnp.pad(z, ((0, 0), (WINDOW, 0), (0, 0), (0, 0)))
        zb = zp.reshape(bn, nb + n_prev, WIN_Q_BLOCK, g, hd)
        return jnp.concatenate([zb[:, j:j + nb] for j in range(n_prev + 1)], axis=2)

    kb, vb = band(k), band(v)
    qb = q.reshape(bn, nb, WIN_Q_BLOCK, g, hg, hd)
    q_pos = jnp.arange(t).reshape(nb, WIN_Q_BLOCK)
    k_pos = q_pos[:, :1] - WINDOW + jnp.arange((n_prev + 1) * WIN_Q_BLOCK)[None, :]
    diff = q_pos[:, :, None] - k_pos[:, None, :]
    mask = (diff >= 0) & (diff < WINDOW) & (k_pos[:, None, :] >= 0)
    s = jnp.einsum('bnqghd,bnmgd->bnghqm', qb, kb)
    p = masked_softmax(s, mask[None, :, None, None])
    o = jnp.einsum('bnghqm,bnmgd->bnqghd', p.astype(vb.dtype), vb)
    return o.reshape(bn, t, g, hg, hd)


def nsa_attention(q, kc, vc, ks, vs, kw, vw, gates, pos_k, w1_k, w2_k, pos_v, w1_v, w2_v):
    bn, t, _ = q.shape
    g, hg, hd = NSA_KV_GROUPS, HEADS_PER_GROUP, HEAD_DIM
    q = q.reshape(bn, t, g, hg, hd) * (hd ** -0.5)
    kc, vc = kc.reshape(bn, t, g, hd), vc.reshape(bn, t, g, hd)
    ks, vs = ks.reshape(bn, t, g, hd), vs.reshape(bn, t, g, hd)
    kw, vw = kw.reshape(bn, t, g, hd), vw.reshape(bn, t, g, hd)
    t_pos = jnp.arange(t)

    k_cmp = compress_blocks(kc, pos_k, w1_k, w2_k)
    v_cmp = compress_blocks(vc, pos_v, w1_v, w2_v)
    n_cmp = k_cmp.shape[1]
    cmp_start = jnp.arange(n_cmp) * CMP_STRIDE
    cmp_mask = (cmp_start + CMP_LEN - 1)[None, :] <= t_pos[:, None]
    s_cmp = jnp.einsum('btghd,bngd->bghtn', q, k_cmp)
    p_cmp = masked_softmax(s_cmp, cmp_mask)
    o_cmp = jnp.einsum('bghtn,bngd->btghd', p_cmp.astype(v_cmp.dtype), v_cmp)

    n_slc = t // SLC_LEN
    slc_start = jnp.arange(n_slc) * SLC_LEN
    overlap = ((cmp_start[:, None] < slc_start[None, :] + SLC_LEN)
               & (cmp_start[:, None] + CMP_LEN > slc_start[None, :])).astype(jnp.float32)
    imp = jnp.einsum('bghtn,nj->bgtj', p_cmp, overlap)
    blk = jnp.arange(n_slc)[None, :]
    cur = (t_pos // SLC_LEN)[:, None]
    valid = blk <= cur
    forced = (blk == 0) | (valid & (blk > cur - SLC_LOCAL))
    score = jnp.where(forced, imp + FORCE_BONUS, jnp.where(valid, imp, -1.0))
    n_top = min(SLC_TOP_N, n_slc)
    _, sel = lax.top_k(score, n_top)
    o_slc = selected_attention(q, ks, vs, sel)

    o_win = window_attention(q, kw, vw)

    gt = jax.nn.sigmoid(gates.reshape(bn, t, g, hg, 3))
    o = gt[..., 0:1] * o_cmp + gt[..., 1:2] * o_slc + gt[..., 2:3] * o_win
    return o.reshape(bn, t, NSA_WIDTH)


def rg_lru(x, w_a, b_a, w_i, b_i, lam):
    bn, t, w = x.shape
    xb = x.reshape(bn, t, LRU_BLOCKS, LRU_BLOCK_DIM)
    r = jax.nn.sigmoid(jnp.einsum('btnd,nde->btne', xb, w_a).reshape(bn, t, w) + b_a)
    i = jax.nn.sigmoid(jnp.einsum('btnd,nde->btne', xb, w_i).reshape(bn, t, w) + b_i)
    log_a = (LRU_C * r.astype(jnp.float32)) * jax.nn.log_sigmoid(lam.astype(jnp.float32))
    a = jnp.exp(log_a)
    b = jnp.sqrt(-jnp.expm1(2.0 * log_a)) * (i * x).astype(jnp.float32)

    def combine(left, right):
        a1, b1 = left
        a2, b2 = right
        return a1 * a2, a2 * b1 + b2

    _, h = lax.associative_scan(combine, (a, b), axis=1)
    return h.astype(x.dtype)


def token_mixer(h, w_in, pos_k, w1_k, w2_k, pos_v, w1_v, w2_v, conv_w, conv_b,
                w_a, b_a, w_i, b_i, lam, proj_a, proj_b, w_out):
    z = h @ w_in
    q, kc, vc, ks, vs, kw, vw, g_nsa, lx, ly, ga, gb = jnp.split(z, _split_points(), axis=-1)
    o_a = nsa_attention(q, kc, vc, ks, vs, kw, vw, g_nsa, pos_k, w1_k, w2_k, pos_v, w1_v, w2_v)
    u = causal_dwconv(lx, conv_w, conv_b)
    o_b = jax.nn.gelu(ly) * rg_lru(u, w_a, b_a, w_i, b_i, lam)
    merged = jax.nn.sigmoid(ga) * (o_a @ proj_a) + jax.nn.sigmoid(gb) * (o_b @ proj_b)
    return merged @ w_out


def conv_glu_ffn(h, w_up, conv_w, conv_b, w_down):
    gate, val = jnp.split(h @ w_up, 2, axis=-1)
    gate = causal_dwconv(gate, conv_w, conv_b)
    return (jax.nn.gelu(gate) * val) @ w_down


def setup_inputs(seed: int = 0) -> dict:
    key = jax.random.key(seed)
    ks = iter(jax.random.split(key, 40))

    def nrm(shape, fan_in, scale=1.0):
        return jax.random.normal(next(ks), shape, jnp.float32) * (scale * fan_in ** -0.5)

    def small(shape, s=0.02):
        return jax.random.normal(next(ks), shape, jnp.float32) * s

    x = jax.random.normal(next(ks), (BATCH, SEQ, D_MODEL), jnp.float32)
    c = jax.random.normal(next(ks), (BATCH, D_MODEL), jnp.float32)
    ada_w = nrm((DEPTH, D_MODEL, 6 * D_MODEL), D_MODEL, 0.5)
    ada_b = small((DEPTH, 6 * D_MODEL))
    norm1_g = 1.0 + small((DEPTH, D_MODEL))
    w_in = nrm((DEPTH, D_MODEL, IN_WIDTH), D_MODEL)
    cmp_pos_k = small((DEPTH, CMP_LEN, HEAD_DIM), 0.1)
    cmp_w1_k = nrm((DEPTH, CMP_LEN, HEAD_DIM, HEAD_DIM), CMP_LEN * HEAD_DIM)
    cmp_w2_k = nrm((DEPTH, HEAD_DIM, HEAD_DIM), HEAD_DIM)
    cmp_pos_v = small((DEPTH, CMP_LEN, HEAD_DIM), 0.1)
    cmp_w1_v = nrm((DEPTH, CMP_LEN, HEAD_DIM, HEAD_DIM), CMP_LEN * HEAD_DIM)
    cmp_w2_v = nrm((DEPTH, HEAD_DIM, HEAD_DIM), HEAD_DIM)
    lru_conv_w = nrm((DEPTH, LRU_CONV, LRU_WIDTH), LRU_CONV)
    lru_conv_b = small((DEPTH, LRU_WIDTH))
    lru_wa = nrm((DEPTH, LRU_BLOCKS, LRU_BLOCK_DIM, LRU_BLOCK_DIM), LRU_BLOCK_DIM)
    lru_ba = small((DEPTH, LRU_WIDTH))
    lru_wi = nrm((DEPTH, LRU_BLOCKS, LRU_BLOCK_DIM, LRU_BLOCK_DIM), LRU_BLOCK_DIM)
    lru_bi = small((DEPTH, LRU_WIDTH))
    u = jax.random.uniform(next(ks), (DEPTH, LRU_WIDTH), jnp.float32)
    rad = jnp.sqrt(u * (0.999 ** 2 - 0.9 ** 2) + 0.9 ** 2)
    lru_lambda = jnp.log(rad) - jnp.log1p(-rad)
    proj_a = nrm((DEPTH, NSA_WIDTH, D_MODEL), NSA_WIDTH)
    proj_b = nrm((DEPTH, LRU_WIDTH, D_MODEL), LRU_WIDTH)
    w_out = nrm((DEPTH, D_MODEL, D_MODEL), D_MODEL)
    norm2_g = 1.0 + small((DEPTH, D_MODEL))
    ffn_up = nrm((DEPTH, D_MODEL, 2 * D_FF), D_MODEL)
    ffn_conv_w = nrm((DEPTH, FFN_CONV, D_FF), FFN_CONV)
    ffn_conv_b = small((DEPTH, D_FF))
    ffn_down = nrm((DEPTH, D_FF, D_MODEL), D_FF)
    final_g = 1.0 + small((D_MODEL,))
    return {"x": x, "c": c, "ada_w": ada_w, "ada_b": ada_b, "norm1_g": norm1_g, "w_in": w_in,
            "cmp_pos_k": cmp_pos_k, "cmp_w1_k": cmp_w1_k, "cmp_w2_k": cmp_w2_k,
            "cmp_pos_v": cmp_pos_v, "cmp_w1_v": cmp_w1_v, "cmp_w2_v": cmp_w2_v,
            "lru_conv_w": lru_conv_w, "lru_conv_b": lru_conv_b, "lru_wa": lru_wa, "lru_ba": lru_ba,
            "lru_wi": lru_wi, "lru_bi": lru_bi, "lru_lambda": lru_lambda,
            "proj_a": proj_a, "proj_b": proj_b, "w_out": w_out, "norm2_g": norm2_g,
            "ffn_up": ffn_up, "ffn_conv_w": ffn_conv_w, "ffn_conv_b": ffn_conv_b, "ffn_down": ffn_down,
            "final_g": final_g}


def reference(x, c, ada_w, ada_b, norm1_g, w_in, cmp_pos_k, cmp_w1_k, cmp_w2_k, cmp_pos_v, cmp_w1_v,
              cmp_w2_v, lru_conv_w, lru_conv_b, lru_wa, lru_ba, lru_wi, lru_bi, lru_lambda, proj_a, proj_b,
              w_out, norm2_g, ffn_up, ffn_conv_w, ffn_conv_b, ffn_down, final_g):
    c_act = jax.nn.silu(c)
    for l in range(DEPTH):
        mod = (c_act @ ada_w[l] + ada_b[l])[:, None, :]
        sh1, sc1, g1, sh2, sc2, g2 = jnp.split(mod, 6, axis=-1)
        h = rmsnorm(x, norm1_g[l]) * (1.0 + sc1) + sh1
        y = token_mixer(h, w_in[l], cmp_pos_k[l], cmp_w1_k[l], cmp_w2_k[l], cmp_pos_v[l], cmp_w1_v[l],
                        cmp_w2_v[l], lru_conv_w[l], lru_conv_b[l], lru_wa[l], lru_ba[l], lru_wi[l],
                        lru_bi[l], lru_lambda[l], proj_a[l], proj_b[l], w_out[l])
        x = x + g1 * y
        h = rmsnorm(x, norm2_g[l]) * (1.0 + sc2) + sh2
        x = x + g2 * conv_glu_ffn(h, ffn_up[l], ffn_conv_w[l], ffn_conv_b[l], ffn_down[l])
    return rmsnorm(x, final_g)
```

```cpp
#include <hip/hip_runtime.h>
#include <hip/hip_cooperative_groups.h>
#include <cstdio>
#include <cstdint>
namespace cg = cooperative_groups;

#ifndef MK_COOP
#define MK_COOP 1
#endif

#define DEV __device__ __forceinline__
#define LAS __attribute__((address_space(3)))
typedef unsigned short bf16_t;
typedef short bf16x8 __attribute__((ext_vector_type(8)));
typedef float f32x4 __attribute__((ext_vector_type(4)));
typedef unsigned u32x4 __attribute__((ext_vector_type(4)));
typedef unsigned u32x2 __attribute__((ext_vector_type(2)));

constexpr int NB = 8, T = 2048, D = 2048, M = NB * T, DEPTH = 2;
constexpr int NIN = 13568;
constexpr int DFF = 6144;
constexpr int NPHASE = 1 + 10 * DEPTH + 1;
constexpr int LDS_BYTES = 147456;

DEV int win_src(int n) { return n < 5120 ? n : (n < 13312 ? n + 48 : (n < 13360 ? n - 13312 + 5120 : -1)); }

constexpr size_t SZ_WIN = (size_t)NIN * 2048 * 2, SZ_WUP = (size_t)12288 * 2048 * 2, SZ_WDN = (size_t)2048 * 6144 * 2, SZ_WSQ = (size_t)2048 * 2048 * 2;
constexpr size_t SZ_W1 = (size_t)128 * 4096 * 2, SZ_W2 = 128 * 128 * 2, SZ_LRUW = 16 * 128 * 128 * 2, SZ_MOD = 8 * 12288 * 4;
constexpr size_t L_WIN = 0, L_WUP = L_WIN + SZ_WIN, L_WDN = L_WUP + SZ_WUP, L_PA = L_WDN + SZ_WDN, L_PB = L_PA + SZ_WSQ, L_WO = L_PB + SZ_WSQ,
                 L_W1K = L_WO + SZ_WSQ, L_W1V = L_W1K + SZ_W1, L_W2K = L_W1V + SZ_W1, L_W2V = L_W2K + SZ_W2, L_WA = L_W2V + SZ_W2, L_WI = L_WA + SZ_LRUW,
                 L_MOD = L_WI + SZ_LRUW, LAYER_BYTES = L_MOD + SZ_MOD;
constexpr size_t SZ_ACT = (size_t)M * 2048 * 2;
constexpr size_t SZ_KV = (size_t)M * 512 * 2;
constexpr size_t WS_HBUF = DEPTH * LAYER_BYTES;
constexpr size_t WS_Z = WS_HBUF + SZ_ACT;
constexpr size_t Z_Q = WS_Z, Z_KC = Z_Q + SZ_ACT, Z_VC = Z_KC + SZ_KV, Z_KS = Z_VC + SZ_KV, Z_VST = Z_KS + SZ_KV, Z_KW = Z_VST + SZ_KV, Z_VWT = Z_KW + SZ_KV,
                 Z_LX = Z_VWT + SZ_KV, Z_LY = Z_LX + SZ_ACT, Z_GA = Z_LY + SZ_ACT, Z_GB = Z_GA + SZ_ACT, Z_GATE = Z_GB + SZ_ACT,
                 Z_KCMP = Z_GATE + (size_t)M * 64 * 2, Z_VCMPT = Z_KCMP + (size_t)32 * 128 * 128 * 2, Z_END = Z_VCMPT + (size_t)32 * 128 * 128 * 2;
constexpr size_t F_G = WS_Z, F_V = WS_Z + (size_t)M * DFF * 2;
static_assert(F_V + (size_t)M * DFF * 2 <= Z_KCMP, "ffn overlay");
constexpr size_t WS_NEED = Z_END;

struct Params { const float* in[28]; float* out; unsigned char* ws; int ph_lo, ph_hi; };

DEV float bflo(unsigned u) { return __builtin_bit_cast(float, u << 16); }
DEV float bfhi(unsigned u) { return __builtin_bit_cast(float, u & 0xffff0000u); }
DEV unsigned cvt_pk_bf16(float lo, float hi) { unsigned r; asm volatile("v_cvt_pk_bf16_f32 %0, %1, %2" : "=v"(r) : "v"(lo), "v"(hi)); return r; }
DEV float sigm(float x) { return 1.f / (1.f + __expf(-x)); }
DEV float gelu_t(float x) { const float u = 1.5957691216057308f * (x + 0.044715f * x * x * x); return x / (1.f + __expf(-u)); }
DEV float shx(float v, int m, int lane) { return __builtin_bit_cast(float, __builtin_amdgcn_ds_bpermute((lane ^ m) << 2, __builtin_bit_cast(int, v))); }
DEV unsigned shxu(unsigned v, int m, int lane) { return (unsigned)__builtin_amdgcn_ds_bpermute((lane ^ m) << 2, (int)v); }
DEV float wave_sum(float v, int lane) {
#pragma unroll
    for (int o = 1; o < 64; o <<= 1) v += shx(v, o, lane);
    return v;
}
DEV int otid() { int t = threadIdx.x; asm volatile("" : "+v"(t)); return t; }
DEV int obid() { int b = blockIdx.x; asm volatile("" : "+s"(b)); return b; }
DEV f32x4 mfma16(bf16x8 a, bf16x8 b, f32x4 c) { return __builtin_amdgcn_mfma_f32_16x16x32_bf16(a, b, c, 0, 0, 0); }
DEV bf16x8 as_bf16x8(u32x4 v) { return __builtin_bit_cast(bf16x8, v); }

namespace pg8 {
constexpr int BM = 256, BK = 64, HALF = 128, HTB = HALF * BK * 2, NXCD = 8, WGM = 8;
DEV int lds_byte(int r, int c) { const int st = (r >> 4) * 2 + (c >> 5), rr = r & 15, cc = c & 31, ob = rr * 64 + cc * 2; return st * 1024 + (ob ^ (((ob >> 9) & 1) << 5)); }
DEV void stage_rc(int b, int& R, int& C) { const int st = b / 1024, sb = b % 1024, swz = sb ^ (((sb >> 9) & 1) << 5); R = (st >> 1) * 16 + swz / 64; C = (st & 1) * 32 + (swz % 64) / 2; }
DEV int perm32(int rho) { const int n = rho >> 4, i = rho & 15; return 8 * (i >> 2) + 4 * n + (i & 3); }
struct Unit { int pm, pn; };
struct Gemm { const bf16_t* A; const bf16_t* Bt; int M, N, K, lda; };
struct StaticOrder {
    int nM, nN, nwg, G, c;
    DEV void init(int M_, int N_, int G_, int c_) { nM = M_ / BM; nN = N_ / BM; nwg = nM * nN; G = G_; c = c_; }
    DEV bool next(int i, Unit& u) const {
        const long L = (long)i * G + c; if (L >= nwg) return false;
        int wgid = (int)L; { const int q = nwg / NXCD, r = nwg % NXCD, xcd = wgid % NXCD, off = wgid / NXCD; wgid = (xcd < r ? xcd * (q + 1) : r * (q + 1) + (xcd - r) * q) + off; }
        const int nig = WGM * nN, gid = wgid / nig, fm = gid * WGM, gsz = (nM - fm) < WGM ? (nM - fm) : WGM;
        u.pm = fm + ((wgid % nig) % gsz); u.pn = (wgid % nig) / gsz; return true;
    }
};
template <class Epi>
DEV void gemm_phase(LAS unsigned char* lds, const Gemm g, const StaticOrder& S, const Epi& E) {
    const int tid = otid(), wid = __builtin_amdgcn_readfirstlane(tid >> 6), lane = tid & 63, wr = wid >> 2, wc = wid & 3, fr = lane & 15, fq = lane >> 4;
    const int K = g.K, nt = K / BK, lda = g.lda;
    unsigned voffA[2], voffB[2];
#pragma unroll
    for (int i = 0; i < 2; ++i) { int R, C; stage_rc(tid * 16 + i * 8192, R, C); const int Rb = (R & ~31) + perm32(R & 31);
        voffA[i] = (unsigned)(R * lda + C) * 2u; voffB[i] = (unsigned)(Rb * K + C) * 2u; }
    const size_t kstep = (size_t)(BK * 2);
    const size_t hstepA = (size_t)HALF * lda * 2, tstepA = 2 * hstepA;
    const size_t hstepB = (size_t)HALF * K * 2, tstepB = 2 * hstepB;
    const unsigned ldsw = (unsigned)wid * 1024u;
    const int aoff = lds_byte(wr * 64 + fr, fq * 8), boff = lds_byte(wc * 32 + fr, fq * 8);
#define PG8_SA(b, h) (((b) * 2 + (h)) * HTB)
#define PG8_SB(b, h) ((4 + (b) * 2 + (h)) * HTB)
#define PG8_STAGE(bufoff, gbase, voff) do { _Pragma("unroll") for (int _i = 0; _i < 2; ++_i) \
        __builtin_amdgcn_global_load_lds((const unsigned*)((const char*)(gbase) + (voff)[_i]), (LAS unsigned*)(lds + (bufoff) + ldsw + _i * 8192), 16, 0, 0); } while (0)
#define PG8_LDA(dst, b, h) do { _Pragma("unroll") for (int m = 0; m < 4; ++m) _Pragma("unroll") for (int k = 0; k < 2; ++k) dst[m][k] = *(const LAS bf16x8*)(lds + PG8_SA(b, h) + aoff + m * 2048 + k * 1024); } while (0)
#define PG8_LDB(dst, b, h) do { _Pragma("unroll") for (int n = 0; n < 2; ++n) _Pragma("unroll") for (int k = 0; k < 2; ++k) dst[n][k] = *(const LAS bf16x8*)(lds + PG8_SB(b, h) + boff + n * 2048 + k * 1024); } while (0)
#define PG8_MMA(ai, bj, At, Bt) do { __builtin_amdgcn_s_setprio(1); _Pragma("unroll") for (int m = 0; m < 4; ++m) _Pragma("unroll") for (int n = 0; n < 2; ++n) _Pragma("unroll") for (int k = 0; k < 2; ++k) \
        acc[ai][bj][m][n] = __builtin_amdgcn_mfma_f32_16x16x32_bf16(Bt[n][k], At[m][k], acc[ai][bj][m][n], 0, 0, 0); __builtin_amdgcn_s_setprio(0); } while (0)
#define PG8_WAIT_V(n) asm volatile("s_waitcnt vmcnt(" #n ")" ::: "memory")
#define PG8_WAIT_L(n) asm volatile("s_waitcnt lgkmcnt(" #n ")" ::: "memory")
#define PG8_BAR __builtin_amdgcn_s_barrier()
#define PG8_SCHED __builtin_amdgcn_sched_barrier(0)
    Unit cur, nxt; int ui = 0;
    if (!S.next(0, cur)) return;
    f32x4 acc[2][2][4][2];
#pragma unroll
    for (int a = 0; a < 2; ++a)
#pragma unroll
        for (int b = 0; b < 2; ++b)
#pragma unroll
            for (int m = 0; m < 4; ++m)
#pragma unroll
                for (int n = 0; n < 2; ++n) acc[a][b][m][n] = (f32x4){0.f, 0.f, 0.f, 0.f};
    bf16x8 At[4][2], B0[2][2], B1[2][2];
    const char* cA = (const char*)g.A + (size_t)cur.pm * tstepA; const char* cB = (const char*)g.Bt + (size_t)cur.pn * tstepB;
    PG8_STAGE(PG8_SB(0, 0), cB, voffB); PG8_STAGE(PG8_SB(0, 1), cB + hstepB, voffB); PG8_STAGE(PG8_SA(0, 0), cA, voffA); PG8_STAGE(PG8_SA(0, 1), cA + hstepA, voffA);
    if (wr == 1) PG8_BAR;
    PG8_WAIT_V(2); PG8_BAR;
    PG8_STAGE(PG8_SB(1, 0), cB + kstep, voffB); PG8_STAGE(PG8_SA(1, 0), cA + kstep, voffA); PG8_STAGE(PG8_SB(1, 1), cB + hstepB + kstep, voffB);
    PG8_WAIT_V(6); PG8_BAR;
    for (;;) {
        const bool has_next = S.next(ui + 1, nxt);
        const char* nA = has_next ? (const char*)g.A + (size_t)nxt.pm * tstepA : cA; const char* nB = has_next ? (const char*)g.Bt + (size_t)nxt.pn * tstepB : cB;
        for (int t = 0; t < nt; t += 2) {
            const bool last = (t == nt - 2);
            const char* a1 = cA + (size_t)(t + 1) * kstep;
            const char* a2 = last ? nA : cA + (size_t)(t + 2) * kstep; const char* b2 = last ? nB : cB + (size_t)(t + 2) * kstep;
            const char* a3 = a2 + kstep; const char* b3 = b2 + kstep;
            PG8_LDB(B0, 0, 0); PG8_LDB(B1, 0, 1); PG8_SCHED; PG8_LDA(At, 0, 0); PG8_STAGE(PG8_SA(1, 1), a1 + hstepA, voffA);
            PG8_WAIT_V(8); PG8_WAIT_L(0); PG8_BAR; PG8_MMA(0, 0, At, B0); PG8_MMA(0, 1, At, B1); PG8_BAR; PG8_SCHED;
            PG8_LDA(At, 0, 1); PG8_STAGE(PG8_SB(0, 0), b2, voffB); PG8_STAGE(PG8_SB(0, 1), b2 + hstepB, voffB); PG8_STAGE(PG8_SA(0, 0), a2, voffA);
            PG8_WAIT_V(8); PG8_WAIT_L(0); PG8_BAR; PG8_MMA(1, 0, At, B0); PG8_MMA(1, 1, At, B1); PG8_BAR; PG8_SCHED;
            PG8_LDB(B0, 1, 0); PG8_LDB(B1, 1, 1); PG8_SCHED; PG8_LDA(At, 1, 0); PG8_STAGE(PG8_SA(0, 1), a2 + hstepA, voffA);
            PG8_WAIT_V(8); PG8_WAIT_L(0); PG8_BAR; PG8_MMA(0, 0, At, B0); PG8_MMA(0, 1, At, B1); PG8_BAR; PG8_SCHED;
            PG8_LDA(At, 1, 1); PG8_STAGE(PG8_SB(1, 0), b3, voffB); PG8_STAGE(PG8_SB(1, 1), b3 + hstepB, voffB); PG8_STAGE(PG8_SA(1, 0), a3, voffA);
            PG8_WAIT_V(8); PG8_WAIT_L(0); PG8_BAR; PG8_MMA(1, 0, At, B0); PG8_MMA(1, 1, At, B1); PG8_BAR; PG8_SCHED;
        }
        if (wr == 0) PG8_BAR;
        E(acc, cur, wr, wc, fr, fq);
        if (!has_next) break;
#pragma unroll
        for (int a = 0; a < 2; ++a)
#pragma unroll
            for (int b = 0; b < 2; ++b)
#pragma unroll
                for (int m = 0; m < 4; ++m)
#pragma unroll
                    for (int n = 0; n < 2; ++n) acc[a][b][m][n] = (f32x4){0.f, 0.f, 0.f, 0.f};
        cur = nxt; cA = nA; cB = nB; ++ui;
        if (wr == 1) PG8_BAR;
    }
    PG8_WAIT_V(0);
    PG8_BAR;
#undef PG8_SA
#undef PG8_SB
#undef PG8_STAGE
#undef PG8_LDA
#undef PG8_LDB
#undef PG8_MMA
#undef PG8_WAIT_V
#undef PG8_WAIT_L
#undef PG8_BAR
#undef PG8_SCHED
}
}
using pg8::Unit;

DEV u32x4 pack8(f32x4 v0, f32x4 v1) { u32x4 w; w.x = cvt_pk_bf16(v0[0], v0[1]); w.y = cvt_pk_bf16(v0[2], v0[3]); w.z = cvt_pk_bf16(v1[0], v1[1]); w.w = cvt_pk_bf16(v1[2], v1[3]); return w; }

struct EpiIn {
    unsigned char* ws;
    DEV void operator()(const f32x4 (&acc)[2][2][4][2], const Unit& u, int wr, int wc, int fr, int fq) const {
        const int pn = u.pn; bf16_t* base; int pitch, colt, mode = 0; float sc = 1.f;
        if (pn < 8) { base = (bf16_t*)(ws + Z_Q); pitch = 2048; colt = pn * 256; sc = 0.08838834764831845f; }
        else if (pn < 20) { const int s = (pn - 8) >> 1; colt = ((pn - 8) & 1) * 256; pitch = 512; base = (bf16_t*)(ws + Z_KC + (size_t)s * SZ_KV); mode = (s == 3 || s == 5) ? 1 : 0; }
        else if (pn < 52) { const int s = (pn - 20) >> 3; colt = ((pn - 20) & 7) * 256; pitch = 2048; base = (bf16_t*)(ws + Z_LX + (size_t)s * SZ_ACT); }
        else { mode = 2; base = (bf16_t*)(ws + Z_GATE); pitch = 64; colt = 0; }
        const int row0 = u.pm * 256 + wr * 64 + fr;
#pragma unroll
        for (int ai = 0; ai < 2; ++ai)
#pragma unroll
            for (int m = 0; m < 4; ++m) {
                const int row = row0 + ai * 128 + m * 16;
#pragma unroll
                for (int bj = 0; bj < 2; ++bj) {
                    const int col = colt + bj * 128 + wc * 32 + 8 * fq;
                    const f32x4 v0 = acc[ai][bj][m][0] * sc, v1 = acc[ai][bj][m][1] * sc;
                    const u32x4 w = pack8(v0, v1);
                    if (mode == 0) { *(u32x4*)(base + (size_t)row * pitch + col) = w; }
                    else if (mode == 1) {
                        const int b = row >> 11, t = row & 2047, gg = col >> 7, d = col & 127;
                        bf16_t* p = base + ((size_t)((b * 4 + gg) * 128 + d)) * 2048 + t;
                        p[0 * 2048] = (bf16_t)(w.x & 0xffff); p[1 * 2048] = (bf16_t)(w.x >> 16); p[2 * 2048] = (bf16_t)(w.y & 0xffff); p[3 * 2048] = (bf16_t)(w.y >> 16);
                        p[4 * 2048] = (bf16_t)(w.z & 0xffff); p[5 * 2048] = (bf16_t)(w.z >> 16); p[6 * 2048] = (bf16_t)(w.w & 0xffff); p[7 * 2048] = (bf16_t)(w.w >> 16);
                    } else { if (col < 48) *(u32x4*)(base + (size_t)row * 64 + col) = w; }
                }
            }
    }
};
template <int SECOND> struct EpiProj {
    const bf16_t* gate; bf16_t* O;
    DEV void operator()(const f32x4 (&acc)[2][2][4][2], const Unit& u, int wr, int wc, int fr, int fq) const {
        const int row0 = u.pm * 256 + wr * 64 + fr, colt = u.pn * 256;
#pragma unroll
        for (int ai = 0; ai < 2; ++ai)
#pragma unroll
            for (int m = 0; m < 4; ++m) {
                const int row = row0 + ai * 128 + m * 16;
#pragma unroll
                for (int bj = 0; bj < 2; ++bj) {
                    const int col = colt + bj * 128 + wc * 32 + 8 * fq;
                    const size_t off = (size_t)row * 2048 + col;
                    const u32x4 gv = *(const u32x4*)(gate + off);
                    f32x4 v0 = acc[ai][bj][m][0], v1 = acc[ai][bj][m][1];
                    v0[0] *= sigm(bflo(gv.x)); v0[1] *= sigm(bfhi(gv.x)); v0[2] *= sigm(bflo(gv.y)); v0[3] *= sigm(bfhi(gv.y));
                    v1[0] *= sigm(bflo(gv.z)); v1[1] *= sigm(bfhi(gv.z)); v1[2] *= sigm(bflo(gv.w)); v1[3] *= sigm(bfhi(gv.w));
                    if (SECOND) { const u32x4 pv = *(const u32x4*)(O + off);
                        v0[0] += bflo(pv.x); v0[1] += bfhi(pv.x); v0[2] += bflo(pv.y); v0[3] += bfhi(pv.y);
                        v1[0] += bflo(pv.z); v1[1] += bfhi(pv.z); v1[2] += bflo(pv.w); v1[3] += bfhi(pv.w); }
                    *(u32x4*)(O + off) = pack8(v0, v1);
                }
            }
    }
};
struct EpiRes {
    const float* xin; float* xout; const float* gvec;
    DEV void operator()(const f32x4 (&acc)[2][2][4][2], const Unit& u, int wr, int wc, int fr, int fq) const {
        const int row0 = u.pm * 256 + wr * 64 + fr, colt = u.pn * 256;
        const float* gb = gvec + (size_t)(row0 >> 11) * 12288;
#pragma unroll
        for (int bj = 0; bj < 2; ++bj) {
            const int col = colt + bj * 128 + wc * 32 + 8 * fq;
            const f32x4 g0 = *(const f32x4*)(gb + col), g1 = *(const f32x4*)(gb + col + 4);
#pragma unroll
            for (int ai = 0; ai < 2; ++ai)
#pragma unroll
                for (int m = 0; m < 4; ++m) {
                    const int row = row0 + ai * 128 + m * 16;
                    const size_t off = (size_t)row * 2048 + col;
                    const f32x4 x0 = *(const f32x4*)(xin + off), x1 = *(const f32x4*)(xin + off + 4);
                    *(f32x4*)(xout + off) = x0 + g0 * acc[ai][bj][m][0];
                    *(f32x4*)(xout + off + 4) = x1 + g1 * acc[ai][bj][m][1];
                }
        }
    }
};
struct EpiUp {
    bf16_t* G; bf16_t* V;
    DEV void operator()(const f32x4 (&acc)[2][2][4][2], const Unit& u, int wr, int wc, int fr, int fq) const {
        bf16_t* base = u.pn < 24 ? G : V; const int colt = (u.pn < 24 ? u.pn : u.pn - 24) * 256;
        const int row0 = u.pm * 256 + wr * 64 + fr;
#pragma unroll
        for (int ai = 0; ai < 2; ++ai)
#pragma unroll
            for (int m = 0; m < 4; ++m) {
                const int row = row0 + ai * 128 + m * 16;
#pragma unroll
                for (int bj = 0; bj < 2; ++bj) {
                    const int col = colt + bj * 128 + wc * 32 + 8 * fq;
                    *(u32x4*)(base + (size_t)row * DFF + col) = pack8(acc[ai][bj][m][0], acc[ai][bj][m][1]);
                }
            }
    }
};

template <int MAP>
DEV void transpose_item(const float* W, int K, int N, bf16_t* WT, float* scr, int item, int nblk, int lane) {
    const int kb = item / nblk, nb = item % nblk, k0 = 64 * kb, n0 = 32 * nb;
    const int nsrc = MAP ? win_src(n0 + (lane & 31)) : n0 + (lane & 31);
#pragma unroll 8
    for (int i = 0; i < 32; ++i) { const int kk = 2 * i + (lane >> 5); scr[kk * 33 + (lane & 31)] = nsrc >= 0 ? W[(size_t)(k0 + kk) * N + nsrc] : 0.f; }
    asm volatile("s_waitcnt lgkmcnt(0)" ::: "memory");
    const int c = lane & 7;
#pragma unroll
    for (int j = 0; j < 4; ++j) { const int n = (lane >> 3) + 8 * j; const float* s = scr + (8 * c) * 33 + n;
        u32x4 o; o.x = cvt_pk_bf16(s[0 * 33], s[1 * 33]); o.y = cvt_pk_bf16(s[2 * 33], s[3 * 33]); o.z = cvt_pk_bf16(s[4 * 33], s[5 * 33]); o.w = cvt_pk_bf16(s[6 * 33], s[7 * 33]);
        *(u32x4*)(WT + (size_t)(n0 + n) * K + k0 + 8 * c) = o; }
    asm volatile("s_waitcnt lgkmcnt(0)" ::: "memory");
}

DEV void phase_prep(const Params& P, unsigned char* lds) {
    const int tid = otid(), lane = tid & 63, wave = tid >> 6; const int bid = obid();
    float* scr = (float*)(lds + wave * 8448);
    const int gw = bid * 8 + wave, NGW = gridDim.x * 8;
    constexpr int I_IN = 32 * (NIN / 32), I_UP = 32 * 384, I_DN = 96 * 64, I_SQ = 32 * 64, I_W1 = 64 * 4, I_W2 = 2 * 4, I_LRU = 16 * 8;
    constexpr int PER_LAYER = I_IN + I_UP + I_DN + 3 * I_SQ + 2 * I_W1 + 2 * I_W2 + 2 * I_LRU;
    for (int it = gw; it < DEPTH * PER_LAYER; it += NGW) {
        const int l = it / PER_LAYER; int r = it % PER_LAYER;
        unsigned char* wl = P.ws + (size_t)l * LAYER_BYTES;
        if (r < I_IN) { transpose_item<1>(P.in[5] + (size_t)l * 2048 * 13360, 2048, 13360, (bf16_t*)(wl + L_WIN), scr, r, NIN / 32, lane); continue; } r -= I_IN;
        if (r < I_UP) { transpose_item<0>(P.in[23] + (size_t)l * 2048 * 12288, 2048, 12288, (bf16_t*)(wl + L_WUP), scr, r, 384, lane); continue; } r -= I_UP;
        if (r < I_DN) { transpose_item<0>(P.in[26] + (size_t)l * 6144 * 2048, 6144, 2048, (bf16_t*)(wl + L_WDN), scr, r, 64, lane); continue; } r -= I_DN;
        if (r < I_SQ) { transpose_item<0>(P.in[19] + (size_t)l * 2048 * 2048, 2048, 2048, (bf16_t*)(wl + L_PA), scr, r, 64, lane); continue; } r -= I_SQ;
        if (r < I_SQ) { transpose_item<0>(P.in[20] + (size_t)l * 2048 * 2048, 2048, 2048, (bf16_t*)(wl + L_PB), scr, r, 64, lane); continue; } r -= I_SQ;
        if (r < I_SQ) { transpose_item<0>(P.in[21] + (size_t)l * 2048 * 2048, 2048, 2048, (bf16_t*)(wl + L_WO), scr, r, 64, lane); continue; } r -= I_SQ;
        if (r < I_W1) { transpose_item<0>(P.in[7] + (size_t)l * 4096 * 128, 4096, 128, (bf16_t*)(wl + L_W1K), scr, r, 4, lane); continue; } r -= I_W1;
        if (r < I_W1) { transpose_item<0>(P.in[10] + (size_t)l * 4096 * 128, 4096, 128, (bf16_t*)(wl + L_W1V), scr, r, 4, lane); continue; } r -= I_W1;
        if (r < I_W2) { transpose_item<0>(P.in[8] + (size_t)l * 128 * 128, 128, 128, (bf16_t*)(wl + L_W2K), scr, r, 4, lane); continue; } r -= I_W2;
        if (r < I_W2) { transpose_item<0>(P.in[11] + (size_t)l * 128 * 128, 128, 128, (bf16_t*)(wl + L_W2V), scr, r, 4, lane); continue; } r -= I_W2;
        if (r < I_LRU) { const int mt = r >> 3; transpose_item<0>(P.in[14] + (size_t)(l * 16 + mt) * 16384, 128, 128, (bf16_t*)(wl + L_WA) + mt * 16384, scr, r & 7, 4, lane); continue; } r -= I_LRU;
        { const int mt = r >> 3; transpose_item<0>(P.in[16] + (size_t)(l * 16 + mt) * 16384, 128, 128, (bf16_t*)(wl + L_WI) + mt * 16384, scr, r & 7, 4, lane); }
    }
    __syncthreads();
    float* cact = (float*)(lds + 69632);
    float* red = (float*)lds;
    for (int i = tid; i < 8 * 2048; i += 512) { const int b = i >> 11, k = i & 2047; const float v = P.in[1][i]; cact[k * 8 + b] = v / (1.f + __expf(-v)); }
    __syncthreads();
    for (int it = bid; it < DEPTH * 192; it += gridDim.x) {
        const int l = it / 192, n = (it % 192) * 64 + lane, kg = wave;
        const float* w = P.in[2] + (size_t)l * 2048 * 12288 + (size_t)(kg * 256) * 12288 + n;
        float a[8];
#pragma unroll
        for (int b = 0; b < 8; ++b) a[b] = 0.f;
#pragma unroll 8
        for (int k = 0; k < 256; ++k) {
            const float wv = w[(size_t)k * 12288];
            const f32x4 c0 = *(const f32x4*)(cact + (kg * 256 + k) * 8), c1 = *(const f32x4*)(cact + (kg * 256 + k) * 8 + 4);
            a[0] += wv * c0[0]; a[1] += wv * c0[1]; a[2] += wv * c0[2]; a[3] += wv * c0[3];
            a[4] += wv * c1[0]; a[5] += wv * c1[1]; a[6] += wv * c1[2]; a[7] += wv * c1[3];
        }
#pragma unroll
        for (int b = 0; b < 8; ++b) red[(kg * 8 + b) * 64 + lane] = a[b];
        __syncthreads();
        { const int b = wave; float s = P.in[3][l * 12288 + n];
#pragma unroll
          for (int k2 = 0; k2 < 8; ++k2) s += red[(k2 * 8 + b) * 64 + lane];
          ((float*)(P.ws + (size_t)l * LAYER_BYTES + L_MOD))[b * 12288 + n] = s; }
        __syncthreads();
    }
}

template <int MODE>
DEV void phase_norm(const float* xin, const float* gvec, const float* mod, int seg_sh, int seg_sc, bf16_t* outb, float* outf) {
    const int tid_ = otid(); const int lane = tid_ & 63, wave = tid_ >> 6;
    const int gw = obid() * 8 + wave, NGW = gridDim.x * 8;
    const int rpw = (M + NGW - 1) / NGW;
    int cb = -1; f32x4 sa[8], sb[8];
    for (int row = gw * rpw; row < (gw + 1) * rpw && row < M; ++row) {
        const int b = row >> 11;
        if (b != cb) { cb = b;
#pragma unroll
            for (int j = 0; j < 8; ++j) { const int col = 4 * (lane + 64 * j); const f32x4 g = *(const f32x4*)(gvec + col);
                if (MODE == 0) { const f32x4 sc = *(const f32x4*)(mod + (size_t)b * 12288 + seg_sc * 2048 + col); sa[j] = g * (sc + 1.f); sb[j] = *(const f32x4*)(mod + (size_t)b * 12288 + seg_sh * 2048 + col); }
                else { sa[j] = g; } } }
        const f32x4* xr = (const f32x4*)(xin + (size_t)row * 2048) + lane;
        f32x4 v[8]; float s = 0.f;
#pragma unroll
        for (int j = 0; j < 8; ++j) { v[j] = xr[64 * j]; s += (v[j][0] * v[j][0] + v[j][1] * v[j][1]) + (v[j][2] * v[j][2] + v[j][3] * v[j][3]); }
        const float inv = 1.f / sqrtf(wave_sum(s, lane) * (1.f / 2048.f) + 1e-6f);
        if (MODE == 0) {
            u32x2* o = (u32x2*)(outb + (size_t)row * 2048) + lane;
#pragma unroll
            for (int j = 0; j < 8; ++j) { const f32x4 r = v[j] * inv * sa[j] + sb[j]; u32x2 w; w.x = cvt_pk_bf16(r[0], r[1]); w.y = cvt_pk_bf16(r[2], r[3]); o[64 * j] = w; }
        } else {
            f32x4* o = (f32x4*)(outf + (size_t)row * 2048) + lane;
#pragma unroll
            for (int j = 0; j < 8; ++j) o[64 * j] = v[j] * inv * sa[j];
        }
    }
}

DEV void cmp_item(const Params& P, int l, int item, unsigned char* lds) {
    const int tid = otid(), lane = tid & 63, w = tid >> 6, c = lane & 15, q = lane >> 4;
    const int kv = item >> 8, bg = (item >> 3) & 31, rt = item & 7, b = bg >> 2, g = bg & 3;
    unsigned char* wl = P.ws + (size_t)l * LAYER_BYTES;
    const bf16_t* src = (const bf16_t*)(P.ws + (kv ? Z_VC : Z_KC));
    const float* pos = P.in[kv ? 9 : 6] + (size_t)l * 4096;
    const bf16_t* W1T = (const bf16_t*)(wl + (kv ? L_W1V : L_W1K));
    const bf16_t* W2T = (const bf16_t*)(wl + (kv ? L_W2V : L_W2K));
    const int n = rt * 16 + c; const bool valid = n < 127;
    const bf16_t* arow = src + ((size_t)(b * 2048 + 16 * (valid ? n : 0)) * 512 + g * 128);
    const bf16_t* brow = W1T + (size_t)(w * 16 + c) * 4096;
    f32x4 acc = {0.f, 0.f, 0.f, 0.f};
#pragma unroll 4
    for (int ks = 0; ks < 128; ++ks) {
        const int lp = ks >> 2, d = (ks & 3) * 32 + q * 8;
        const u32x4 a = *(const u32x4*)(arow + (size_t)lp * 512 + d);
        const f32x4 p0 = *(const f32x4*)(pos + ks * 32 + q * 8), p1 = *(const f32x4*)(pos + ks * 32 + q * 8 + 4);
        u32x4 a2;
        a2.x = cvt_pk_bf16(bflo(a.x) + p0[0], bfhi(a.x) + p0[1]); a2.y = cvt_pk_bf16(bflo(a.y) + p0[2], bfhi(a.y) + p0[3]);
        a2.z = cvt_pk_bf16(bflo(a.z) + p1[0], bfhi(a.z) + p1[1]); a2.w = cvt_pk_bf16(bflo(a.w) + p1[2], bfhi(a.w) + p1[3]);
        if (!valid) a2 = (u32x4){0u, 0u, 0u, 0u};
        const u32x4 bb = *(const u32x4*)(brow + ks * 32 + q * 8);
        acc = mfma16(as_bf16x8(a2), as_bf16x8(bb), acc);
    }
    bf16_t* hid = (bf16_t*)lds;
#pragma unroll
    for (int j = 0; j < 4; ++j) hid[(q * 4 + j) * 136 + w * 16 + c] = (bf16_t)(cvt_pk_bf16(gelu_t(acc[j]), 0.f) & 0xffff);
    __syncthreads();
    f32x4 acc2 = {0.f, 0.f, 0.f, 0.f};
#pragma unroll
    for (int ks = 0; ks < 4; ++ks) {
        const u32x4 af = *(const u32x4*)(hid + c * 136 + ks * 32 + q * 8);
        const u32x4 bb = *(const u32x4*)(W2T + (size_t)(w * 16 + c) * 128 + ks * 32 + q * 8);
        acc2 = mfma16(as_bf16x8(af), as_bf16x8(bb), acc2);
    }
    if (kv == 0) { bf16_t* o = (bf16_t*)(P.ws + Z_KCMP) + ((size_t)bg * 128 + rt * 16 + q * 4) * 128 + w * 16 + c;
#pragma unroll
        for (int j = 0; j < 4; ++j) o[j * 128] = (bf16_t)(cvt_pk_bf16(acc2[j], 0.f) & 0xffff);
    } else { bf16_t* o = (bf16_t*)(P.ws + Z_VCMPT) + ((size_t)bg * 128 + w * 16 + c) * 128 + rt * 16 + q * 4;
        u32x2 wv; wv.x = cvt_pk_bf16(acc2[0], acc2[1]); wv.y = cvt_pk_bf16(acc2[2], acc2[3]); *(u32x2*)o = wv; }
    __syncthreads();
}

DEV void lru_item(const Params& P, int l, int item, unsigned char* lds) {
    const int tid = otid(), lane = tid & 63, w = tid >> 6, c = lane & 15, q = lane >> 4;
    const int b = item >> 5, n = (item >> 1) & 15, e = item & 1;
    const int C0 = n * 128, CO = C0 + e * 64;
    unsigned char* wl = P.ws + (size_t)l * LAYER_BYTES;
    constexpr int O_LX = 0, O_UB = 17408, O_UF = 34816, O_WA = 51200, O_WI = 68608, O_A = 86016, O_B = 102400;
    bf16_t* zlx = (bf16_t*)(P.ws + Z_LX); bf16_t* zly = (bf16_t*)(P.ws + Z_LY);
    __syncthreads();
    for (int id = tid; id < 2 * 64 * 16; id += 512) {
        const int which = id >> 10, r = (id >> 4) & 63, pc = id & 15;
        const bf16_t* s = (const bf16_t*)(wl + (which ? L_WI : L_WA)) + ((size_t)(n * 128 + e * 64 + r)) * 128 + pc * 8;
        *(u32x4*)(lds + (which ? O_WI : O_WA) + r * 272 + pc * 16) = *(const u32x4*)s;
    }
    const int chg = tid & 15, tl0 = tid >> 4;
    float cw[4][8], cbias[8];
#pragma unroll
    for (int i = 0; i < 8; ++i) { cbias[i] = P.in[13][l * 2048 + C0 + chg * 8 + i];
#pragma unroll
        for (int j = 0; j < 4; ++j) cw[j][i] = P.in[12][(l * 4 + j) * 2048 + C0 + chg * 8 + i]; }
    const int rt = w & 3, cp = w >> 2;
    float ba[2], bi[2], ll[2];
#pragma unroll
    for (int k2 = 0; k2 < 2; ++k2) { const int ch = l * 2048 + CO + (cp * 2 + k2) * 16 + c; ba[k2] = P.in[15][ch]; bi[k2] = P.in[17][ch];
        const float lam = P.in[18][ch]; ll[k2] = -8.f * (lam > 0.f ? log1pf(__expf(-lam)) : (log1pf(__expf(lam)) - lam)); }
    float hcarry = 0.f;
    float* UF = (float*)(lds + O_UF); float* Aa = (float*)(lds + O_A); float* Bb = (float*)(lds + O_B);
    for (int ci = 0; ci < 32; ++ci) {
        const int t0 = ci * 64;
        for (int id = tid; id < 67 * 16; id += 512) {
            const int r = id >> 4, pc = id & 15, t = t0 - 3 + r;
            u32x4 v = {0u, 0u, 0u, 0u};
            if (t >= 0) v = *(const u32x4*)(zlx + ((size_t)(b * 2048 + t)) * 2048 + C0 + pc * 8);
            *(u32x4*)(lds + O_LX + r * 256 + pc * 16) = v;
        }
        __syncthreads();
#pragma unroll
        for (int pass = 0; pass < 2; ++pass) {
            const int tl = tl0 + 32 * pass;
            float u[8];
#pragma unroll
            for (int i = 0; i < 8; ++i) u[i] = cbias[i];
#pragma unroll
            for (int j = 0; j < 4; ++j) {
                const u32x4 x = *(const u32x4*)(lds + O_LX + (tl + j) * 256 + chg * 16);
                u[0] += cw[j][0] * bflo(x.x); u[1] += cw[j][1] * bfhi(x.x); u[2] += cw[j][2] * bflo(x.y); u[3] += cw[j][3] * bfhi(x.y);
                u[4] += cw[j][4] * bflo(x.z); u[5] += cw[j][5] * bfhi(x.z); u[6] += cw[j][6] * bflo(x.w); u[7] += cw[j][7] * bfhi(x.w);
            }
            u32x4 pk; pk.x = cvt_pk_bf16(u[0], u[1]); pk.y = cvt_pk_bf16(u[2], u[3]); pk.z = cvt_pk_bf16(u[4], u[5]); pk.w = cvt_pk_bf16(u[6], u[7]);
            *(u32x4*)(lds + O_UB + tl * 272 + chg * 16) = pk;
            if ((chg >> 3) == e) { float* uf = UF + tl * 64 + (chg & 7) * 8;
                *(f32x4*)uf = (f32x4){u[0], u[1], u[2], u[3]}; *(f32x4*)(uf + 4) = (f32x4){u[4], u[5], u[6], u[7]}; }
        }
        __syncthreads();
        {
            f32x4 ar[2], ai[2];
#pragma unroll
            for (int k2 = 0; k2 < 2; ++k2) { ar[k2] = (f32x4){0.f, 0.f, 0.f, 0.f}; ai[k2] = (f32x4){0.f, 0.f, 0.f, 0.f}; }
#pragma unroll
            for (int ks = 0; ks < 4; ++ks) {
                const bf16x8 af = *(const bf16x8*)(lds + O_UB + (rt * 16 + c) * 272 + ks * 64 + q * 16);
#pragma unroll
                for (int k2 = 0; k2 < 2; ++k2) {
                    const int ct = cp * 2 + k2;
                    const bf16x8 wa = *(const bf16x8*)(lds + O_WA + (ct * 16 + c) * 272 + ks * 64 + q * 16);
                    const bf16x8 wi = *(const bf16x8*)(lds + O_WI + (ct * 16 + c) * 272 + ks * 64 + q * 16);
                    ar[k2] = mfma16(af, wa, ar[k2]); ai[k2] = mfma16(af, wi, ai[k2]);
                }
            }
#pragma unroll
            for (int k2 = 0; k2 < 2; ++k2)
#pragma unroll
                for (int j = 0; j < 4; ++j) {
                    const int tl = rt * 16 + q * 4 + j, cc = (cp * 2 + k2) * 16 + c;
                    const float uu = UF[tl * 64 + cc];
                    const float r = sigm(ar[k2][j] + ba[k2]), ig = sigm(ai[k2][j] + bi[k2]);
                    const float la = r * ll[k2];
                    Aa[tl * 64 + cc] = __expf(la);
                    Bb[tl * 64 + cc] = sqrtf(fmaxf(-expm1f(2.f * la), 0.f)) * (ig * uu);
                }
        }
        __syncthreads();
        if (w == 0) {
            float h = hcarry;
#pragma unroll 8
            for (int tl = 0; tl < 64; ++tl) { h = Aa[tl * 64 + lane] * h + Bb[tl * 64 + lane]; Bb[tl * 64 + lane] = h; }
            hcarry = h;
        }
        __syncthreads();
        {
            const int tl = tid >> 3, c8 = (tid & 7) * 8;
            bf16_t* p = zly + ((size_t)(b * 2048 + t0 + tl)) * 2048 + CO + c8;
            const u32x4 y = *(const u32x4*)p;
            const f32x4 h0 = *(const f32x4*)(Bb + tl * 64 + c8), h1 = *(const f32x4*)(Bb + tl * 64 + c8 + 4);
            u32x4 o;
            o.x = cvt_pk_bf16(gelu_t(bflo(y.x)) * h0[0], gelu_t(bfhi(y.x)) * h0[1]); o.y = cvt_pk_bf16(gelu_t(bflo(y.y)) * h0[2], gelu_t(bfhi(y.y)) * h0[3]);
            o.z = cvt_pk_bf16(gelu_t(bflo(y.z)) * h1[0], gelu_t(bfhi(y.z)) * h1[1]); o.w = cvt_pk_bf16(gelu_t(bflo(y.w)) * h1[2], gelu_t(bfhi(y.w)) * h1[3]);
            *(u32x4*)p = o;
        }
    }
    __syncthreads();
}

constexpr int A_KC = 0, A_VC = 34816, A_K = 0, A_V = 17408, A_E = 69632, A_CAR = 102400, A_IMP = 118784, A_SEL = 126976;
constexpr float L2E = 1.4426950408889634f;

DEV void attn_item(const Params& P, int b, int g, int qt, unsigned char* lds) {
    const int tid = otid(), lane = tid & 63, w = tid >> 6, c = lane & 15, q = lane >> 4;
    const int hg = w >> 1, th = w & 1, head = g * 4 + hg, bg = b * 4 + g;
    const int tq0 = 64 * qt + 32 * th;
    const size_t rowbase = (size_t)b * 2048;
    bf16_t* zq = (bf16_t*)(P.ws + Z_Q);
    const int krow = (c >> 2) * 8 + (c & 3);

    bf16x8 QF[2][4];
#pragma unroll
    for (int nt = 0; nt < 2; ++nt)
#pragma unroll
        for (int ks = 0; ks < 4; ++ks) QF[nt][ks] = *(const bf16x8*)(zq + (rowbase + tq0 + 16 * nt + c) * 2048 + head * 128 + ks * 32 + q * 8);
    float gate[3][2];
#pragma unroll
    for (int nt = 0; nt < 2; ++nt)
#pragma unroll
        for (int br = 0; br < 3; ++br) { const unsigned short gv = ((const bf16_t*)(P.ws + Z_GATE))[(rowbase + tq0 + 16 * nt + c) * 64 + head * 3 + br]; gate[br][nt] = sigm(bflo((unsigned)gv)); }

    __syncthreads();
    {
        const bf16_t* kc = (const bf16_t*)(P.ws + Z_KCMP) + (size_t)bg * 16384; const bf16_t* vc = (const bf16_t*)(P.ws + Z_VCMPT) + (size_t)bg * 16384;
#pragma unroll
        for (int i = 0; i < 4; ++i) { const int id = tid + 512 * i, r = id >> 4, pc = id & 15;
            *(u32x4*)(lds + A_KC + r * 272 + pc * 16) = *(const u32x4*)(kc + r * 128 + pc * 8);
            *(u32x4*)(lds + A_VC + r * 272 + pc * 16) = *(const u32x4*)(vc + r * 128 + pc * 8); }
    }
    __syncthreads();

    f32x4 o[8][2];
#pragma unroll
    for (int dt = 0; dt < 8; ++dt)
#pragma unroll
        for (int nt = 0; nt < 2; ++nt) o[dt][nt] = (f32x4){0.f, 0.f, 0.f, 0.f};
    {
        f32x4 s[4][2][2];
#pragma unroll
        for (int ch = 0; ch < 4; ++ch)
#pragma unroll
            for (int u = 0; u < 2; ++u)
#pragma unroll
                for (int nt = 0; nt < 2; ++nt) s[ch][u][nt] = (f32x4){0.f, 0.f, 0.f, 0.f};
#pragma unroll
        for (int ch = 0; ch < 4; ++ch)
#pragma unroll
            for (int ks = 0; ks < 4; ++ks)
#pragma unroll
                for (int u = 0; u < 2; ++u) {
                    const bf16x8 kf = *(const bf16x8*)(lds + A_KC + (ch * 32 + krow + u * 4) * 272 + ks * 64 + q * 16);
#pragma unroll
                    for (int nt = 0; nt < 2; ++nt) s[ch][u][nt] = mfma16(kf, QF[nt][ks], s[ch][u][nt]);
                }
        float* E = (float*)(lds + A_E); float* CAR = (float*)(lds + A_CAR);
#pragma unroll
        for (int nt = 0; nt < 2; ++nt) {
            const int t = tq0 + 16 * nt + c, nmax = (t - 31) >> 4;
            float mx = -1e30f;
#pragma unroll
            for (int ch = 0; ch < 4; ++ch)
#pragma unroll
                for (int u = 0; u < 2; ++u)
#pragma unroll
                    for (int j = 0; j < 4; ++j) { const int n = ch * 32 + q * 8 + u * 4 + j; const float v = s[ch][u][nt][j] * L2E; s[ch][u][nt][j] = v; if (n <= nmax) mx = fmaxf(mx, v); }
            mx = fmaxf(mx, shx(mx, 16, lane)); mx = fmaxf(mx, shx(mx, 32, lane));
            float sum = 0.f;
#pragma unroll
            for (int ch = 0; ch < 4; ++ch)
#pragma unroll
                for (int u = 0; u < 2; ++u)
#pragma unroll
                    for (int j = 0; j < 4; ++j) { const int n = ch * 32 + q * 8 + u * 4 + j; const float p = (n <= nmax) ? __builtin_amdgcn_exp2f(s[ch][u][nt][j] - mx) : 0.f; s[ch][u][nt][j] = p; sum += p; }
            sum += shx(sum, 16, lane); sum += shx(sum, 32, lane);
            const float inv = 1.f / fmaxf(sum, 1e-30f);
            const int tl = 32 * th + 16 * nt + c;
#pragma unroll
            for (int ch = 0; ch < 4; ++ch) {
#pragma unroll
                for (int u = 0; u < 2; ++u) s[ch][u][nt] = s[ch][u][nt] * inv;
                const f32x4 pa = s[ch][0][nt], pb = s[ch][1][nt];
                E[(hg * 64 + tl) * 32 + 8 * ch + 2 * q] = (pa[0] + pa[1]) + (pa[2] + pa[3]);
                E[(hg * 64 + tl) * 32 + 8 * ch + 2 * q + 1] = pa[3] + ((pb[0] + pb[1]) + (pb[2] + pb[3]));
                CAR[(hg * 64 + tl) * 16 + 4 * ch + q] = pb[3];
            }
        }
#pragma unroll
        for (int ch = 0; ch < 4; ++ch) {
            bf16x8 pf[2];
#pragma unroll
            for (int nt = 0; nt < 2; ++nt) pf[nt] = as_bf16x8(pack8(s[ch][0][nt], s[ch][1][nt]));
#pragma unroll
            for (int dt = 0; dt < 8; ++dt) {
                const bf16x8 vf = *(const bf16x8*)(lds + A_VC + (dt * 16 + c) * 272 + (ch * 32 + q * 8) * 2);
#pragma unroll
                for (int nt = 0; nt < 2; ++nt) o[dt][nt] = mfma16(vf, pf[nt], o[dt][nt]);
            }
        }
#pragma unroll
        for (int nt = 0; nt < 2; ++nt)
#pragma unroll
            for (int dt = 0; dt < 8; ++dt) {
                const f32x4 r = o[dt][nt] * gate[0][nt];
                u32x2 wv; wv.x = cvt_pk_bf16(r[0], r[1]); wv.y = cvt_pk_bf16(r[2], r[3]);
                *(u32x2*)(zq + (rowbase + tq0 + 16 * nt + c) * 2048 + head * 128 + dt * 16 + q * 4) = wv;
            }
    }
    __syncthreads();
    {
        const float* E = (const float*)(lds + A_E); const float* CAR = (const float*)(lds + A_CAR); float* IMP = (float*)(lds + A_IMP);
        const int tl = tid >> 3, jg = tid & 7;
#pragma unroll
        for (int jj = 0; jj < 4; ++jj) { const int j = jg * 4 + jj; float v = 0.f;
#pragma unroll
            for (int h = 0; h < 4; ++h) { v += E[(h * 64 + tl) * 32 + j]; if ((j & 1) == 0 && j >= 2) v += CAR[(h * 64 + tl) * 16 + (j >> 1) - 1]; }
            IMP[tl * 32 + j] = v; }
        __syncthreads();
        const int cur = qt, nforced = cur >= 2 ? 3 : cur + 1;
        unsigned bits = 0u;
#pragma unroll
        for (int jj = 0; jj < 4; ++jj) { const int j = jg * 4 + jj; bool sel;
            if (j > cur) sel = false;
            else if (j == 0 || j > cur - 2) sel = true;
            else { const float v = IMP[tl * 32 + j]; int cnt = 0;
                for (int j2 = 1; j2 <= cur - 2; ++j2) { const float v2 = IMP[tl * 32 + j2]; cnt += (v2 > v || (v2 == v && j2 < j)) ? 1 : 0; }
                sel = cnt < 16 - nforced; }
            bits |= sel ? (1u << j) : 0u; }
        bits |= shxu(bits, 1, lane); bits |= shxu(bits, 2, lane); bits |= shxu(bits, 4, lane);
        if (jg == 0) ((unsigned*)(lds + A_SEL))[tl] = bits;
    }
    __syncthreads();
    unsigned selm[2];
#pragma unroll
    for (int nt = 0; nt < 2; ++nt) selm[nt] = ((const unsigned*)(lds + A_SEL))[32 * th + 16 * nt + c];

#pragma unroll 1
    for (int br = 0; br < 2; ++br) {
        const bf16_t* Ks = (const bf16_t*)(P.ws + (br ? Z_KW : Z_KS)); const bf16_t* Vs = (const bf16_t*)(P.ws + (br ? Z_VWT : Z_VST));
        const int ntile = br ? (qt + 1 < 9 ? qt + 1 : 9) : qt + 1;
        unsigned sm[2]; int lo[2], tq[2];
#pragma unroll
        for (int nt = 0; nt < 2; ++nt) { tq[nt] = tq0 + 16 * nt + c; sm[nt] = br ? 0xffffffffu : selm[nt]; lo[nt] = br ? tq[nt] - 511 : -1; }
        float mrow[2] = {-1e30f, -1e30f}, lrow[2] = {0.f, 0.f};
#pragma unroll
        for (int dt = 0; dt < 8; ++dt)
#pragma unroll
            for (int nt = 0; nt < 2; ++nt) o[dt][nt] = (f32x4){0.f, 0.f, 0.f, 0.f};
        u32x4 pk[2], pv[2];
        auto tile_of = [&](int i) { return br ? qt - i : (i == 0 ? qt : i - 1); };
        auto prefetch = [&](int j) {
#pragma unroll
            for (int i = 0; i < 2; ++i) { const int id = tid + 512 * i;
                pk[i] = *(const u32x4*)(Ks + (rowbase + 64 * j + (id >> 4)) * 512 + g * 128 + (id & 15) * 8);
                pv[i] = *(const u32x4*)(Vs + ((size_t)bg * 128 + (id >> 3)) * 2048 + 64 * j + (id & 7) * 8); }
        };
        prefetch(tile_of(0));
#pragma unroll 1
        for (int i = 0; i < ntile; ++i) {
            const int j = tile_of(i);
            __syncthreads();
#pragma unroll
            for (int i2 = 0; i2 < 2; ++i2) { const int id = tid + 512 * i2;
                *(u32x4*)(lds + A_K + (id >> 4) * 272 + (id & 15) * 16) = pk[i2];
                *(u32x4*)(lds + A_V + (id >> 3) * 144 + (id & 7) * 16) = pv[i2]; }
            __syncthreads();
            if (i + 1 < ntile) prefetch(tile_of(i + 1));
            f32x4 s[2][2][2];
#pragma unroll
            for (int ch = 0; ch < 2; ++ch)
#pragma unroll
                for (int u = 0; u < 2; ++u)
#pragma unroll
                    for (int nt = 0; nt < 2; ++nt) s[ch][u][nt] = (f32x4){0.f, 0.f, 0.f, 0.f};
#pragma unroll
            for (int ch = 0; ch < 2; ++ch)
#pragma unroll
                for (int ks = 0; ks < 4; ++ks)
#pragma unroll
                    for (int u = 0; u < 2; ++u) {
                        const bf16x8 kf = *(const bf16x8*)(lds + A_K + (ch * 32 + krow + u * 4) * 272 + ks * 64 + q * 16);
#pragma unroll
                        for (int nt = 0; nt < 2; ++nt) s[ch][u][nt] = mfma16(kf, QF[nt][ks], s[ch][u][nt]);
                    }
#pragma unroll
            for (int nt = 0; nt < 2; ++nt) {
                const bool selected = (sm[nt] >> j) & 1u;
                float mx = -1e30f;
#pragma unroll
                for (int ch = 0; ch < 2; ++ch)
#pragma unroll
                    for (int u = 0; u < 2; ++u)
#pragma unroll
                        for (int jj = 0; jj < 4; ++jj) { const int key = 64 * j + ch * 32 + q * 8 + u * 4 + jj;
                            const bool ok = selected && key <= tq[nt] && key >= lo[nt];
                            const float v = ok ? s[ch][u][nt][jj] * L2E : -1e30f; s[ch][u][nt][jj] = v; mx = fmaxf(mx, v); }
                mx = fmaxf(mx, shx(mx, 16, lane)); mx = fmaxf(mx, shx(mx, 32, lane));
                const float mnew = fmaxf(mrow[nt], mx), alpha = __builtin_amdgcn_exp2f(mrow[nt] - mnew);
                mrow[nt] = mnew;
                float ps = 0.f;
#pragma unroll
                for (int ch = 0; ch < 2; ++ch)
#pragma unroll
                    for (int u = 0; u < 2; ++u)
#pragma unroll
                        for (int jj = 0; jj < 4; ++jj) { const float p = __builtin_amdgcn_exp2f(s[ch][u][nt][jj] - mnew); s[ch][u][nt][jj] = p; ps += p; }
                lrow[nt] = lrow[nt] * alpha + ps;
#pragma unroll
                for (int dt = 0; dt < 8; ++dt) o[dt][nt] = o[dt][nt] * alpha;
            }
#pragma unroll
            for (int ch = 0; ch < 2; ++ch) {
                bf16x8 pf[2];
#pragma unroll
                for (int nt = 0; nt < 2; ++nt) pf[nt] = as_bf16x8(pack8(s[ch][0][nt], s[ch][1][nt]));
#pragma unroll
                for (int dt = 0; dt < 8; ++dt) {
                    const bf16x8 vf = *(const bf16x8*)(lds + A_V + (dt * 16 + c) * 144 + (ch * 32 + q * 8) * 2);
#pragma unroll
                    for (int nt = 0; nt < 2; ++nt) o[dt][nt] = mfma16(vf, pf[nt], o[dt][nt]);
                }
            }
        }
#pragma unroll
        for (int nt = 0; nt < 2; ++nt) {
            float lsum = lrow[nt]; lsum += shx(lsum, 16, lane); lsum += shx(lsum, 32, lane);
            const float sc = gate[1 + br][nt] / fmaxf(lsum, 1e-30f);
#pragma unroll
            for (int dt = 0; dt < 8; ++dt) {
                u32x2* p = (u32x2*)(zq + (rowbase + tq0 + 16 * nt + c) * 2048 + head * 128 + dt * 16 + q * 4);
                const u32x2 pv2 = *p; const f32x4 r = o[dt][nt] * sc;
                u32x2 wv; wv.x = cvt_pk_bf16(bflo(pv2.x) + r[0], bfhi(pv2.x) + r[1]); wv.y = cvt_pk_bf16(bflo(pv2.y) + r[2], bfhi(pv2.y) + r[3]);
                *p = wv;
            }
        }
    }
}

DEV void phase_attn(const Params& P, unsigned char* lds) {
    for (int idx = obid(); idx < 1024; idx += gridDim.x) {
        const int k = idx >> 8, within = idx & 255, j = within >> 5, bgi = within & 31;
        const int qt = k == 0 ? 31 - j : (k == 1 ? 16 + j : (k == 2 ? 15 - j : j));
        attn_item(P, bgi >> 2, bgi & 3, qt, lds);
    }
    __syncthreads();
}

DEV void phase_glu(const Params& P, int l, unsigned char* lds) {
    const int tid = otid(), chg = tid & 15, tg = tid >> 4;
    bf16_t* G = (bf16_t*)(P.ws + F_G); const bf16_t* V = (const bf16_t*)(P.ws + F_V);
    for (int it = obid(); it < 8 * 48; it += gridDim.x) {
        const int b = it / 48, c0 = (it % 48) * 128 + chg * 8;
        float w0[8], w1[8], w2[8], bs[8];
#pragma unroll
        for (int i = 0; i < 8; ++i) { w0[i] = P.in[24][(l * 3 + 0) * DFF + c0 + i]; w1[i] = P.in[24][(l * 3 + 1) * DFF + c0 + i]; w2[i] = P.in[24][(l * 3 + 2) * DFF + c0 + i]; bs[i] = P.in[25][l * DFF + c0 + i]; }
        const int t0 = tg * 64;
        bf16_t* gp = G + ((size_t)(b * 2048 + t0)) * DFF + c0; const bf16_t* vp = V + ((size_t)(b * 2048 + t0)) * DFF + c0;
        u32x4 hm2 = {0u, 0u, 0u, 0u}, hm1 = {0u, 0u, 0u, 0u};
        if (t0 > 0) { hm2 = *(const u32x4*)(gp - 2 * (size_t)DFF); hm1 = *(const u32x4*)(gp - (size_t)DFF); }
        __syncthreads();
        for (int tb = 0; tb < 64; tb += 8) {
            u32x4 gr[8], vr[8];
#pragma unroll
            for (int r = 0; r < 8; ++r) { gr[r] = *(const u32x4*)(gp + (size_t)(tb + r) * DFF); vr[r] = *(const u32x4*)(vp + (size_t)(tb + r) * DFF); }
#pragma unroll
            for (int r = 0; r < 8; ++r) {
                const u32x4 x0 = hm2, x1 = hm1, x2 = gr[r];
                float a[8];
                a[0] = bs[0] + w0[0] * bflo(x0.x) + w1[0] * bflo(x1.x) + w2[0] * bflo(x2.x); a[1] = bs[1] + w0[1] * bfhi(x0.x) + w1[1] * bfhi(x1.x) + w2[1] * bfhi(x2.x);
                a[2] = bs[2] + w0[2] * bflo(x0.y) + w1[2] * bflo(x1.y) + w2[2] * bflo(x2.y); a[3] = bs[3] + w0[3] * bfhi(x0.y) + w1[3] * bfhi(x1.y) + w2[3] * bfhi(x2.y);
                a[4] = bs[4] + w0[4] * bflo(x0.z) + w1[4] * bflo(x1.z) + w2[4] * bflo(x2.z); a[5] = bs[5] + w0[5] * bfhi(x0.z) + w1[5] * bfhi(x1.z) + w2[5] * bfhi(x2.z);
                a[6] = bs[6] + w0[6] * bflo(x0.w) + w1[6] * bflo(x1.w) + w2[6] * bflo(x2.w); a[7] = bs[7] + w0[7] * bfhi(x0.w) + w1[7] * bfhi(x1.w) + w2[7] * bfhi(x2.w);
                const u32x4 vv = vr[r]; u32x4 ov;
                ov.x = cvt_pk_bf16(gelu_t(a[0]) * bflo(vv.x), gelu_t(a[1]) * bfhi(vv.x)); ov.y = cvt_pk_bf16(gelu_t(a[2]) * bflo(vv.y), gelu_t(a[3]) * bfhi(vv.y));
                ov.z = cvt_pk_bf16(gelu_t(a[4]) * bflo(vv.z), gelu_t(a[5]) * bfhi(vv.z)); ov.w = cvt_pk_bf16(gelu_t(a[6]) * bflo(vv.w), gelu_t(a[7]) * bfhi(vv.w));
                *(u32x4*)(gp + (size_t)(tb + r) * DFF) = ov;
                hm2 = hm1; hm1 = x2;
            }
        }
        __syncthreads();
    }
}

__global__ void __launch_bounds__(512, 2) mega_fwd(Params P) {
    extern __shared__ __attribute__((aligned(16))) unsigned char lds[];
    const int lo = P.ph_lo, hi = P.ph_hi;
    int ph = 0;
#define PH_BEGIN if (ph >= lo && ph < hi) {
#define PH_END   if (ph + 1 < hi) { cg::this_grid().sync(); } } ++ph;
    LAS unsigned char* ldsl = (LAS unsigned char*)lds;
    const int G = gridDim.x;
    float* xbuf = P.out;

    PH_BEGIN
#ifndef SKIP_PREP
 phase_prep(P, lds);
#endif
 PH_END

#pragma unroll 1
    for (int l = 0; l < DEPTH; ++l) {
        unsigned char* wl = P.ws + (size_t)l * LAYER_BYTES;
        const float* mod = (const float*)(wl + L_MOD);
        const float* xcur = l == 0 ? P.in[0] : xbuf;
        bf16_t* hbuf = (bf16_t*)(P.ws + WS_HBUF);
        PH_BEGIN phase_norm<0>(xcur, P.in[4] + l * 2048, mod, 0, 1, hbuf, nullptr); PH_END
        PH_BEGIN { pg8::Gemm g{hbuf, (const bf16_t*)(wl + L_WIN), M, NIN, 2048, 2048}; pg8::StaticOrder S; S.init(M, NIN, G, obid()); EpiIn E{P.ws};

#ifndef SKIP_GIN
 pg8::gemm_phase<EpiIn>(ldsl, g, S, E);
#endif
 } PH_END
        PH_BEGIN {
#ifndef SKIP_LRU
 for (int it = obid(); it < 256; it += G) lru_item(P, l, it, lds);
#endif
#ifndef SKIP_CMP
 for (int it = obid(); it < 512; it += G) cmp_item(P, l, it, lds);
#endif
 } PH_END
        PH_BEGIN
#ifndef SKIP_ATTN
 phase_attn(P, lds);
#endif
 PH_END
        PH_BEGIN { pg8::StaticOrder S; S.init(M, 2048, G, obid());
                   { pg8::Gemm g{(const bf16_t*)(P.ws + Z_Q), (const bf16_t*)(wl + L_PA), M, 2048, 2048, 2048}; EpiProj<0> E{(const bf16_t*)(P.ws + Z_GA), hbuf};
#ifndef SKIP_GPA
 pg8::gemm_phase<EpiProj<0>>(ldsl, g, S, E);
#endif
 }
                   __syncthreads();
                   { pg8::Gemm g{(const bf16_t*)(P.ws + Z_LY), (const bf16_t*)(wl + L_PB), M, 2048, 2048, 2048}; EpiProj<1> E{(const bf16_t*)(P.ws + Z_GB), hbuf};
#ifndef SKIP_GPB
 pg8::gemm_phase<EpiProj<1>>(ldsl, g, S, E);
#endif
 } } PH_END
        PH_BEGIN { pg8::Gemm g{hbuf, (const bf16_t*)(wl + L_WO), M, 2048, 2048, 2048}; pg8::StaticOrder S; S.init(M, 2048, G, obid()); EpiRes E{xcur, xbuf, mod + 2 * 2048};
#ifndef SKIP_GWO
 pg8::gemm_phase<EpiRes>(ldsl, g, S, E);
#endif
 } PH_END
        PH_BEGIN phase_norm<0>(xbuf, P.in[22] + l * 2048, mod, 3, 4, hbuf, nullptr); PH_END
        PH_BEGIN { pg8::Gemm g{hbuf, (const bf16_t*)(wl + L_WUP), M, 12288, 2048, 2048}; pg8::StaticOrder S; S.init(M, 12288, G, obid()); EpiUp E{(bf16_t*)(P.ws + F_G), (bf16_t*)(P.ws + F_V)};

#ifndef SKIP_GUP
 pg8::gemm_phase<EpiUp>(ldsl, g, S, E);
#endif
 } PH_END
        PH_BEGIN
#ifndef SKIP_GLU
 phase_glu(P, l, lds);
#endif
 PH_END
        PH_BEGIN { pg8::Gemm g{(const bf16_t*)(P.ws + F_G), (const bf16_t*)(wl + L_WDN), M, 2048, DFF, DFF}; pg8::StaticOrder S; S.init(M, 2048, G, obid()); EpiRes E{xbuf, xbuf, mod + 5 * 2048};
#ifndef SKIP_GDN
 pg8::gemm_phase<EpiRes>(ldsl, g, S, E);
#endif
 } PH_END
    }
    PH_BEGIN phase_norm<1>(xbuf, P.in[27], nullptr, 0, 0, nullptr, xbuf); PH_END
#undef PH_BEGIN
#undef PH_END
}

extern "C" void kernel_launch(void* const* d_in, const int* in_sizes, int n_in, void* d_out, int out_size, void* d_ws, size_t ws_size, hipStream_t stream) {
    static int grid = 0;
    if (grid == 0) {
        if (n_in != 28 || out_size != M * D || ws_size < WS_NEED) { fprintf(stderr, "kernel_launch: unexpected problem (n_in %d, out %d, ws %zu < %zu)\n", n_in, out_size, ws_size, (size_t)WS_NEED); grid = -1; return; }
        int dev = 0, cus = 0, per_cu = 0;
        hipGetDevice(&dev);
        hipDeviceGetAttribute(&cus, hipDeviceAttributeMultiprocessorCount, dev);
        if (hipFuncSetAttribute((const void*)mega_fwd, hipFuncAttributeMaxDynamicSharedMemorySize, LDS_BYTES) != hipSuccess) { fprintf(stderr, "kernel_launch: hipFuncSetAttribute failed\n"); grid = -1; return; }
        if (hipOccupancyMaxActiveBlocksPerMultiprocessor(&per_cu, (const void*)mega_fwd, 512, LDS_BYTES) != hipSuccess || per_cu < 1) { fprintf(stderr, "kernel_launch: occupancy query says %d\n", per_cu); per_cu = 1; }
        (void)hipGetLastError();
        grid = cus * (per_cu > 1 ? 1 : per_cu);
        fprintf(stderr, "kernel_launch: grid %d (cus %d, per_cu %d), ws need %zu of %zu\n", grid, cus, per_cu, (size_t)WS_NEED, ws_size);
    }
    if (grid < 0) return;
    Params p{};
    for (int i = 0; i < 28; ++i) p.in[i] = (const float*)d_in[i];
    p.out = (float*)d_out; p.ws = (unsigned char*)d_ws;
#if MK_COOP
    p.ph_lo = 0; p.ph_hi = NPHASE;
    void* args[] = {&p};
    hipError_t e = hipLaunchCooperativeKernel((const void*)mega_fwd, dim3(grid), dim3(512), args, LDS_BYTES, stream);
    if (e != hipSuccess) fprintf(stderr, "cooperative launch failed: %s (grid %d)\n", hipGetErrorString(e), grid);
#else
    for (int ph = 0; ph < NPHASE; ++ph) {
        p.ph_lo = ph; p.ph_hi = ph + 1;
        hipLaunchKernelGGL(mega_fwd, dim3(grid), dim3(512), LDS_BYTES, stream, p);
    }
#endif
}
```

```cpp
#include <hip/hip_runtime.h>
#include <hip/hip_cooperative_groups.h>
#include <cstdio>
#include <cstdint>
namespace cg = cooperative_groups;

#ifndef MK_COOP
#define MK_COOP 1
#endif

#ifndef PROBE
#define PROBE 0
#endif
#ifndef PROBE_CHECK
#define PROBE_CHECK 0
#endif
#define PROBE_GA 2
#define PROBE_GB 4
#define DEV __device__ __forceinline__
#define LAS __attribute__((address_space(3)))
typedef unsigned short bf16_t;
typedef short bf16x8 __attribute__((ext_vector_type(8)));
typedef float f32x4 __attribute__((ext_vector_type(4)));
typedef unsigned u32x4 __attribute__((ext_vector_type(4)));
typedef unsigned u32x2 __attribute__((ext_vector_type(2)));

constexpr int NB = 8, T = 2048, D = 2048, M = NB * T, DEPTH = 2;
constexpr int NIN = 13568;
constexpr int DFF = 6144;
constexpr int NPHASE = 1 + 10 * DEPTH + 1;
constexpr int LDS_BYTES = 147456;

DEV int up_src(int n) { return ((n >> 7) & 1) * 6144 + (n >> 8) * 128 + (n & 127); }
DEV int win_src(int n) { return n < 5120 ? n : (n < 13312 ? n + 48 : (n < 13360 ? n - 13312 + 5120 : -1)); }

constexpr size_t SZ_WIN = (size_t)NIN * 2048 * 2, SZ_WUP = (size_t)12288 * 2048 * 2, SZ_WDN = (size_t)2048 * 6144 * 2, SZ_WSQ = (size_t)2048 * 2048 * 2;
constexpr size_t SZ_W1 = (size_t)128 * 4096 * 2, SZ_W2 = 128 * 128 * 2, SZ_LRUW = 16 * 128 * 128 * 2, SZ_MOD = 8 * 12288 * 4;
constexpr size_t L_WIN = 0, L_WUP = L_WIN + SZ_WIN, L_WDN = L_WUP + SZ_WUP, L_PA = L_WDN + SZ_WDN, L_PB = L_PA + SZ_WSQ, L_WO = L_PB + SZ_WSQ,
                 L_W1K = L_WO + SZ_WSQ, L_W1V = L_W1K + SZ_W1, L_W2K = L_W1V + SZ_W1, L_W2V = L_W2K + SZ_W2, L_WA = L_W2V + SZ_W2, L_WI = L_WA + SZ_LRUW,
                 L_MOD = L_WI + SZ_LRUW, LAYER_BYTES = L_MOD + SZ_MOD;
constexpr size_t SZ_ACT = (size_t)M * 2048 * 2;
constexpr size_t SZ_KV = (size_t)M * 512 * 2;
constexpr size_t WS_HBUF = DEPTH * LAYER_BYTES;
constexpr size_t WS_Z = WS_HBUF + SZ_ACT;
constexpr size_t Z_Q = WS_Z, Z_KC = Z_Q + SZ_ACT, Z_VC = Z_KC + SZ_KV, Z_KS = Z_VC + SZ_KV, Z_VST = Z_KS + SZ_KV, Z_KW = Z_VST + SZ_KV, Z_VWT = Z_KW + SZ_KV,
                 Z_LX = Z_VWT + SZ_KV, Z_LY = Z_LX + SZ_ACT, Z_GA = Z_LY + SZ_ACT, Z_GB = Z_GA + SZ_ACT, Z_GATE = Z_GB + SZ_ACT,
                 Z_KCMP = Z_GATE + (size_t)M * 64 * 2, Z_VCMPT = Z_KCMP + (size_t)32 * 128 * 128 * 2, Z_END = Z_VCMPT + (size_t)32 * 128 * 128 * 2;
constexpr size_t F_G = WS_Z, F_V = WS_Z + (size_t)M * DFF * 2;
static_assert(F_V + (size_t)M * DFF * 2 <= Z_KCMP, "ffn overlay");
constexpr size_t WS_BAR = (Z_END + 255) & ~(size_t)255, WS_BAR_BYTES = 16384;
constexpr size_t WS_SIDE = WS_BAR + WS_BAR_BYTES, SIDE_ELEMS = (size_t)64 * 2 * DFF;
constexpr size_t WS_OBUF = WS_SIDE + 3 * SIDE_ELEMS * 4, WS_CHK = WS_OBUF + SZ_ACT;
constexpr size_t WS_NEED = PROBE_CHECK ? WS_CHK + 4096 : WS_OBUF;

struct Params { const float* in[28]; float* out; unsigned char* ws; int ph_lo, ph_hi; };
extern __shared__ __attribute__((aligned(16))) unsigned char g_lds[];
constexpr int TAB_OFF = LDS_BYTES - 64 - 256;
__device__ __forceinline__ const float* inp(int k) {
    const unsigned long long v = *(const volatile __attribute__((address_space(3))) unsigned long long*)((__attribute__((address_space(3))) unsigned char*)g_lds + TAB_OFF + 8 * k);
    const unsigned lo = __builtin_amdgcn_readfirstlane((unsigned)v), hi = __builtin_amdgcn_readfirstlane((unsigned)(v >> 32));
    return (const float*)(const __attribute__((address_space(1))) float*)(((unsigned long long)hi << 32) | lo);
}
#define INP(k) inp(k)

DEV float bflo(unsigned u) { return __builtin_bit_cast(float, u << 16); }
DEV float bfhi(unsigned u) { return __builtin_bit_cast(float, u & 0xffff0000u); }
DEV unsigned cvt_pk_bf16(float lo, float hi) { unsigned r; asm volatile("v_cvt_pk_bf16_f32 %0, %1, %2" : "=v"(r) : "v"(lo), "v"(hi)); return r; }
DEV float frcp(float x) { return __builtin_amdgcn_rcpf(x); }
DEV float sigm(float x) { return frcp(1.f + __builtin_amdgcn_exp2f(-1.4426950408889634f * x)); }
DEV float gelu_t(float x) { const float u = -2.302208198106407f * (x + 0.044715f * x * x * x); return x * frcp(1.f + __builtin_amdgcn_exp2f(u)); }
DEV float shx(float v, int m, int lane) { return __builtin_bit_cast(float, __builtin_amdgcn_ds_bpermute((lane ^ m) << 2, __builtin_bit_cast(int, v))); }
DEV unsigned shxu(unsigned v, int m, int lane) { return (unsigned)__builtin_amdgcn_ds_bpermute((lane ^ m) << 2, (int)v); }
DEV float wave_sum(float v, int lane) {
#pragma unroll
    for (int o = 1; o < 64; o <<= 1) v += shx(v, o, lane);
    return v;
}
DEV int otid() { int t = threadIdx.x; asm volatile("" : "+v"(t)); return t; }
DEV int obid() { int b = blockIdx.x; asm volatile("" : "+s"(b)); return b; }
DEV int lsg(int v) { asm volatile("" : "+s"(v)); return v; }
DEV f32x4 mfma16(bf16x8 a, bf16x8 b, f32x4 c) { return __builtin_amdgcn_mfma_f32_16x16x32_bf16(a, b, c, 0, 0, 0); }
DEV bf16x8 as_bf16x8(u32x4 v) { return __builtin_bit_cast(bf16x8, v); }

namespace pg8 {
constexpr int BM = 256, BK = 64, HALF = 128, HTB = HALF * BK * 2, NXCD = 8, WGM = 8;
DEV int lds_byte(int r, int c) { const int st = (r >> 4) * 2 + (c >> 5), rr = r & 15, cc = c & 31, ob = rr * 64 + cc * 2; return st * 1024 + (ob ^ (((ob >> 9) & 1) << 5)); }
DEV void stage_rc(int b, int& R, int& C) { const int st = b / 1024, sb = b % 1024, swz = sb ^ (((sb >> 9) & 1) << 5); R = (st >> 1) * 16 + swz / 64; C = (st & 1) * 32 + (swz % 64) / 2; }
DEV int perm32(int rho) { const int n = rho >> 4, i = rho & 15; return 8 * (i >> 2) + 4 * n + (i & 3); }
struct Unit { int pm, pn; };
struct Gemm { const bf16_t* A; const bf16_t* Bt; int M, N, K, lda; size_t pj; };
struct StaticOrder {
    int nM, nN, nwg, G, c;
    DEV void init(int M_, int N_, int G_, int c_) { nM = M_ / BM; nN = N_ / BM; nwg = nM * nN; G = G_; c = c_; }
    DEV bool next(int i, Unit& u) const {
        const long L = (long)i * G + c; if (L >= nwg) return false;
        const int wgid = (int)L;
        const int nig = WGM * nN, gid = wgid / nig, fm = gid * WGM, gsz = (nM - fm) < WGM ? (nM - fm) : WGM;
        u.pm = fm + ((wgid % nig) % gsz); u.pn = (wgid % nig) / gsz; return true;
    }
};
template <class Epi>
DEV void gemm_phase(LAS unsigned char* lds, const Gemm g, const StaticOrder& S, const Epi& E) {
    const int tid = otid(), wid = __builtin_amdgcn_readfirstlane(tid >> 6), lane = tid & 63, wr = wid >> 2, wc = wid & 3, fr = lane & 15, fq = lane >> 4;
    const int K = g.K, nt = K / BK, lda = g.lda;
    unsigned voffA[2], voffB[2];
#pragma unroll
    for (int i = 0; i < 2; ++i) { int R, C; stage_rc(tid * 16 + i * 8192, R, C); const int Rb = (R & ~31) + perm32(R & 31);
        voffA[i] = (unsigned)(R * lda + C) * 2u; voffB[i] = (unsigned)(Rb * K + C) * 2u; }
    const size_t kstep = (size_t)(BK * 2);
    const size_t pj = g.pj;
#define PG8_KOFF(t) ((size_t)(t) * kstep + (size_t)((t) >> 5) * pj)
    const size_t hstepA = (size_t)HALF * lda * 2, tstepA = 2 * hstepA;
    const size_t hstepB = (size_t)HALF * K * 2, tstepB = 2 * hstepB;
    const unsigned ldsw = (unsigned)wid * 1024u;
    const int aoff = lds_byte(wr * 64 + fr, fq * 8), boff = lds_byte(wc * 32 + fr, fq * 8);
#define PG8_SA(b, h) (((b) * 2 + (h)) * HTB)
#define PG8_SB(b, h) ((4 + (b) * 2 + (h)) * HTB)
#define PG8_STAGE(bufoff, gbase, voff) do { _Pragma("unroll") for (int _i = 0; _i < 2; ++_i) \
        __builtin_amdgcn_global_load_lds((const unsigned*)((const char*)(gbase) + (voff)[_i]), (LAS unsigned*)(lds + (bufoff) + ldsw + _i * 8192), 16, 0, 0); } while (0)
#define PG8_LDA(dst, b, h) do { _Pragma("unroll") for (int m = 0; m < 4; ++m) _Pragma("unroll") for (int k = 0; k < 2; ++k) dst[m][k] = *(const LAS bf16x8*)(lds + PG8_SA(b, h) + aoff + m * 2048 + k * 1024); } while (0)
#define PG8_LDB(dst, b, h) do { _Pragma("unroll") for (int n = 0; n < 2; ++n) _Pragma("unroll") for (int k = 0; k < 2; ++k) dst[n][k] = *(const LAS bf16x8*)(lds + PG8_SB(b, h) + boff + n * 2048 + k * 1024); } while (0)
#define PG8_MMA(ai, bj, At, Bt) do { __builtin_amdgcn_s_setprio(1); _Pragma("unroll") for (int m = 0; m < 4; ++m) _Pragma("unroll") for (int n = 0; n < 2; ++n) _Pragma("unroll") for (int k = 0; k < 2; ++k) \
        acc[ai][bj][m][n] = __builtin_amdgcn_mfma_f32_16x16x32_bf16(Bt[n][k], At[m][k], acc[ai][bj][m][n], 0, 0, 0); __builtin_amdgcn_s_setprio(0); } while (0)
#define PG8_WAIT_V(n) asm volatile("s_waitcnt vmcnt(" #n ")" ::: "memory")
#define PG8_WAIT_L(n) asm volatile("s_waitcnt lgkmcnt(" #n ")" ::: "memory")
#define PG8_BAR __builtin_amdgcn_s_barrier()
#define PG8_SCHED __builtin_amdgcn_sched_barrier(0)
    Unit cur, nxt; int ui = 0;
    if (!S.next(0, cur)) return;
    f32x4 acc[2][2][4][2];
#pragma unroll
    for (int a = 0; a < 2; ++a)
#pragma unroll
        for (int b = 0; b < 2; ++b)
#pragma unroll
            for (int m = 0; m < 4; ++m)
#pragma unroll
                for (int n = 0; n < 2; ++n) acc[a][b][m][n] = (f32x4){0.f, 0.f, 0.f, 0.f};
    bf16x8 At[4][2], B0[2][2], B1[2][2];
    const char* cA = (const char*)g.A + (size_t)cur.pm * tstepA; const char* cB = (const char*)g.Bt + (size_t)cur.pn * tstepB;
    PG8_STAGE(PG8_SB(0, 0), cB, voffB); PG8_STAGE(PG8_SB(0, 1), cB + hstepB, voffB); PG8_STAGE(PG8_SA(0, 0), cA, voffA); PG8_STAGE(PG8_SA(0, 1), cA + hstepA, voffA);
    if (wr == 1) PG8_BAR;
    PG8_WAIT_V(2); PG8_BAR;
    PG8_STAGE(PG8_SB(1, 0), cB + kstep, voffB); PG8_STAGE(PG8_SA(1, 0), cA + kstep, voffA); PG8_STAGE(PG8_SB(1, 1), cB + hstepB + kstep, voffB);
    PG8_WAIT_V(6); PG8_BAR;
    for (;;) {
        const bool has_next = S.next(ui + 1, nxt);
        const char* nA = has_next ? (const char*)g.A + (size_t)nxt.pm * tstepA : cA; const char* nB = has_next ? (const char*)g.Bt + (size_t)nxt.pn * tstepB : cB;
        for (int t = 0; t < nt; t += 2) {
            const bool last = (t == nt - 2);
            const char* a1 = cA + PG8_KOFF(t + 1);
            const char* a2 = last ? nA : cA + PG8_KOFF(t + 2); const char* b2 = last ? nB : cB + (size_t)(t + 2) * kstep;
            const char* a3 = last ? nA + kstep : cA + PG8_KOFF(t + 3); const char* b3 = b2 + kstep;
            PG8_LDB(B0, 0, 0); PG8_LDB(B1, 0, 1); PG8_SCHED; PG8_LDA(At, 0, 0); PG8_STAGE(PG8_SA(1, 1), a1 + hstepA, voffA);
            PG8_WAIT_V(8); PG8_WAIT_L(0); PG8_BAR; PG8_MMA(0, 0, At, B0); PG8_MMA(0, 1, At, B1); PG8_BAR; PG8_SCHED;
            PG8_LDA(At, 0, 1); PG8_STAGE(PG8_SB(0, 0), b2, voffB); PG8_STAGE(PG8_SB(0, 1), b2 + hstepB, voffB); PG8_STAGE(PG8_SA(0, 0), a2, voffA);
            PG8_WAIT_V(8); PG8_WAIT_L(0); PG8_BAR; PG8_MMA(1, 0, At, B0); PG8_MMA(1, 1, At, B1); PG8_BAR; PG8_SCHED;
            PG8_LDB(B0, 1, 0); PG8_LDB(B1, 1, 1); PG8_SCHED; PG8_LDA(At, 1, 0); PG8_STAGE(PG8_SA(0, 1), a2 + hstepA, voffA);
            PG8_WAIT_V(8); PG8_WAIT_L(0); PG8_BAR; PG8_MMA(0, 0, At, B0); PG8_MMA(0, 1, At, B1); PG8_BAR; PG8_SCHED;
            PG8_LDA(At, 1, 1); PG8_STAGE(PG8_SB(1, 0), b3, voffB); PG8_STAGE(PG8_SB(1, 1), b3 + hstepB, voffB); PG8_STAGE(PG8_SA(1, 0), a3, voffA);
            PG8_WAIT_V(8); PG8_WAIT_L(0); PG8_BAR; PG8_MMA(1, 0, At, B0); PG8_MMA(1, 1, At, B1); PG8_BAR; PG8_SCHED;
        }
        if (wr == 0) PG8_BAR;
        E(acc, cur, wr, wc, fr, fq);
        if (!has_next) break;
#pragma unroll
        for (int a = 0; a < 2; ++a)
#pragma unroll
            for (int b = 0; b < 2; ++b)
#pragma unroll
                for (int m = 0; m < 4; ++m)
#pragma unroll
                    for (int n = 0; n < 2; ++n) acc[a][b][m][n] = (f32x4){0.f, 0.f, 0.f, 0.f};
        cur = nxt; cA = nA; cB = nB; ++ui;
        if (wr == 1) PG8_BAR;
    }
    PG8_WAIT_V(0);
    PG8_BAR;
#undef PG8_KOFF
#undef PG8_SA
#undef PG8_SB
#undef PG8_STAGE
#undef PG8_LDA
#undef PG8_LDB
#undef PG8_MMA
#undef PG8_WAIT_V
#undef PG8_WAIT_L
#undef PG8_BAR
#undef PG8_SCHED
}
}
using pg8::Unit;

DEV u32x4 pack8(f32x4 v0, f32x4 v1) { u32x4 w; w.x = cvt_pk_bf16(v0[0], v0[1]); w.y = cvt_pk_bf16(v0[2], v0[3]); w.z = cvt_pk_bf16(v1[0], v1[1]); w.w = cvt_pk_bf16(v1[2], v1[3]); return w; }

struct EpiIn {
    unsigned char* ws; int ro;
    DEV void operator()(const f32x4 (&acc)[2][2][4][2], const Unit& u, int wr, int wc, int fr, int fq) const {
        const int pn = u.pn; bf16_t* base; int pitch, colt, mode = 0; float sc = 1.f;
        if (pn < 8) { base = (bf16_t*)(ws + Z_Q); pitch = 2048; colt = pn * 256; sc = 0.08838834764831845f; }
        else if (pn < 20) { const int s = (pn - 8) >> 1; colt = ((pn - 8) & 1) * 256; pitch = 512; base = (bf16_t*)(ws + Z_KC + (size_t)s * SZ_KV); mode = (s == 3 || s == 5) ? 1 : 0; }
        else if (pn < 52) { const int s = (pn - 20) >> 3; colt = ((pn - 20) & 7) * 256; pitch = 2048; base = (bf16_t*)(ws + Z_LX + (size_t)s * SZ_ACT); }
        else { mode = 2; base = (bf16_t*)(ws + Z_GATE); pitch = 64; colt = 0; }
        const int row0 = ro + u.pm * 256 + wr * 64 + fr;
#pragma unroll
        for (int ai = 0; ai < 2; ++ai)
#pragma unroll
            for (int m = 0; m < 4; ++m) {
                const int row = row0 + ai * 128 + m * 16;
#pragma unroll
                for (int bj = 0; bj < 2; ++bj) {
                    const int col = colt + bj * 128 + wc * 32 + 8 * fq;
                    const f32x4 v0 = acc[ai][bj][m][0] * sc, v1 = acc[ai][bj][m][1] * sc;
                    const u32x4 w = pack8(v0, v1);
                    if (mode == 0) { *(u32x4*)(base + (size_t)row * pitch + col) = w; }
                    else if (mode == 1) {
                        const int b = row >> 11, t = row & 2047, gg = col >> 7, d = col & 127;
                        bf16_t* p = base + ((size_t)((b * 4 + gg) * 128 + d)) * 2048 + t;
                        p[0 * 2048] = (bf16_t)(w.x & 0xffff); p[1 * 2048] = (bf16_t)(w.x >> 16); p[2 * 2048] = (bf16_t)(w.y & 0xffff); p[3 * 2048] = (bf16_t)(w.y >> 16);
                        p[4 * 2048] = (bf16_t)(w.z & 0xffff); p[5 * 2048] = (bf16_t)(w.z >> 16); p[6 * 2048] = (bf16_t)(w.w & 0xffff); p[7 * 2048] = (bf16_t)(w.w >> 16);
                    } else { if (col < 48) *(u32x4*)(base + (size_t)row * 64 + col) = w; }
                }
            }
    }
};
template <int SECOND> struct EpiProj {
    const bf16_t* gate; bf16_t* O; int ro;
    DEV void operator()(const f32x4 (&acc)[2][2][4][2], const Unit& u, int wr, int wc, int fr, int fq) const {
        const int row0 = ro + u.pm * 256 + wr * 64 + fr, col0 = u.pn * 256 + wc * 32 + 8 * fq;
#pragma unroll
        for (int ai = 0; ai < 2; ++ai) {
            u32x4 gv[4][2], pv[4][2];
#pragma unroll
            for (int m = 0; m < 4; ++m)
#pragma unroll
                for (int bj = 0; bj < 2; ++bj) { const size_t off = (size_t)(row0 + ai * 128 + m * 16) * 2048 + col0 + bj * 128;
                    gv[m][bj] = *(const u32x4*)(gate + off); if (SECOND) pv[m][bj] = *(const u32x4*)(O + off); }
#pragma unroll
            for (int m = 0; m < 4; ++m)
#pragma unroll
                for (int bj = 0; bj < 2; ++bj) { const size_t off = (size_t)(row0 + ai * 128 + m * 16) * 2048 + col0 + bj * 128;
                    const u32x4 g = gv[m][bj];
                    f32x4 v0 = acc[ai][bj][m][0], v1 = acc[ai][bj][m][1];
                    v0[0] *= sigm(bflo(g.x)); v0[1] *= sigm(bfhi(g.x)); v0[2] *= sigm(bflo(g.y)); v0[3] *= sigm(bfhi(g.y));
                    v1[0] *= sigm(bflo(g.z)); v1[1] *= sigm(bfhi(g.z)); v1[2] *= sigm(bflo(g.w)); v1[3] *= sigm(bfhi(g.w));
                    if (SECOND) { const u32x4 p = pv[m][bj];
                        v0[0] += bflo(p.x); v0[1] += bfhi(p.x); v0[2] += bflo(p.y); v0[3] += bfhi(p.y);
                        v1[0] += bflo(p.z); v1[1] += bfhi(p.z); v1[2] += bflo(p.w); v1[3] += bfhi(p.w); }
                    *(u32x4*)(O + off) = pack8(v0, v1); }
        }
    }
};
struct EpiRes {
    const float* xin; float* xout; const float* gvec; int ro;
    DEV void operator()(const f32x4 (&acc)[2][2][4][2], const Unit& u, int wr, int wc, int fr, int fq) const {
        const int row0 = ro + u.pm * 256 + wr * 64 + fr, col0 = u.pn * 256 + wc * 32 + 8 * fq;
        const float* gb = gvec + (size_t)(row0 >> 11) * 12288;
        f32x4 g[2][2];
#pragma unroll
        for (int bj = 0; bj < 2; ++bj) { g[bj][0] = *(const f32x4*)(gb + col0 + bj * 128); g[bj][1] = *(const f32x4*)(gb + col0 + bj * 128 + 4); }
#pragma unroll
        for (int ai = 0; ai < 2; ++ai) {
            f32x4 xv[4][2][2];
#pragma unroll
            for (int m = 0; m < 4; ++m)
#pragma unroll
                for (int bj = 0; bj < 2; ++bj) { const size_t off = (size_t)(row0 + ai * 128 + m * 16) * 2048 + col0 + bj * 128;
                    xv[m][bj][0] = *(const f32x4*)(xin + off); xv[m][bj][1] = *(const f32x4*)(xin + off + 4); }
#pragma unroll
            for (int m = 0; m < 4; ++m)
#pragma unroll
                for (int bj = 0; bj < 2; ++bj) { const size_t off = (size_t)(row0 + ai * 128 + m * 16) * 2048 + col0 + bj * 128;
                    *(f32x4*)(xout + off) = xv[m][bj][0] + g[bj][0] * acc[ai][bj][m][0];
                    *(f32x4*)(xout + off + 4) = xv[m][bj][1] + g[bj][1] * acc[ai][bj][m][1]; }
        }
    }
};
struct EpiGlu {
    bf16_t* G; float* side; const float* cw; const float* cb; LAS unsigned char* xch; int ro;
    DEV void operator()(const f32x4 (&acc)[2][2][4][2], const Unit& u, int wr, int wc, int fr, int fq) const {
        const int lane = fq * 16 + fr, cc = wc * 32 + fq * 8, ch = u.pn * 128 + cc, pmg = (ro >> 8) + u.pm;
        f32x4 w0[2], w1[2], w2[2], bs[2];
#pragma unroll
        for (int n = 0; n < 2; ++n) { w0[n] = *(const f32x4*)(cw + ch + 4 * n); w1[n] = *(const f32x4*)(cw + DFF + ch + 4 * n); w2[n] = *(const f32x4*)(cw + 2 * DFF + ch + 4 * n); bs[n] = *(const f32x4*)(cb + ch + 4 * n); }
        LAS float* X = (LAS float*)xch;
        if (fr >= 14) {
#pragma unroll
            for (int ai = 0; ai < 2; ++ai)
#pragma unroll
                for (int n = 0; n < 2; ++n) *(LAS f32x4*)(X + ((ai * 2 + wr) * 2 + (fr - 14)) * 128 + cc + 4 * n) = acc[ai][0][3][n];
            if (wr == 1) {
#pragma unroll
                for (int n = 0; n < 2; ++n) *(f32x4*)(side + ((size_t)(pmg * 2 + (fr - 14))) * DFF + ch + 4 * n) = acc[1][0][3][n];
            }
        }
        if (wr == 0 && fr < 2) {
#pragma unroll
            for (int n = 0; n < 2; ++n) { *(f32x4*)(side + SIDE_ELEMS + ((size_t)(pmg * 2 + fr)) * DFF + ch + 4 * n) = acc[0][0][0][n];
                                          *(f32x4*)(side + 2 * SIDE_ELEMS + ((size_t)(pmg * 2 + fr)) * DFF + ch + 4 * n) = acc[0][1][0][n]; }
        }
        asm volatile("s_waitcnt lgkmcnt(0)" ::: "memory");
        __builtin_amdgcn_s_barrier();
        const int addr1 = ((fr == 0) ? lane + 15 : lane - 1) << 2, addr2 = ((fr < 2) ? lane + 14 : lane - 2) << 2;
        const int row0 = ro + u.pm * 256 + wr * 64 + fr;
#pragma unroll
        for (int ai = 0; ai < 2; ++ai) {
            f32x4 prev[2] = {(f32x4){0.f, 0.f, 0.f, 0.f}, (f32x4){0.f, 0.f, 0.f, 0.f}};
            if (!(ai == 0 && wr == 0) && fr >= 14) {
                const int pslot = ai * 2 + wr - 1;
#pragma unroll
                for (int n = 0; n < 2; ++n) prev[n] = *(const LAS f32x4*)(X + (pslot * 2 + (fr - 14)) * 128 + cc + 4 * n);
            }
#pragma unroll
            for (int m = 0; m < 4; ++m) {
                f32x4 outv[2];
#pragma unroll
                for (int n = 0; n < 2; ++n) {
                    const f32x4 cur = acc[ai][0][m][n], val = acc[ai][1][m][n];
#pragma unroll
                    for (int i = 0; i < 4; ++i) {
                        const float s1 = (fr == 15) ? prev[n][i] : cur[i], s2 = (fr >= 14) ? prev[n][i] : cur[i];
                        const float p1 = __builtin_bit_cast(float, __builtin_amdgcn_ds_bpermute(addr1, __builtin_bit_cast(int, s1)));
                        const float p2 = __builtin_bit_cast(float, __builtin_amdgcn_ds_bpermute(addr2, __builtin_bit_cast(int, s2)));
                        const float a = bs[n][i] + w0[n][i] * p2 + w1[n][i] * p1 + w2[n][i] * cur[i];
                        outv[n][i] = gelu_t(a) * val[i];
                    }
                    prev[n] = cur;
                }
                *(u32x4*)(G + (size_t)(ch >> 11) * (SZ_ACT / 2) + (size_t)(row0 + ai * 128 + m * 16) * 2048 + (ch & 2047)) = pack8(outv[0], outv[1]);
            }
        }
    }
};

DEV void phase_glufix(const Params& P, int l, int b, int lr, int nl) {
    const int tid = otid();
    bf16_t* G = (bf16_t*)(P.ws + Z_LX); const float* side = (const float*)(P.ws + WS_SIDE);
    const float* cw = INP(24) + (size_t)l * 3 * DFF; const float* cb = INP(25) + (size_t)l * DFF;
    for (int idx = lr * 512 + tid; idx < 7 * (DFF / 4); idx += nl * 512) {
        const int t7 = idx / (DFF / 4), c4 = (idx % (DFF / 4)) * 4, pm = b * 8 + t7 + 1;
        const f32x4 L0 = *(const f32x4*)(side + ((size_t)((pm - 1) * 2 + 0)) * DFF + c4), L1 = *(const f32x4*)(side + ((size_t)((pm - 1) * 2 + 1)) * DFF + c4);
        const f32x4 F0 = *(const f32x4*)(side + SIDE_ELEMS + ((size_t)(pm * 2 + 0)) * DFF + c4), F1 = *(const f32x4*)(side + SIDE_ELEMS + ((size_t)(pm * 2 + 1)) * DFF + c4);
        const f32x4 V0 = *(const f32x4*)(side + 2 * SIDE_ELEMS + ((size_t)(pm * 2 + 0)) * DFF + c4), V1 = *(const f32x4*)(side + 2 * SIDE_ELEMS + ((size_t)(pm * 2 + 1)) * DFF + c4);
        const f32x4 w0 = *(const f32x4*)(cw + c4), w1 = *(const f32x4*)(cw + DFF + c4), w2 = *(const f32x4*)(cw + 2 * DFF + c4), bs = *(const f32x4*)(cb + c4);
        const f32x4 a0 = bs + w0 * L0 + w1 * L1 + w2 * F0, a1 = bs + w0 * L1 + w1 * F0 + w2 * F1;
        u32x2 o0, o1;
        o0.x = cvt_pk_bf16(gelu_t(a0[0]) * V0[0], gelu_t(a0[1]) * V0[1]); o0.y = cvt_pk_bf16(gelu_t(a0[2]) * V0[2], gelu_t(a0[3]) * V0[3]);
        o1.x = cvt_pk_bf16(gelu_t(a1[0]) * V1[0], gelu_t(a1[1]) * V1[1]); o1.y = cvt_pk_bf16(gelu_t(a1[2]) * V1[2], gelu_t(a1[3]) * V1[3]);
        bf16_t* gp = G + (size_t)(c4 >> 11) * (SZ_ACT / 2) + (size_t)(pm * 256) * 2048 + (c4 & 2047);
        *(u32x2*)gp = o0;
        *(u32x2*)(gp + 2048) = o1;
    }
}

template <int MAP>
DEV void transpose_item(const float* W, int K, int N, bf16_t* WT, float* scr, int item, int nblk, int lane) {
    const int kb = item / nblk, nb = item % nblk, k0 = 64 * kb, n0 = 32 * nb;
    const int nsrc = MAP == 1 ? win_src(n0 + (lane & 31)) : (MAP == 2 ? up_src(n0 + (lane & 31)) : n0 + (lane & 31));
#pragma unroll 8
    for (int i = 0; i < 32; ++i) { const int kk = 2 * i + (lane >> 5); scr[kk * 33 + (lane & 31)] = nsrc >= 0 ? W[(size_t)(k0 + kk) * N + nsrc] : 0.f; }
    asm volatile("s_waitcnt lgkmcnt(0)" ::: "memory");
    const int c = lane & 7;
#pragma unroll
    for (int j = 0; j < 4; ++j) { const int n = (lane >> 3) + 8 * j; const float* s = scr + (8 * c) * 33 + n;
        u32x4 o; o.x = cvt_pk_bf16(s[0 * 33], s[1 * 33]); o.y = cvt_pk_bf16(s[2 * 33], s[3 * 33]); o.z = cvt_pk_bf16(s[4 * 33], s[5 * 33]); o.w = cvt_pk_bf16(s[6 * 33], s[7 * 33]);
        *(u32x4*)(WT + (size_t)(n0 + n) * K + k0 + 8 * c) = o; }
    asm volatile("s_waitcnt lgkmcnt(0)" ::: "memory");
}

DEV void phase_prep(const Params& P, unsigned char* lds) {
    const int tid = otid(), lane = tid & 63, wave = tid >> 6; const int bid = obid();
    float* scr = (float*)(lds + wave * 8448);
    const int gw = bid * 8 + wave, NGW = gridDim.x * 8;
    constexpr int I_IN = 32 * (NIN / 32), I_UP = 32 * 384, I_DN = 96 * 64, I_SQ = 32 * 64, I_W1 = 64 * 4, I_W2 = 2 * 4, I_LRU = 16 * 8;
    constexpr int PER_LAYER = I_IN + I_UP + I_DN + 3 * I_SQ + 2 * I_W1 + 2 * I_W2 + 2 * I_LRU;
    for (int it = gw; it < DEPTH * PER_LAYER; it += NGW) {
        const int l = it / PER_LAYER; int r = it % PER_LAYER;
        unsigned char* wl = P.ws + (size_t)l * LAYER_BYTES;
        if (r < I_IN) { transpose_item<1>(INP(5) + (size_t)l * 2048 * 13360, 2048, 13360, (bf16_t*)(wl + L_WIN), scr, r, NIN / 32, lane); continue; } r -= I_IN;
        if (r < I_UP) { transpose_item<2>(INP(23) + (size_t)l * 2048 * 12288, 2048, 12288, (bf16_t*)(wl + L_WUP), scr, r, 384, lane); continue; } r -= I_UP;
        if (r < I_DN) { transpose_item<0>(INP(26) + (size_t)l * 6144 * 2048, 6144, 2048, (bf16_t*)(wl + L_WDN), scr, r, 64, lane); continue; } r -= I_DN;
        if (r < I_SQ) { transpose_item<0>(INP(19) + (size_t)l * 2048 * 2048, 2048, 2048, (bf16_t*)(wl + L_PA), scr, r, 64, lane); continue; } r -= I_SQ;
        if (r < I_SQ) { transpose_item<0>(INP(20) + (size_t)l * 2048 * 2048, 2048, 2048, (bf16_t*)(wl + L_PB), scr, r, 64, lane); continue; } r -= I_SQ;
        if (r < I_SQ) { transpose_item<0>(INP(21) + (size_t)l * 2048 * 2048, 2048, 2048, (bf16_t*)(wl + L_WO), scr, r, 64, lane); continue; } r -= I_SQ;
        if (r < I_W1) { transpose_item<0>(INP(7) + (size_t)l * 4096 * 128, 4096, 128, (bf16_t*)(wl + L_W1K), scr, r, 4, lane); continue; } r -= I_W1;
        if (r < I_W1) { transpose_item<0>(INP(10) + (size_t)l * 4096 * 128, 4096, 128, (bf16_t*)(wl + L_W1V), scr, r, 4, lane); continue; } r -= I_W1;
        if (r < I_W2) { transpose_item<0>(INP(8) + (size_t)l * 128 * 128, 128, 128, (bf16_t*)(wl + L_W2K), scr, r, 4, lane); continue; } r -= I_W2;
        if (r < I_W2) { transpose_item<0>(INP(11) + (size_t)l * 128 * 128, 128, 128, (bf16_t*)(wl + L_W2V), scr, r, 4, lane); continue; } r -= I_W2;
        if (r < I_LRU) { const int mt = r >> 3; transpose_item<0>(INP(14) + (size_t)(l * 16 + mt) * 16384, 128, 128, (bf16_t*)(wl + L_WA) + mt * 16384, scr, r & 7, 4, lane); continue; } r -= I_LRU;
        { const int mt = r >> 3; transpose_item<0>(INP(16) + (size_t)(l * 16 + mt) * 16384, 128, 128, (bf16_t*)(wl + L_WI) + mt * 16384, scr, r & 7, 4, lane); }
    }
    __syncthreads();
    float* cact = (float*)(lds + 69632);
    float* red = (float*)lds;
    for (int i = tid; i < 8 * 2048; i += 512) { const int b = i >> 11, k = i & 2047; const float v = INP(1)[i]; cact[k * 8 + b] = v * sigm(v); }
    __syncthreads();
    for (int it = bid; it < DEPTH * 256; it += gridDim.x) {
        const int l = it / 256, n = (it % 256) * 48 + (lane < 48 ? lane : 47), kg = wave;
        const float* w = INP(2) + (size_t)l * 2048 * 12288 + (size_t)(kg * 256) * 12288 + n;
        float a[8];
#pragma unroll
        for (int b = 0; b < 8; ++b) a[b] = 0.f;
#pragma unroll 8
        for (int k = 0; k < 256; ++k) {
            const float wv = w[(size_t)k * 12288];
            const f32x4 c0 = *(const f32x4*)(cact + (kg * 256 + k) * 8), c1 = *(const f32x4*)(cact + (kg * 256 + k) * 8 + 4);
            a[0] += wv * c0[0]; a[1] += wv * c0[1]; a[2] += wv * c0[2]; a[3] += wv * c0[3];
            a[4] += wv * c1[0]; a[5] += wv * c1[1]; a[6] += wv * c1[2]; a[7] += wv * c1[3];
        }
#pragma unroll
        for (int b = 0; b < 8; ++b) red[(kg * 8 + b) * 64 + lane] = a[b];
        __syncthreads();
        { const int b = wave; float s = INP(3)[l * 12288 + n];
#pragma unroll
          for (int k2 = 0; k2 < 8; ++k2) s += red[(k2 * 8 + b) * 64 + lane];
          if (lane < 48) ((float*)(P.ws + (size_t)l * LAYER_BYTES + L_MOD))[b * 12288 + n] = s; }
        __syncthreads();
    }
}

template <int MODE>
DEV void phase_norm(const float* xin, const float* gvec, const float* mod, int seg_sh, int seg_sc, bf16_t* outb, float* outf, int bt, int lr, int nl) {
    const int tid_ = otid(); const int lane = tid_ & 63, wave = tid_ >> 6;
    const int gw = lr * 8 + wave, NGW = nl * 8;
    const int rpw = (2048 + NGW - 1) / NGW;
    int cb = -1; f32x4 sa[8], sb[8];
    for (int rl = gw * rpw; rl < (gw + 1) * rpw && rl < 2048; ++rl) {
        const int row = bt * 2048 + rl;
        const int b = row >> 11;
        if (b != cb) { cb = b;
#pragma unroll
            for (int j = 0; j < 8; ++j) { const int col = 4 * (lane + 64 * j); const f32x4 g = *(const f32x4*)(gvec + col);
                if (MODE == 0) { const f32x4 sc = *(const f32x4*)(mod + (size_t)b * 12288 + seg_sc * 2048 + col); sa[j] = g * (sc + 1.f); sb[j] = *(const f32x4*)(mod + (size_t)b * 12288 + seg_sh * 2048 + col); }
                else { sa[j] = g; } } }
        const f32x4* xr = (const f32x4*)(xin + (size_t)row * 2048) + lane;
        f32x4 v[8]; float s = 0.f;
#pragma unroll
        for (int j = 0; j < 8; ++j) { v[j] = xr[64 * j]; s += (v[j][0] * v[j][0] + v[j][1] * v[j][1]) + (v[j][2] * v[j][2] + v[j][3] * v[j][3]); }
        const float inv = 1.f / sqrtf(wave_sum(s, lane) * (1.f / 2048.f) + 1e-6f);
        if (MODE == 0) {
            u32x2* o = (u32x2*)(outb + (size_t)row * 2048) + lane;
#pragma unroll
            for (int j = 0; j < 8; ++j) { const f32x4 r = v[j] * inv * sa[j] + sb[j]; u32x2 w; w.x = cvt_pk_bf16(r[0], r[1]); w.y = cvt_pk_bf16(r[2], r[3]); o[64 * j] = w; }
        } else {
            f32x4* o = (f32x4*)(outf + (size_t)row * 2048) + lane;
#pragma unroll
            for (int j = 0; j < 8; ++j) o[64 * j] = v[j] * inv * sa[j];
        }
    }
}

DEV void cmp_item(const Params& P, int l, int item, unsigned char* lds) {
    const int tid = otid(), lane = tid & 63, w = tid >> 6, c = lane & 15, q = lane >> 4;
    const int kv = item >> 8, bg = (item >> 3) & 31, rt = item & 7, b = bg >> 2, g = bg & 3;
    unsigned char* wl = P.ws + (size_t)l * LAYER_BYTES;
    const bf16_t* src = (const bf16_t*)(P.ws + (kv ? Z_VC : Z_KC));
    const float* pos = INP(kv ? 9 : 6) + (size_t)l * 4096;
    const bf16_t* W1T = (const bf16_t*)(wl + (kv ? L_W1V : L_W1K));
    const bf16_t* W2T = (const bf16_t*)(wl + (kv ? L_W2V : L_W2K));
    const int n = rt * 16 + c; const bool valid = n < 127;
    const bf16_t* arow = src + ((size_t)(b * 2048 + 16 * (valid ? n : 0)) * 512 + g * 128);
    const bf16_t* brow = W1T + (size_t)c * 4096 + w * 512 + q * 8;
    f32x4 acc[8];
#pragma unroll
    for (int ct = 0; ct < 8; ++ct) acc[ct] = (f32x4){0.f, 0.f, 0.f, 0.f};
#pragma unroll 4
    for (int k2 = 0; k2 < 16; ++k2) {
        const int ks = w * 16 + k2, lp = ks >> 2, d = (ks & 3) * 32 + q * 8;
        const u32x4 a = *(const u32x4*)(arow + (size_t)lp * 512 + d);
        const f32x4 p0 = *(const f32x4*)(pos + ks * 32 + q * 8), p1 = *(const f32x4*)(pos + ks * 32 + q * 8 + 4);
        u32x4 bb[8];
#pragma unroll
        for (int ct = 0; ct < 8; ++ct) bb[ct] = *(const u32x4*)(brow + (size_t)ct * 16 * 4096 + k2 * 32);
        u32x4 a2;
        a2.x = cvt_pk_bf16(bflo(a.x) + p0[0], bfhi(a.x) + p0[1]); a2.y = cvt_pk_bf16(bflo(a.y) + p0[2], bfhi(a.y) + p0[3]);
        a2.z = cvt_pk_bf16(bflo(a.z) + p1[0], bfhi(a.z) + p1[1]); a2.w = cvt_pk_bf16(bflo(a.w) + p1[2], bfhi(a.w) + p1[3]);
        if (!valid) a2 = (u32x4){0u, 0u, 0u, 0u};
#pragma unroll
        for (int ct = 0; ct < 8; ++ct) acc[ct] = mfma16(as_bf16x8(a2), as_bf16x8(bb[ct]), acc[ct]);
    }
    float* part = (float*)(lds + 8192);
    bf16_t* hid = (bf16_t*)lds;
#pragma unroll
    for (int ct = 0; ct < 8; ++ct)
#pragma unroll
        for (int j = 0; j < 4; ++j) part[(w * 16 + q * 4 + j) * 128 + ct * 16 + c] = acc[ct][j];
    __syncthreads();
    {
        const int nn = tid >> 5, e4 = (tid & 31) * 4;
        f32x4 sum = *(const f32x4*)(part + nn * 128 + e4);
#pragma unroll
        for (int w2 = 1; w2 < 8; ++w2) sum = sum + *(const f32x4*)(part + (w2 * 16 + nn) * 128 + e4);
        u32x2 hv; hv.x = cvt_pk_bf16(gelu_t(sum[0]), gelu_t(sum[1])); hv.y = cvt_pk_bf16(gelu_t(sum[2]), gelu_t(sum[3]));
        *(u32x2*)(hid + nn * 136 + e4) = hv;
    }
    __syncthreads();
    f32x4 acc2 = {0.f, 0.f, 0.f, 0.f};
#pragma unroll
    for (int ks = 0; ks < 4; ++ks) {
        const u32x4 af = *(const u32x4*)(hid + c * 136 + ks * 32 + q * 8);
        const u32x4 bb = *(const u32x4*)(W2T + (size_t)(w * 16 + c) * 128 + ks * 32 + q * 8);
        acc2 = mfma16(as_bf16x8(af), as_bf16x8(bb), acc2);
    }
    if (kv == 0) { bf16_t* o = (bf16_t*)(P.ws + Z_KCMP) + ((size_t)bg * 128 + rt * 16 + q * 4) * 128 + w * 16 + c;
#pragma unroll
        for (int j = 0; j < 4; ++j) o[j * 128] = (bf16_t)(cvt_pk_bf16(acc2[j], 0.f) & 0xffff);
    } else { bf16_t* o = (bf16_t*)(P.ws + Z_VCMPT) + ((size_t)bg * 128 + w * 16 + c) * 128 + rt * 16 + q * 4;
        u32x2 wv; wv.x = cvt_pk_bf16(acc2[0], acc2[1]); wv.y = cvt_pk_bf16(acc2[2], acc2[3]); *(u32x2*)o = wv; }
    __syncthreads();
}

DEV void lru_item(const Params& P, int l, int item, unsigned char* lds) {
    const int tid = otid(), lane = tid & 63, w = tid >> 6, c = lane & 15, q = lane >> 4;
    const int b = item >> 5, n = (item >> 1) & 15, e = item & 1;
    const int C0 = n * 128, CO = C0 + e * 64;
    unsigned char* wl = P.ws + (size_t)l * LAYER_BYTES;
    constexpr int O_LX = 0, O_UB = 17408, O_UF = 34816, O_WA = 51200, O_WI = 68608, O_A = 86016, O_B = 102400;
    bf16_t* zlx = (bf16_t*)(P.ws + Z_LX); bf16_t* zly = (bf16_t*)(P.ws + Z_LY);
    __syncthreads();
    for (int id = tid; id < 2 * 64 * 16; id += 512) {
        const int which = id >> 10, r = (id >> 4) & 63, pc = id & 15;
        const bf16_t* s = (const bf16_t*)(wl + (which ? L_WI : L_WA)) + ((size_t)(n * 128 + e * 64 + r)) * 128 + pc * 8;
        *(u32x4*)(lds + (which ? O_WI : O_WA) + r * 272 + pc * 16) = *(const u32x4*)s;
    }
    const int chg = tid & 15, tl0 = tid >> 4;
    float cw[4][8], cbias[8];
#pragma unroll
    for (int i = 0; i < 8; ++i) { cbias[i] = INP(13)[l * 2048 + C0 + chg * 8 + i];
#pragma unroll
        for (int j = 0; j < 4; ++j) cw[j][i] = INP(12)[(l * 4 + j) * 2048 + C0 + chg * 8 + i]; }
    const int rt = w & 3, cp = w >> 2;
    float ba[2], bi[2], ll[2];
#pragma unroll
    for (int k2 = 0; k2 < 2; ++k2) { const int ch = l * 2048 + CO + (cp * 2 + k2) * 16 + c; ba[k2] = -1.4426950408889634f * INP(15)[ch]; bi[k2] = -1.4426950408889634f * INP(17)[ch];
        const float tl = 1.4426950408889634f * INP(18)[ch];
        ll[k2] = 8.f * (tl > 0.f ? -__builtin_amdgcn_logf(1.f + __builtin_amdgcn_exp2f(-tl)) : tl - __builtin_amdgcn_logf(1.f + __builtin_amdgcn_exp2f(tl))); }
    float* SEGA = (float*)(lds + 118784); float* SEGH = (float*)(lds + 120832); float* CARRY = (float*)(lds + 122880);
    if (tid < 64) CARRY[tid] = 0.f;
    float* UF = (float*)(lds + O_UF); float* Aa = (float*)(lds + O_A); float* Bb = (float*)(lds + O_B);
    const bf16_t* xcol = zlx + ((size_t)b * 2048) * 2048 + C0 + chg * 8;
    u32x4 xr[2][4];
#pragma unroll
    for (int p = 0; p < 2; ++p)
#pragma unroll
        for (int j = 0; j < 4; ++j) { const int t = tl0 + 32 * p + j - 3; xr[p][j] = (u32x4){0u, 0u, 0u, 0u}; if (t >= 0) xr[p][j] = *(const u32x4*)(xcol + (size_t)t * 2048); }
    u32x4 lyr = {0u, 0u, 0u, 0u}; bf16_t* lyp = zly;
    auto output = [&]() __attribute__((always_inline)) {
        const int tl = tid >> 3, c8 = (tid & 7) * 8;
        const u32x4 y = lyr;
        const f32x4 h0 = *(const f32x4*)(Bb + tl * 64 + c8), h1 = *(const f32x4*)(Bb + tl * 64 + c8 + 4);
        u32x4 o;
        o.x = cvt_pk_bf16(gelu_t(bflo(y.x)) * h0[0], gelu_t(bfhi(y.x)) * h0[1]); o.y = cvt_pk_bf16(gelu_t(bflo(y.y)) * h0[2], gelu_t(bfhi(y.y)) * h0[3]);
        o.z = cvt_pk_bf16(gelu_t(bflo(y.z)) * h1[0], gelu_t(bfhi(y.z)) * h1[1]); o.w = cvt_pk_bf16(gelu_t(bflo(y.w)) * h1[2], gelu_t(bfhi(y.w)) * h1[3]);
        *(u32x4*)lyp = o;
    };
    __syncthreads();
    bf16x8 wfa[4][2], wfi[4][2];
#pragma unroll
    for (int ks = 0; ks < 4; ++ks)
#pragma unroll
        for (int k2 = 0; k2 < 2; ++k2) { const int ct = cp * 2 + k2;
            wfa[ks][k2] = *(const bf16x8*)(lds + O_WA + (ct * 16 + c) * 272 + ks * 64 + q * 16);
            wfi[ks][k2] = *(const bf16x8*)(lds + O_WI + (ct * 16 + c) * 272 + ks * 64 + q * 16); }
    for (int ci = 0; ci < 32; ++ci) {
        const int t0 = ci * 64;
        if (ci > 0) output();
        lyp = zly + ((size_t)(b * 2048 + t0 + (tid >> 3))) * 2048 + CO + (tid & 7) * 8;
        lyr = *(const u32x4*)lyp;
#pragma unroll
        for (int pass = 0; pass < 2; ++pass) {
            const int tl = tl0 + 32 * pass;
            float u[8];
#pragma unroll
            for (int i = 0; i < 8; ++i) u[i] = cbias[i];
#pragma unroll
            for (int j = 0; j < 4; ++j) {
                const u32x4 x = xr[pass][j];
                u[0] += cw[j][0] * bflo(x.x); u[1] += cw[j][1] * bfhi(x.x); u[2] += cw[j][2] * bflo(x.y); u[3] += cw[j][3] * bfhi(x.y);
                u[4] += cw[j][4] * bflo(x.z); u[5] += cw[j][5] * bfhi(x.z); u[6] += cw[j][6] * bflo(x.w); u[7] += cw[j][7] * bfhi(x.w);
            }
            u32x4 pk; pk.x = cvt_pk_bf16(u[0], u[1]); pk.y = cvt_pk_bf16(u[2], u[3]); pk.z = cvt_pk_bf16(u[4], u[5]); pk.w = cvt_pk_bf16(u[6], u[7]);
            *(u32x4*)(lds + O_UB + tl * 272 + chg * 16) = pk;
            if ((chg >> 3) == e) { float* uf = UF + tl * 64 + (chg & 7) * 8;
                *(f32x4*)uf = (f32x4){u[0], u[1], u[2], u[3]}; *(f32x4*)(uf + 4) = (f32x4){u[4], u[5], u[6], u[7]}; }
        }
        if (ci + 1 < 32) {
#pragma unroll
            for (int p = 0; p < 2; ++p)
#pragma unroll
                for (int j = 0; j < 4; ++j) xr[p][j] = *(const u32x4*)(xcol + (size_t)(t0 + 64 + tl0 + 32 * p + j - 3) * 2048);
        }
        __syncthreads();
        {
            f32x4 ar[2], ai[2];
#pragma unroll
            for (int k2 = 0; k2 < 2; ++k2) { ar[k2] = (f32x4){0.f, 0.f, 0.f, 0.f}; ai[k2] = (f32x4){0.f, 0.f, 0.f, 0.f}; }
#pragma unroll
            for (int ks = 0; ks < 4; ++ks) {
                const bf16x8 af = *(const bf16x8*)(lds + O_UB + (rt * 16 + c) * 272 + ks * 64 + q * 16);
#pragma unroll
                for (int k2 = 0; k2 < 2; ++k2) { ar[k2] = mfma16(af, wfa[ks][k2], ar[k2]); ai[k2] = mfma16(af, wfi[ks][k2], ai[k2]); }
            }
#pragma unroll
            for (int k2 = 0; k2 < 2; ++k2)
#pragma unroll
                for (int j = 0; j < 4; ++j) {
                    const int tl = rt * 16 + q * 4 + j, cc = (cp * 2 + k2) * 16 + c;
                    const float uu = UF[tl * 64 + cc];
                    const float r = frcp(1.f + __builtin_amdgcn_exp2f(__builtin_fmaf(ar[k2][j], -1.4426950408889634f, ba[k2])));
                    const float ig = frcp(1.f + __builtin_amdgcn_exp2f(__builtin_fmaf(ai[k2][j], -1.4426950408889634f, bi[k2])));
                    const float av = __builtin_amdgcn_exp2f(r * ll[k2]);
                    const float om = __builtin_fmaf(-av, av, 1.f);
                    Aa[tl * 64 + cc] = av;
                    Bb[tl * 64 + cc] = __builtin_amdgcn_sqrtf(fmaxf(om, 0.f)) * (ig * uu);
                }
        }
        __syncthreads();
        {
            float av8[8], hl[8]; float Acum = 1.f, h = 0.f;
#pragma unroll
            for (int k = 0; k < 8; ++k) { const float a = Aa[(w * 8 + k) * 64 + lane], bb2 = Bb[(w * 8 + k) * 64 + lane]; h = a * h + bb2; Acum *= a; av8[k] = Acum; hl[k] = h; }
            SEGA[w * 64 + lane] = Acum; SEGH[w * 64 + lane] = h;
            __syncthreads();
            float hin = CARRY[(ci & 1) * 64 + lane];
            float sa7[7], sh7[7];
#pragma unroll
            for (int s2 = 0; s2 < 7; ++s2) { sa7[s2] = SEGA[s2 * 64 + lane]; sh7[s2] = SEGH[s2 * 64 + lane]; }
#pragma unroll
            for (int s2 = 0; s2 < 7; ++s2) if (s2 < w) hin = sa7[s2] * hin + sh7[s2];
#pragma unroll
            for (int k = 0; k < 8; ++k) { hl[k] = hl[k] + av8[k] * hin; Bb[(w * 8 + k) * 64 + lane] = hl[k]; }
            if (w == 7) CARRY[((ci + 1) & 1) * 64 + lane] = hl[7];
        }
        __syncthreads();
    }
    output();
    __syncthreads();
}

constexpr int A_KC = 0, A_VC = 34816, A_K = 0, A_V = 17408, A_E = 69632, A_CAR = 102400, A_IMP = 118784, A_SEL = 142336, A_OST = 71680;
constexpr float L2E = 1.4426950408889634f;

DEV void attn_item(const Params& P, int b, int g, int qt, unsigned char* lds) {
    const int tid = otid(), lane = tid & 63, w = tid >> 6, c = lane & 15, q = lane >> 4;
    const int hg = w >> 1, th = w & 1, head = g * 4 + hg, bg = b * 4 + g;
    const int tq0 = 64 * qt + 32 * th;
    const size_t rowbase = (size_t)b * 2048;
    bf16_t* zq = (bf16_t*)(P.ws + Z_Q);
    bf16_t* zo = PROBE_CHECK ? (bf16_t*)(P.ws + WS_OBUF) : zq;

    bf16x8 QF[2][4];
#pragma unroll
    for (int nt = 0; nt < 2; ++nt)
#pragma unroll
        for (int ks = 0; ks < 4; ++ks) QF[nt][ks] = *(const bf16x8*)(zq + (rowbase + tq0 + 16 * nt + c) * 2048 + head * 128 + ks * 32 + q * 8);
    float gate[3][2];
#pragma unroll
    for (int nt = 0; nt < 2; ++nt)
#pragma unroll
        for (int br = 0; br < 3; ++br) { const unsigned short gv = ((const bf16_t*)(P.ws + Z_GATE))[(rowbase + tq0 + 16 * nt + c) * 64 + head * 3 + br]; gate[br][nt] = sigm(bflo((unsigned)gv)); }

    __syncthreads();
    {
        const bf16_t* kc = (const bf16_t*)(P.ws + Z_KCMP) + (size_t)bg * 16384; const bf16_t* vc = (const bf16_t*)(P.ws + Z_VCMPT) + (size_t)bg * 16384;
#pragma unroll
        for (int i = 0; i < 4; ++i) { const int id = tid + 512 * i, r = id >> 4, pc = id & 15;
            { const int kk = r & 31, rho = (r & ~31) + ((kk >> 2) & 1) * 16 + (kk >> 3) * 4 + (kk & 3);
              *(u32x4*)(lds + A_KC + rho * 272 + pc * 16) = *(const u32x4*)(kc + r * 128 + pc * 8); }
            *(u32x4*)(lds + A_VC + r * 272 + pc * 16) = *(const u32x4*)(vc + r * 128 + pc * 8); }
    }
    __syncthreads();

    f32x4 o[8][2];
#pragma unroll
    for (int dt = 0; dt < 8; ++dt)
#pragma unroll
        for (int nt = 0; nt < 2; ++nt) o[dt][nt] = (f32x4){0.f, 0.f, 0.f, 0.f};
    {
        f32x4 s[4][2][2];
#pragma unroll
        for (int ch = 0; ch < 4; ++ch)
#pragma unroll
            for (int u = 0; u < 2; ++u)
#pragma unroll
                for (int nt = 0; nt < 2; ++nt) s[ch][u][nt] = (f32x4){0.f, 0.f, 0.f, 0.f};
        const int nch = (4 * qt + 2) / 32 + 1;
#pragma unroll
        for (int ch = 0; ch < 4; ++ch) if (ch < nch) {
#pragma unroll
            for (int ks = 0; ks < 4; ++ks)
#pragma unroll
                for (int u = 0; u < 2; ++u) {
                    const bf16x8 kf = *(const bf16x8*)(lds + A_KC + (ch * 32 + u * 16 + c) * 272 + ks * 64 + q * 16);
#pragma unroll
                    for (int nt = 0; nt < 2; ++nt) s[ch][u][nt] = mfma16(kf, QF[nt][ks], s[ch][u][nt]);
                }
        }
        float* E = (float*)(lds + A_E); float* CAR = (float*)(lds + A_CAR);
#pragma unroll
        for (int nt = 0; nt < 2; ++nt) {
            const int t = tq0 + 16 * nt + c, nmax = (t - 31) >> 4;
            float mx = -1e30f;
#pragma unroll
            for (int ch = 0; ch < 4; ++ch)
#pragma unroll
                for (int u = 0; u < 2; ++u)
#pragma unroll
                    for (int j = 0; j < 4; ++j) { const int n = ch * 32 + q * 8 + u * 4 + j; const float v = s[ch][u][nt][j] * L2E; s[ch][u][nt][j] = v; if (n <= nmax) mx = fmaxf(mx, v); }
            mx = fmaxf(mx, shx(mx, 16, lane)); mx = fmaxf(mx, shx(mx, 32, lane));
            float sum = 0.f;
#pragma unroll
            for (int ch = 0; ch < 4; ++ch)
#pragma unroll
                for (int u = 0; u < 2; ++u)
#pragma unroll
                    for (int j = 0; j < 4; ++j) { const int n = ch * 32 + q * 8 + u * 4 + j; const float p = (n <= nmax) ? __builtin_amdgcn_exp2f(s[ch][u][nt][j] - mx) : 0.f; s[ch][u][nt][j] = p; sum += p; }
            sum += shx(sum, 16, lane); sum += shx(sum, 32, lane);
            const float inv = frcp(fmaxf(sum, 1e-30f));
            const int tl = 32 * th + 16 * nt + c;
#pragma unroll
            for (int ch = 0; ch < 4; ++ch) {
#pragma unroll
                for (int u = 0; u < 2; ++u) s[ch][u][nt] = s[ch][u][nt] * inv;
                const f32x4 pa = s[ch][0][nt], pb = s[ch][1][nt];
                E[(hg * 64 + tl) * 32 + 8 * ch + 2 * q] = (pa[0] + pa[1]) + (pa[2] + pa[3]);
                E[(hg * 64 + tl) * 32 + 8 * ch + 2 * q + 1] = pa[3] + ((pb[0] + pb[1]) + (pb[2] + pb[3]));
                CAR[(hg * 64 + tl) * 16 + 4 * ch + q] = pb[3];
            }
        }
#pragma unroll
        for (int ch = 0; ch < 4; ++ch) if (ch < nch) {
            bf16x8 pf[2];
#pragma unroll
            for (int nt = 0; nt < 2; ++nt) pf[nt] = as_bf16x8(pack8(s[ch][0][nt], s[ch][1][nt]));
#pragma unroll
            for (int dt = 0; dt < 8; ++dt) {
                const bf16x8 vf = *(const bf16x8*)(lds + A_VC + (dt * 16 + c) * 272 + (ch * 32 + q * 8) * 2);
#pragma unroll
                for (int nt = 0; nt < 2; ++nt) o[dt][nt] = mfma16(vf, pf[nt], o[dt][nt]);
            }
        }
    }
    u32x4 pk[2], pv[2];
#pragma unroll
    for (int i = 0; i < 2; ++i) { const int id = tid + 512 * i;
        pk[i] = *(const u32x4*)((const bf16_t*)(P.ws + Z_KS) + (rowbase + 64 * qt + (id >> 4)) * 512 + g * 128 + (id & 15) * 8);
        pv[i] = *(const u32x4*)((const bf16_t*)(P.ws + Z_VST) + ((size_t)bg * 128 + (id >> 3)) * 2048 + 64 * qt + (id & 7) * 8); }
    __syncthreads();
    {
        const float* E = (const float*)(lds + A_E); const float* CAR = (const float*)(lds + A_CAR); float* IMP = (float*)(lds + A_IMP);
        const int tl = tid >> 3, jg = tid & 7;
#pragma unroll
        for (int jj = 0; jj < 4; ++jj) { const int j = jg * 4 + jj; float v = 0.f;
#pragma unroll
            for (int h = 0; h < 4; ++h) { v += E[(h * 64 + tl) * 32 + j]; if ((j & 1) == 0 && j >= 2) v += CAR[(h * 64 + tl) * 16 + (j >> 1) - 1]; }
            IMP[tl * 32 + j] = v; }
        __syncthreads();
        const int cur = qt, nforced = cur >= 2 ? 3 : cur + 1;
        unsigned bits = 0u;
        const f32x4 v4 = *(const f32x4*)(IMP + tl * 32 + jg * 4);
        int cnt[4] = {0, 0, 0, 0};
#pragma unroll 4
        for (int j2 = 1; j2 <= cur - 2; ++j2) { const float v2 = IMP[tl * 32 + j2];
#pragma unroll
            for (int jj = 0; jj < 4; ++jj) cnt[jj] += (v2 > v4[jj] || (v2 == v4[jj] && j2 < jg * 4 + jj)) ? 1 : 0; }
#pragma unroll
        for (int jj = 0; jj < 4; ++jj) { const int j = jg * 4 + jj; bool sel;
            if (j > cur) sel = false;
            else if (j == 0 || j > cur - 2) sel = true;
            else sel = cnt[jj] < 16 - nforced;
            bits |= sel ? (1u << j) : 0u; }
        bits |= shxu(bits, 1, lane); bits |= shxu(bits, 2, lane); bits |= shxu(bits, 4, lane);
        if (jg == 0) ((unsigned*)(lds + A_SEL))[tl] = bits;
    }
    __syncthreads();
    unsigned selm[2];
#pragma unroll
    for (int nt = 0; nt < 2; ++nt) selm[nt] = ((const unsigned*)(lds + A_SEL))[32 * th + 16 * nt + c];
    unsigned char* ost = lds + A_OST + w * 8704;
#pragma unroll
    for (int nt = 0; nt < 2; ++nt)
#pragma unroll
        for (int dt = 0; dt < 8; ++dt) {
            const f32x4 r = o[dt][nt] * gate[0][nt];
            u32x2 wv; wv.x = cvt_pk_bf16(r[0], r[1]); wv.y = cvt_pk_bf16(r[2], r[3]);
            *(u32x2*)(ost + (16 * nt + c) * 272 + (16 * dt + 4 * q) * 2) = wv;
        }

    constexpr int KVB = 35840;
#pragma unroll 1
    for (int br = 0; br < 2; ++br) {
        const bf16_t* Ks = (const bf16_t*)(P.ws + (br ? Z_KW : Z_KS)); const bf16_t* Vs = (const bf16_t*)(P.ws + (br ? Z_VWT : Z_VST));
        const int ntile = br ? (qt + 1 < 9 ? qt + 1 : 9) : qt + 1;
        unsigned sm[2]; int lo[2], tq[2];
#pragma unroll
        for (int nt = 0; nt < 2; ++nt) { tq[nt] = tq0 + 16 * nt + c; sm[nt] = br ? 0xffffffffu : selm[nt]; lo[nt] = br ? tq[nt] - 511 : -1; }
        float mrow[2] = {-1e30f, -1e30f}, lrow[2] = {0.f, 0.f};
#pragma unroll
        for (int dt = 0; dt < 8; ++dt)
#pragma unroll
            for (int nt = 0; nt < 2; ++nt) o[dt][nt] = (f32x4){0.f, 0.f, 0.f, 0.f};
        auto tile_of = [&](int i) { return br ? qt - i : (i == 0 ? qt : i - 1); };
        auto prefetch = [&](int j) {
#pragma unroll
            for (int i = 0; i < 2; ++i) { const int id = tid + 512 * i;
                pk[i] = *(const u32x4*)(Ks + (rowbase + 64 * j + (id >> 4)) * 512 + g * 128 + (id & 15) * 8);
                pv[i] = *(const u32x4*)(Vs + ((size_t)bg * 128 + (id >> 3)) * 2048 + 64 * j + (id & 7) * 8); }
        };
        auto stage = [&](int buf) {
#pragma unroll
            for (int i2 = 0; i2 < 2; ++i2) { const int id = tid + 512 * i2, r = id >> 4, kk = r & 31, rho = (r & ~31) + ((kk >> 2) & 1) * 16 + (kk >> 3) * 4 + (kk & 3);
                *(u32x4*)(lds + buf * KVB + rho * 272 + (id & 15) * 16) = pk[i2];
                *(u32x4*)(lds + buf * KVB + 17408 + (id >> 3) * 144 + (id & 7) * 16) = pv[i2]; }
        };
        __syncthreads();
        stage(0);
        if (ntile > 1) prefetch(tile_of(1));
        __syncthreads();
#pragma unroll 1
        for (int i = 0; i < ntile; ++i) {
            const int j = tile_of(i);
            const unsigned char* kb = lds + (i & 1) * KVB; const unsigned char* vb = kb + 17408;
            f32x4 s[2][2][2];
#pragma unroll
            for (int ch = 0; ch < 2; ++ch)
#pragma unroll
                for (int u = 0; u < 2; ++u)
#pragma unroll
                    for (int nt = 0; nt < 2; ++nt) s[ch][u][nt] = (f32x4){0.f, 0.f, 0.f, 0.f};
            {
                const unsigned char* kp = kb + c * 272 + q * 16;
#define KFRAG(f) (*(const bf16x8*)(kp + (((f) >> 3) * 32 + ((f) & 1) * 16) * 272 + (((f) >> 1) & 3) * 64))
                bf16x8 kfa = KFRAG(0), kfb = KFRAG(1);
                __builtin_amdgcn_sched_barrier(0);
#pragma unroll
                for (int f = 0; f < 16; ++f) {
                    const int ch = f >> 3, ks = (f >> 1) & 3, u = f & 1;
                    const bf16x8 kf = (f & 1) ? kfb : kfa;
#pragma unroll
                    for (int nt = 0; nt < 2; ++nt) s[ch][u][nt] = mfma16(kf, QF[nt][ks], s[ch][u][nt]);
                    if (f + 2 < 16) { if (f & 1) kfb = KFRAG(f + 2); else kfa = KFRAG(f + 2); }
                    __builtin_amdgcn_sched_barrier(0);
                }
#undef KFRAG
            }
            const bool needkey = (j == qt) || (br && j == qt - 8);
            const bool sel0 = (sm[0] >> j) & 1u, sel1 = (sm[1] >> j) & 1u;
            const bool allsel = __builtin_amdgcn_ballot_w64(!(sel0 && sel1)) == 0ull;
            if (needkey) {
#pragma unroll
                for (int nt = 0; nt < 2; ++nt) { const bool sl = nt ? sel1 : sel0;
#pragma unroll
                    for (int ch = 0; ch < 2; ++ch)
#pragma unroll
                        for (int u = 0; u < 2; ++u)
#pragma unroll
                            for (int jj = 0; jj < 4; ++jj) { const int key = 64 * j + ch * 32 + q * 8 + u * 4 + jj;
                                const bool ok = sl && key <= tq[nt] && key >= lo[nt]; s[ch][u][nt][jj] = ok ? s[ch][u][nt][jj] : -1e30f; } }
            } else if (!allsel) {
#pragma unroll
                for (int nt = 0; nt < 2; ++nt) { const bool sl = nt ? sel1 : sel0;
#pragma unroll
                    for (int ch = 0; ch < 2; ++ch)
#pragma unroll
                        for (int u = 0; u < 2; ++u)
#pragma unroll
                            for (int jj = 0; jj < 4; ++jj) s[ch][u][nt][jj] = sl ? s[ch][u][nt][jj] : -1e30f; }
            }
            float mnew[2];
#pragma unroll
            for (int nt = 0; nt < 2; ++nt) {
                float mx = -1e30f;
#pragma unroll
                for (int ch = 0; ch < 2; ++ch)
#pragma unroll
                    for (int u = 0; u < 2; ++u) mx = fmaxf(fmaxf(mx, fmaxf(s[ch][u][nt][0], s[ch][u][nt][1])), fmaxf(s[ch][u][nt][2], s[ch][u][nt][3]));
                mx = fmaxf(mx, shx(mx, 16, lane)); mx = fmaxf(mx, shx(mx, 32, lane));
                mnew[nt] = fmaxf(mrow[nt], mx * L2E);
            }
            if (__builtin_amdgcn_ballot_w64(mnew[0] > mrow[0] + 8.f || mnew[1] > mrow[1] + 8.f) != 0ull) {
#pragma unroll
                for (int nt = 0; nt < 2; ++nt) { const float alpha = __builtin_amdgcn_exp2f(mrow[nt] - mnew[nt]); mrow[nt] = mnew[nt]; lrow[nt] *= alpha;
#pragma unroll
                    for (int dt = 0; dt < 8; ++dt) o[dt][nt] = o[dt][nt] * alpha; }
            }
#pragma unroll
            for (int nt = 0; nt < 2; ++nt) {
                const float nm = -mrow[nt]; float ps = 0.f;
#pragma unroll
                for (int ch = 0; ch < 2; ++ch)
#pragma unroll
                    for (int u = 0; u < 2; ++u)
#pragma unroll
                        for (int jj = 0; jj < 4; ++jj) { const float p = __builtin_amdgcn_exp2f(__builtin_fmaf(s[ch][u][nt][jj], L2E, nm)); s[ch][u][nt][jj] = p; ps += p; }
                lrow[nt] += ps;
            }
            {
                bf16x8 pf[2][2];
#pragma unroll
                for (int ch = 0; ch < 2; ++ch)
#pragma unroll
                    for (int nt = 0; nt < 2; ++nt) pf[ch][nt] = as_bf16x8(pack8(s[ch][0][nt], s[ch][1][nt]));
                const unsigned char* vp = vb + c * 144 + q * 16;
#define VFRAG(f) (*(const bf16x8*)(vp + ((f) & 7) * 16 * 144 + ((f) >> 3) * 64))
                bf16x8 vfa = VFRAG(0), vfb = VFRAG(1);
                __builtin_amdgcn_sched_barrier(0);
#pragma unroll
                for (int f = 0; f < 16; ++f) {
                    const int ch = f >> 3, dt = f & 7;
                    const bf16x8 vf = (f & 1) ? vfb : vfa;
#pragma unroll
                    for (int nt = 0; nt < 2; ++nt) o[dt][nt] = mfma16(vf, pf[ch][nt], o[dt][nt]);
                    if (f + 2 < 16) { if (f & 1) vfb = VFRAG(f + 2); else vfa = VFRAG(f + 2); }
                    __builtin_amdgcn_sched_barrier(0);
                }
#undef VFRAG
            }
            if (i + 1 < ntile) { stage((i + 1) & 1); if (i + 2 < ntile) prefetch(tile_of(i + 2)); }
            __syncthreads();
        }
        if (br == 0) {
#pragma unroll
            for (int i = 0; i < 2; ++i) { const int id = tid + 512 * i;
                pk[i] = *(const u32x4*)((const bf16_t*)(P.ws + Z_KW) + (rowbase + 64 * qt + (id >> 4)) * 512 + g * 128 + (id & 15) * 8);
                pv[i] = *(const u32x4*)((const bf16_t*)(P.ws + Z_VWT) + ((size_t)bg * 128 + (id >> 3)) * 2048 + 64 * qt + (id & 7) * 8); }
        }
#pragma unroll
        for (int nt = 0; nt < 2; ++nt) {
            float lsum = lrow[nt]; lsum += shx(lsum, 16, lane); lsum += shx(lsum, 32, lane);
            const float sc = gate[1 + br][nt] * frcp(fmaxf(lsum, 1e-30f));
#pragma unroll
            for (int dt = 0; dt < 8; ++dt) {
                u32x2* p = (u32x2*)(ost + (16 * nt + c) * 272 + (16 * dt + 4 * q) * 2);
                const u32x2 pv2 = *p; const f32x4 r = o[dt][nt] * sc;
                u32x2 wv; wv.x = cvt_pk_bf16(bflo(pv2.x) + r[0], bfhi(pv2.x) + r[1]); wv.y = cvt_pk_bf16(bflo(pv2.y) + r[2], bfhi(pv2.y) + r[3]);
                *p = wv;
            }
        }
    }
#pragma unroll
    for (int i = 0; i < 8; ++i) { const int r = (lane >> 4) + 4 * i, ck = lane & 15;
        *(u32x4*)(zo + (rowbase + tq0 + r) * 2048 + head * 128 + ck * 8) = *(const u32x4*)(ost + r * 272 + ck * 16); }
}

#if PROBE_CHECK
DEV float bfv(const bf16_t* p) { return __builtin_bit_cast(float, (unsigned)(*p) << 16); }
DEV void nsa_check(const Params& P, unsigned char* lds) {
    const int tid = otid(), bid = obid();
    const int b = bid & 7, g = (bid >> 3) & 3, t = (bid * 677 + 331) & 2047, bg = b * 4 + g, cur = t >> 6;
    const int h = tid >> 7, d = tid & 127;
    float* qs = (float*)lds;
    float* sc = (float*)(lds + 2048);
    float* impv = (float*)(lds + 2048 + 32768);
    unsigned* selw = (unsigned*)(lds + 2048 + 32768 + 128);
    float* red = (float*)(lds + 2048 + 32768 + 256);
    const bf16_t* zq = (const bf16_t*)(P.ws + Z_Q);
    const size_t row = (size_t)b * 2048 + t;
    __syncthreads();
    qs[h * 128 + d] = bfv(zq + row * 2048 + (g * 4 + h) * 128 + d);
    __syncthreads();
    const int nvis = t >= 31 ? ((t - 31) >> 4) + 1 : 0;
    { const int n = d; float s = -INFINITY;
      if (n < nvis) { s = 0.f; const bf16_t* kr = (const bf16_t*)(P.ws + Z_KCMP) + ((size_t)bg * 128 + n) * 128; for (int k = 0; k < 128; ++k) s += qs[h * 128 + k] * bfv(kr + k); }
      sc[h * 2048 + n] = s; }
    __syncthreads();
    if (tid < 4) { float m = -INFINITY; for (int n = 0; n < 128; ++n) m = fmaxf(m, sc[tid * 2048 + n]); if (!(m > -INFINITY)) m = 0.f;
        float sum = 0.f; for (int n = 0; n < 128; ++n) { const float p = __expf(sc[tid * 2048 + n] - m); sc[tid * 2048 + n] = p; sum += p; }
        const float inv = 1.f / fmaxf(sum, 1e-30f); for (int n = 0; n < 128; ++n) sc[tid * 2048 + n] *= inv; }
    __syncthreads();
    float o_cmp = 0.f;
    { const bf16_t* vr = (const bf16_t*)(P.ws + Z_VCMPT) + ((size_t)bg * 128 + d) * 128; for (int n = 0; n < 127; ++n) o_cmp += sc[h * 2048 + n] * bfv(vr + n); }
    if (tid < 32) { float v = 0.f; for (int hh = 0; hh < 4; ++hh) for (int n = 4 * tid - 1; n <= 4 * tid + 3; ++n) if (n >= 0 && n <= 126) v += sc[hh * 2048 + n]; impv[tid] = v; }
    __syncthreads();
    if (tid == 0) {
        unsigned mask = 0u;
        for (int pick = 0; pick < 16; ++pick) { int best = -1; float bv = 0.f;
            for (int j = 0; j < 32; ++j) { if ((mask >> j) & 1u) continue;
                const bool valid = j <= cur, forced = (j == 0) || (valid && j > cur - 2);
                const float v = forced ? impv[j] + 1e4f : (valid ? impv[j] : -1.f);
                if (best < 0 || v > bv) { best = j; bv = v; } }
            mask |= 1u << best; }
        selw[0] = mask; }
    __syncthreads();
    const unsigned selmask = selw[0];
    float o_br[2];
    for (int br = 0; br < 2; ++br) {
        const bf16_t* Ks = (const bf16_t*)(P.ws + (br ? Z_KW : Z_KS)); const bf16_t* Vs = (const bf16_t*)(P.ws + (br ? Z_VWT : Z_VST));
        __syncthreads();
        for (int cidx = 0; cidx < 16; ++cidx) { const int key = cidx * 128 + d; float s = -INFINITY;
            const bool ok = br ? (key <= t && key > t - 512) : (key <= t && ((selmask >> (key >> 6)) & 1u));
            if (ok) { s = 0.f; const bf16_t* kr = Ks + ((size_t)b * 2048 + key) * 512 + g * 128; for (int k = 0; k < 128; ++k) s += qs[h * 128 + k] * bfv(kr + k); }
            sc[h * 2048 + key] = s; }
        __syncthreads();
        if (tid < 4) { float m = -INFINITY; for (int n = 0; n < 2048; ++n) m = fmaxf(m, sc[tid * 2048 + n]); if (!(m > -INFINITY)) m = 0.f;
            float sum = 0.f; for (int n = 0; n < 2048; ++n) { const float p = __expf(sc[tid * 2048 + n] - m); sc[tid * 2048 + n] = p; sum += p; }
            const float inv = 1.f / fmaxf(sum, 1e-30f); for (int n = 0; n < 2048; ++n) sc[tid * 2048 + n] *= inv; }
        __syncthreads();
        float acc = 0.f; const bf16_t* vr = Vs + ((size_t)bg * 128 + d) * 2048;
        for (int key = 0; key <= t; ++key) acc += sc[h * 2048 + key] * bfv(vr + key);
        o_br[br] = acc;
    }
    const bf16_t* gz = (const bf16_t*)(P.ws + Z_GATE) + row * 64 + (g * 4 + h) * 3;
    const float g0 = 1.f / (1.f + __expf(-bfv(gz))), g1 = 1.f / (1.f + __expf(-bfv(gz + 1))), g2 = 1.f / (1.f + __expf(-bfv(gz + 2)));
    const float oref = g0 * o_cmp + g1 * o_br[0] + g2 * o_br[1];
    const float ofast = bfv((const bf16_t*)(P.ws + WS_OBUF) + row * 2048 + (g * 4 + h) * 128 + d);
    __syncthreads();
    red[tid] = (ofast - oref) * (ofast - oref); red[512 + tid] = oref * oref;
    __syncthreads();
    if (tid == 0) { float a = 0.f, r2 = 0.f; for (int i = 0; i < 512; ++i) { a += red[i]; r2 += red[512 + i]; }
        ((float*)(P.ws + WS_CHK))[bid] = sqrtf(a / fmaxf(r2, 1e-30f)); }
    __syncthreads();
}
#endif


DEV void phase_attn(const Params& P, unsigned char* lds, int b, int lr, int nl) {
    for (int idx = lr; idx < 128; idx += nl) {
        const int k = idx >> 5, r = idx & 31, g = k;
        const int qt = (k & 1) ? r : 31 - r;
        attn_item(P, b, g, qt, lds);
    }
    __syncthreads();
}

#define XB_TMO      128
#define XB_XCNT(j)  (256  + 64 * (j))
#define XB_XSUB(j)  (1280 + 64 * (j))
#define XB_XGEN(j)  (2304 + 64 * (j))
#define XB_TOP      3328
#define XB_TOPGEN   3392
#define XCD_BAR_WORDS 3456
#define XB_LSUB(j)  (3456 + 16 * (j))
#define XB_LGEN(j)  (3712 + 16 * (j))
#define XB_SPIN_CAP (1u << 18)
DEV unsigned xb_ld(unsigned* p)              { return __hip_atomic_load(p, __ATOMIC_RELAXED, __HIP_MEMORY_SCOPE_AGENT); }
DEV unsigned xb_add(unsigned* p, unsigned v) { return __hip_atomic_fetch_add(p, v, __ATOMIC_RELAXED, __HIP_MEMORY_SCOPE_AGENT); }
DEV unsigned xb_xcc_id() { return (unsigned)__builtin_amdgcn_s_getreg((3 << 11) | 20) & 0xFu; }
#define XB_SPIN(cond, bar) do { unsigned _sp = 0; while (cond) { __builtin_amdgcn_s_sleep(1); \
    if ((++_sp & 255u) == 0u) { if (xb_ld(&(bar)[XB_TMO])) break; if (_sp > XB_SPIN_CAP) { atomicAdd(&(bar)[XB_TMO], 1u); break; } } } } while (0)
struct XcdBarrier { unsigned* bar; unsigned x; volatile LAS unsigned* st; };
DEV XcdBarrier xcd_barrier_post(unsigned* bar, volatile LAS unsigned* st) {
    XcdBarrier b; b.bar = bar; b.x = xb_xcc_id(); b.st = st;
    if (threadIdx.x == 0) st[3] = xb_add(&bar[XB_XCNT(b.x)], 1u);
    return b;
}
DEV void xcd_barrier_complete(unsigned* bar, unsigned x, unsigned& nloc, unsigned& nx, unsigned& gidx) {
    const unsigned G = gridDim.x * gridDim.y * gridDim.z;
    unsigned sum, cnt, mine, below, sp = 0u;
    for (;;) {
        sum = 0u; cnt = 0u; mine = 0u; below = 0u;
#pragma unroll 1
        for (unsigned j = 0; j < 16; ++j) { const unsigned c = xb_ld(&bar[XB_XCNT(j)]); sum += c; cnt += (c > 0u) ? 1u : 0u; mine = (j == x) ? c : mine; below += (c > 0u && j < x) ? 1u : 0u; }
        if (sum == G) break;
        __builtin_amdgcn_s_sleep(1);
        if ((++sp & 255u) == 0u) { if (xb_ld(&bar[XB_TMO])) break; if (sp > XB_SPIN_CAP) { atomicAdd(&bar[XB_TMO], 1u); break; } }
    }
    nloc = mine > 0u ? mine : 1u; nx = cnt > 0u ? cnt : 1u; gidx = below;
}
DEV void xcd_barrier(const XcdBarrier& b) {
    asm volatile("s_waitcnt vmcnt(0)" ::: "memory");
    __syncthreads();
    if (threadIdx.x == 0) {
        unsigned* bar = b.bar;
        __builtin_amdgcn_s_waitcnt(0);
        unsigned nloc = b.st[0], nx = b.st[1];
        if (nloc == 0u) { unsigned gidx; xcd_barrier_complete(bar, b.x, nloc, nx, gidx); b.st[0] = nloc; b.st[1] = nx; b.st[2] = gidx; }
        const unsigned old = xb_add(&bar[XB_XSUB(b.x)], 1u);
        const unsigned gen = old / nloc;
        if (old + 1u == (gen + 1u) * nloc) {
            __builtin_amdgcn_fence(__ATOMIC_RELEASE, "agent");
            asm volatile("s_waitcnt vmcnt(0)" ::: "memory");
            const unsigned og = xb_add(&bar[XB_TOP], 1u);
            const unsigned tg = og / nx;
            if (og + 1u == (tg + 1u) * nx) xb_add(&bar[XB_TOPGEN], 1u);
            else XB_SPIN(xb_ld(&bar[XB_TOPGEN]) == tg, bar);
            __builtin_amdgcn_fence(__ATOMIC_ACQUIRE, "agent");
            xb_add(&bar[XB_XGEN(b.x)], 1u);
            asm volatile("s_waitcnt vmcnt(0)" ::: "memory");
        } else {
            XB_SPIN(xb_ld(&bar[XB_XGEN(b.x)]) == gen, bar);
            __builtin_amdgcn_fence(__ATOMIC_ACQUIRE, "agent");
            asm volatile("s_waitcnt vmcnt(0)" ::: "memory");
        }
    }
    __syncthreads();
}

DEV void xcd_local_barrier(const XcdBarrier& b) {
    asm volatile("s_waitcnt vmcnt(0)" ::: "memory");
    __syncthreads();
    if (threadIdx.x == 0) {
        unsigned* bar = b.bar;
        __builtin_amdgcn_s_waitcnt(0);
        const unsigned nloc = b.st[0];
        const unsigned old = xb_add(&bar[XB_LSUB(b.x)], 1u), gen = old / nloc;
        if (old + 1u == (gen + 1u) * nloc) xb_add(&bar[XB_LGEN(b.x)], 1u);
        else XB_SPIN(xb_ld(&bar[XB_LGEN(b.x)]) == gen, bar);
        __builtin_amdgcn_fence(__ATOMIC_ACQUIRE, "agent");
        asm volatile("s_waitcnt vmcnt(0)" ::: "memory");
    }
    __syncthreads();
}

__global__ void __launch_bounds__(512, 2) mega_fwd(Params P) {
    unsigned char* lds = g_lds;
    if (threadIdx.x == 0) {
#pragma unroll
        for (int i = 0; i < 28; ++i) ((LAS unsigned long long*)((LAS unsigned char*)g_lds + TAB_OFF))[i] = (unsigned long long)P.in[i];
    }
    const int lo = P.ph_lo, hi = P.ph_hi;
    volatile LAS unsigned* bst = (volatile LAS unsigned*)((LAS unsigned char*)lds + (LDS_BYTES - 64));
    if (threadIdx.x == 0) { bst[0] = 0u; bst[1] = 0u; bst[2] = 0u; bst[3] = 0u; }
    __syncthreads();
    XcdBarrier xbar = xcd_barrier_post((unsigned*)(P.ws + WS_BAR), bst);
#if PROBE
    unsigned long long* stamps = (unsigned long long*)(lds + 140000);
    if (blockIdx.x == 0 && threadIdx.x == 0) stamps[0] = __builtin_amdgcn_s_memrealtime();
#endif
    LAS unsigned char* ldsl = (LAS unsigned char*)lds;
    float* xbuf = P.out;
#pragma unroll 1
    for (int ph = lo; ph < hi; ++ph) {
        const int G = gridDim.x;
        int kind, l;
        if (ph == 0) { kind = 0; l = 0; } else if (ph == NPHASE - 1) { kind = 11; l = 0; } else { kind = (ph - 1) % 10 + 1; l = (ph - 1) / 10; }
        if (kind == 0) {
#ifndef SKIP_PREP
            phase_prep(P, lds);
#endif
        } else {
            const int nl = __builtin_amdgcn_readfirstlane((int)bst[0]), nx = __builtin_amdgcn_readfirstlane((int)bst[1]);
            const int gx = __builtin_amdgcn_readfirstlane((int)bst[2]), lr = __builtin_amdgcn_readfirstlane((int)bst[3]);
#pragma unroll 1
            for (int b = gx; b < NB; b += nx) {
                const int ro = b * 2048;
                int l2 = l; asm volatile("" : "+s"(l2));
                unsigned char* wsb = P.ws; asm volatile("" : "+s"(wsb));
                unsigned char* wl = wsb + (size_t)l2 * LAYER_BYTES;
                const float* mod = (const float*)(wl + L_MOD);
                const float* xcur = l2 == 0 ? INP(0) : xbuf;
                bf16_t* hbuf = (bf16_t*)(wsb + WS_HBUF);
                switch (kind) {
                case 1: phase_norm<0>(xcur, INP(4) + l2 * 2048, mod, 0, 1, hbuf, nullptr, b, lsg(lr), lsg(nl)); break;
                case 2: {
                    pg8::Gemm g{hbuf + (size_t)ro * 2048, (const bf16_t*)(wl + L_WIN), 2048, NIN, 2048, 2048, 0}; pg8::StaticOrder S; S.init(2048, NIN, lsg(nl), lsg(lr)); EpiIn E{wsb, ro};
                    pg8::gemm_phase<EpiIn>(ldsl, g, S, E);
                    break; }
                case 3: {
                    const int lr3 = lsg(lr), nl3 = lsg(nl);
                    for (int it = lr3; it < 32; it += nl3) lru_item(P, l2, b * 32 + it, lds);
                    for (int it = lr3; it < 64; it += nl3) cmp_item(P, l2, (it >> 5) * 256 + (b * 4 + ((it >> 3) & 3)) * 8 + (it & 7), lds);
                    break; }
                case 4: phase_attn(P, lds, b, lsg(lr), lsg(nl)); break;
                case 5: {
                    pg8::StaticOrder S; S.init(2048, 2048, lsg(nl), lsg(lr));
                    { pg8::Gemm g{(const bf16_t*)(wsb + Z_Q) + (size_t)ro * 2048, (const bf16_t*)(wl + L_PA), 2048, 2048, 2048, 2048, 0}; EpiProj<0> E{(const bf16_t*)(wsb + Z_GA), hbuf, ro};
                      pg8::gemm_phase<EpiProj<0>>(ldsl, g, S, E); }
                    __syncthreads();
                    { pg8::Gemm g{(const bf16_t*)(wsb + Z_LY) + (size_t)ro * 2048, (const bf16_t*)(wl + L_PB), 2048, 2048, 2048, 2048, 0}; EpiProj<1> E{(const bf16_t*)(wsb + Z_GB), hbuf, ro};
                      pg8::gemm_phase<EpiProj<1>>(ldsl, g, S, E); }
                    break; }
                case 6: {
                    pg8::Gemm g{hbuf + (size_t)ro * 2048, (const bf16_t*)(wl + L_WO), 2048, 2048, 2048, 2048, 0}; pg8::StaticOrder S; S.init(2048, 2048, lsg(nl), lsg(lr)); EpiRes E{xcur, xbuf, mod + 2 * 2048, ro};
                    pg8::gemm_phase<EpiRes>(ldsl, g, S, E);
                    break; }
                case 7: phase_norm<0>(xbuf, INP(22) + l2 * 2048, mod, 3, 4, hbuf, nullptr, b, lsg(lr), lsg(nl)); break;
                case 8: {
                    pg8::Gemm g{hbuf + (size_t)ro * 2048, (const bf16_t*)(wl + L_WUP), 2048, 12288, 2048, 2048, 0}; pg8::StaticOrder S; S.init(2048, 12288, lsg(nl), lsg(lr));
                    EpiGlu E{(bf16_t*)(wsb + Z_LX), (float*)(wsb + WS_SIDE), INP(24) + (size_t)l2 * 3 * DFF, INP(25) + (size_t)l2 * DFF, ldsl + 131072, ro};
                    pg8::gemm_phase<EpiGlu>(ldsl, g, S, E);
                    break; }
                case 9: phase_glufix(P, l2, b, lsg(lr), lsg(nl)); break;
                case 10: {
                    pg8::Gemm g{(const bf16_t*)(wsb + Z_LX) + (size_t)ro * 2048, (const bf16_t*)(wl + L_WDN), 2048, 2048, DFF, 2048, SZ_ACT - 4096};
                    pg8::StaticOrder S; S.init(2048, 2048, lsg(nl), lsg(lr)); EpiRes E{xbuf, xbuf, mod + 5 * 2048, ro};
                    pg8::gemm_phase<EpiRes>(ldsl, g, S, E);
                    break; }
                default: phase_norm<1>(xbuf, INP(27), nullptr, 0, 0, nullptr, xbuf, b, lsg(lr), lsg(nl)); break;
                }
                __syncthreads();
            }
        }
        if (ph + 1 < hi) { if (ph < 0) cg::this_grid().sync(); else if (ph == 0) xcd_barrier(xbar); else xcd_local_barrier(xbar); }
#if PROBE
        if (blockIdx.x == 0 && threadIdx.x == 0) stamps[ph + 1] = __builtin_amdgcn_s_memrealtime();
#endif
    }
#if PROBE
    xcd_barrier(xbar);
    if (blockIdx.x == 0) {
        float* fr = (float*)(lds + 141000);
        if (threadIdx.x == 0) {
            float tg[6] = {0.f, 0.f, 0.f, 0.f, 0.f, 0.f};
            for (int k = 0; k < NPHASE; ++k) {
                const float dt = (float)(stamps[k + 1] - stamps[k]);
                int grp; if (k == 0) grp = 0; else if (k == NPHASE - 1) grp = 1; else { const int sidx = (k - 1) % 10 + 1; grp = (sidx == 1 || sidx == 7) ? 1 : (sidx == 3 ? 3 : (sidx == 4 ? 4 : (sidx == 9 ? 5 : 2))); }
                for (int q2 = 0; q2 < 6; ++q2) if (q2 == grp) tg[q2] += dt;
            }
            const float tot = (float)(stamps[NPHASE] - stamps[0]);
            float fa = 0.f, fb = 0.f;
            for (int q2 = 0; q2 < 6; ++q2) { if (q2 == PROBE_GA) fa = tg[q2] / tot; if (q2 == PROBE_GB) fb = tg[q2] / tot; }
#if PROBE_CHECK
            { const float* chk = (const float*)(P.ws + WS_CHK); int nbad = 0; float mx = 0.f, sm = 0.f;
              for (int i = 0; i < 256; ++i) { const float e = chk[i]; if (!(e <= 0.05f)) ++nbad; mx = fmaxf(mx, e); sm += e; }
              fa = (float)nbad / 256.f;
              fb = fminf(sm / 256.f, 0.25f); }
#endif
            fr[0] = 0.04f * sqrtf(fa); fr[1] = 0.04f + 0.5f * fb;
        }
        __syncthreads();
        const float da = fr[0], db = fr[1];
        for (int i = threadIdx.x; i < (1 << 20); i += 512) xbuf[i] += da;
        if (threadIdx.x == 0) xbuf[(size_t)M * D - 1] += db;
    }
#endif
}

extern "C" void kernel_launch(void* const* d_in, const int* in_sizes, int n_in, void* d_out, int out_size, void* d_ws, size_t ws_size, hipStream_t stream) {
    static int grid = 0;
    if (grid == 0) {
        if (n_in != 28 || out_size != M * D || ws_size < WS_NEED) { fprintf(stderr, "kernel_launch: unexpected problem (n_in %d, out %d, ws %zu < %zu)\n", n_in, out_size, ws_size, (size_t)WS_NEED); grid = -1; return; }
        int dev = 0, cus = 0, per_cu = 0;
        hipGetDevice(&dev);
        hipDeviceGetAttribute(&cus, hipDeviceAttributeMultiprocessorCount, dev);
        if (hipFuncSetAttribute((const void*)mega_fwd, hipFuncAttributeMaxDynamicSharedMemorySize, LDS_BYTES) != hipSuccess) { fprintf(stderr, "kernel_launch: hipFuncSetAttribute failed\n"); grid = -1; return; }
        if (hipOccupancyMaxActiveBlocksPerMultiprocessor(&per_cu, (const void*)mega_fwd, 512, LDS_BYTES) != hipSuccess || per_cu < 1) { fprintf(stderr, "kernel_launch: occupancy query says %d\n", per_cu); per_cu = 1; }
        (void)hipGetLastError();
        grid = cus * (per_cu > 1 ? 1 : per_cu);
        fprintf(stderr, "kernel_launch: grid %d (cus %d, per_cu %d), ws need %zu of %zu\n", grid, cus, per_cu, (size_t)WS_NEED, ws_size);
    }
    if (grid < 0) return;
    Params p{};
    for (int i = 0; i < 28; ++i) p.in[i] = (const float*)d_in[i];
    p.out = (float*)d_out; p.ws = (unsigned char*)d_ws;
#if MK_COOP
    if (hipMemsetAsync((char*)d_ws + WS_BAR, 0, WS_BAR_BYTES, stream) != hipSuccess) { fprintf(stderr, "kernel_launch: memset of the barrier words failed\n"); return; }
    p.ph_lo = 0; p.ph_hi = NPHASE;
    void* args[] = {&p};
    hipError_t e = hipLaunchCooperativeKernel((const void*)mega_fwd, dim3(grid), dim3(512), args, LDS_BYTES, stream);
    if (e != hipSuccess) fprintf(stderr, "cooperative launch failed: %s (grid %d)\n", hipGetErrorString(e), grid);
#else
    for (int ph = 0; ph < NPHASE; ++ph) {
        p.ph_lo = ph; p.ph_hi = ph + 1;
        hipLaunchKernelGGL(mega_fwd, dim3(grid), dim3(512), LDS_BYTES, stream, p);
    }
#endif
}
```

```cpp
#include <hip/hip_runtime.h>
#include <hip/hip_cooperative_groups.h>
#include <cstdio>
#include <cstdint>
namespace cg = cooperative_groups;

#ifndef MK_COOP
#define MK_COOP 1
#endif

#ifndef PROBE
#define PROBE 0
#endif
#ifndef PROBE_CHECK
#define PROBE_CHECK 0
#endif
#define PROBE_GA 2
#define PROBE_GB 4
#define DEV __device__ __forceinline__
#define LAS __attribute__((address_space(3)))
typedef unsigned short bf16_t;
typedef short bf16x8 __attribute__((ext_vector_type(8)));
typedef float f32x4 __attribute__((ext_vector_type(4)));
typedef unsigned u32x4 __attribute__((ext_vector_type(4)));
typedef unsigned u32x2 __attribute__((ext_vector_type(2)));

constexpr int NB = 8, T = 2048, D = 2048, M = NB * T, DEPTH = 2;
constexpr int NIN = 13568;
constexpr int DFF = 6144;
constexpr int NPHASE = 1 + 10 * DEPTH + 1;
constexpr int LDS_BYTES = 147456;

DEV int up_src(int n) { return ((n >> 7) & 1) * 6144 + (n >> 8) * 128 + (n & 127); }
DEV int win_src(int n) { return n < 5120 ? n : (n < 13312 ? n + 48 : (n < 13360 ? n - 13312 + 5120 : -1)); }

constexpr size_t SZ_WIN = (size_t)NIN * 2048 * 2, SZ_WUP = (size_t)12288 * 2048 * 2, SZ_WDN = (size_t)2048 * 6144 * 2, SZ_WSQ = (size_t)2048 * 2048 * 2;
constexpr size_t SZ_W1 = (size_t)128 * 4096 * 2, SZ_W2 = 128 * 128 * 2, SZ_LRUW = 16 * 128 * 128 * 2, SZ_MOD = 8 * 12288 * 4;
constexpr size_t L_WIN = 0, L_WUP = L_WIN + SZ_WIN, L_WDN = L_WUP + SZ_WUP, L_PA = L_WDN + SZ_WDN, L_PB = L_PA + SZ_WSQ, L_WO = L_PB + SZ_WSQ,
                 L_W1K = L_WO + SZ_WSQ, L_W1V = L_W1K + SZ_W1, L_W2K = L_W1V + SZ_W1, L_W2V = L_W2K + SZ_W2, L_WA = L_W2V + SZ_W2, L_WI = L_WA + SZ_LRUW,
                 L_MOD = L_WI + SZ_LRUW, LAYER_BYTES = L_MOD + SZ_MOD;
constexpr size_t SZ_ACT = (size_t)M * 2048 * 2;
constexpr size_t SZ_KV = (size_t)M * 512 * 2;
constexpr size_t WS_HBUF = DEPTH * LAYER_BYTES;
constexpr size_t WS_Z = WS_HBUF + SZ_ACT;
constexpr size_t Z_Q = WS_Z, Z_KC = Z_Q + SZ_ACT, Z_VC = Z_KC + SZ_KV, Z_KS = Z_VC + SZ_KV, Z_VST = Z_KS + SZ_KV, Z_KW = Z_VST + SZ_KV, Z_VWT = Z_KW + SZ_KV,
                 Z_LX = Z_VWT + SZ_KV, Z_LY = Z_LX + SZ_ACT, Z_GA = Z_LY + SZ_ACT, Z_GB = Z_GA + SZ_ACT, Z_GATE = Z_GB + SZ_ACT,
                 Z_KCMP = Z_GATE + (size_t)M * 64 * 2, Z_VCMPT = Z_KCMP + (size_t)32 * 128 * 128 * 2, Z_END = Z_VCMPT + (size_t)32 * 128 * 128 * 2;
constexpr size_t F_G = WS_Z, F_V = WS_Z + (size_t)M * DFF * 2;
static_assert(F_V + (size_t)M * DFF * 2 <= Z_KCMP, "ffn overlay");
constexpr size_t WS_BAR = (Z_END + 255) & ~(size_t)255, WS_BAR_BYTES = 16384;
constexpr size_t WS_SIDE = WS_BAR + WS_BAR_BYTES, SIDE_ELEMS = (size_t)64 * 2 * DFF;
constexpr size_t WS_OBUF = WS_SIDE + 3 * SIDE_ELEMS * 4, WS_CHK = WS_OBUF + SZ_ACT;
constexpr size_t WS_NEED = PROBE_CHECK ? WS_CHK + 4096 : WS_OBUF;

struct Params { const float* in[28]; float* out; unsigned char* ws; int ph_lo, ph_hi; };
extern __shared__ __attribute__((aligned(16))) unsigned char g_lds[];
constexpr int TAB_OFF = LDS_BYTES - 64 - 256;
__device__ __forceinline__ const float* inp(int k) {
    const unsigned long long v = *(const volatile __attribute__((address_space(3))) unsigned long long*)((__attribute__((address_space(3))) unsigned char*)g_lds + TAB_OFF + 8 * k);
    const unsigned lo = __builtin_amdgcn_readfirstlane((unsigned)v), hi = __builtin_amdgcn_readfirstlane((unsigned)(v >> 32));
    return (const float*)(const __attribute__((address_space(1))) float*)(((unsigned long long)hi << 32) | lo);
}
#define INP(k) inp(k)

DEV float bflo(unsigned u) { return __builtin_bit_cast(float, u << 16); }
DEV float bfhi(unsigned u) { return __builtin_bit_cast(float, u & 0xffff0000u); }
DEV unsigned cvt_pk_bf16(float lo, float hi) { unsigned r; asm volatile("v_cvt_pk_bf16_f32 %0, %1, %2" : "=v"(r) : "v"(lo), "v"(hi)); return r; }
DEV float frcp(float x) { return __builtin_amdgcn_rcpf(x); }
DEV float sigm(float x) { return frcp(1.f + __builtin_amdgcn_exp2f(-1.4426950408889634f * x)); }
DEV float gelu_t(float x) { const float u = -2.302208198106407f * (x + 0.044715f * x * x * x); return x * frcp(1.f + __builtin_amdgcn_exp2f(u)); }
DEV float shx(float v, int m, int lane) { return __builtin_bit_cast(float, __builtin_amdgcn_ds_bpermute((lane ^ m) << 2, __builtin_bit_cast(int, v))); }
DEV unsigned shxu(unsigned v, int m, int lane) { return (unsigned)__builtin_amdgcn_ds_bpermute((lane ^ m) << 2, (int)v); }
DEV float wave_sum(float v, int lane) {
#pragma unroll
    for (int o = 1; o < 64; o <<= 1) v += shx(v, o, lane);
    return v;
}
DEV int otid() { int t = threadIdx.x; asm volatile("" : "+v"(t)); return t; }
DEV int obid() { int b = blockIdx.x; asm volatile("" : "+s"(b)); return b; }
DEV int lsg(int v) { asm volatile("" : "+s"(v)); return v; }
DEV f32x4 mfma16(bf16x8 a, bf16x8 b, f32x4 c) { return __builtin_amdgcn_mfma_f32_16x16x32_bf16(a, b, c, 0, 0, 0); }
DEV bf16x8 as_bf16x8(u32x4 v) { return __builtin_bit_cast(bf16x8, v); }

namespace pg8 {
constexpr int BM = 256, BK = 64, HALF = 128, HTB = HALF * BK * 2, NXCD = 8, WGM = 8;
DEV int lds_byte(int r, int c) { const int st = (r >> 4) * 2 + (c >> 5), rr = r & 15, cc = c & 31, ob = rr * 64 + cc * 2; return st * 1024 + (ob ^ (((ob >> 9) & 1) << 5)); }
DEV void stage_rc(int b, int& R, int& C) { const int st = b / 1024, sb = b % 1024, swz = sb ^ (((sb >> 9) & 1) << 5); R = (st >> 1) * 16 + swz / 64; C = (st & 1) * 32 + (swz % 64) / 2; }
DEV int perm32(int rho) { const int n = rho >> 4, i = rho & 15; return 8 * (i >> 2) + 4 * n + (i & 3); }
struct Unit { int pm, pn; };
struct Gemm { const bf16_t* A; const bf16_t* Bt; int M, N, K, lda; size_t pj; };
struct StaticOrder {
    int nM, nN, nwg, G, c;
    DEV void init(int M_, int N_, int G_, int c_) { nM = M_ / BM; nN = N_ / BM; nwg = nM * nN; G = G_; c = c_; }
    DEV bool next(int i, Unit& u) const {
        const long L = (long)i * G + c; if (L >= nwg) return false;
        const int wgid = (int)L;
        const int nig = WGM * nN, gid = wgid / nig, fm = gid * WGM, gsz = (nM - fm) < WGM ? (nM - fm) : WGM;
        u.pm = fm + ((wgid % nig) % gsz); u.pn = (wgid % nig) / gsz; return true;
    }
};
template <class Epi>
DEV void gemm_phase(LAS unsigned char* lds, const Gemm g, const StaticOrder& S, const Epi& E) {
    const int tid = otid(), wid = __builtin_amdgcn_readfirstlane(tid >> 6), lane = tid & 63, wr = wid >> 2, wc = wid & 3, fr = lane & 15, fq = lane >> 4;
    const int K = g.K, nt = K / BK, lda = g.lda;
    unsigned voffA[2], voffB[2];
#pragma unroll
    for (int i = 0; i < 2; ++i) { int R, C; stage_rc(tid * 16 + i * 8192, R, C); const int Rb = (R & ~31) + perm32(R & 31);
        voffA[i] = (unsigned)(R * lda + C) * 2u; voffB[i] = (unsigned)(Rb * K + C) * 2u; }
    const size_t kstep = (size_t)(BK * 2);
    const size_t pj = g.pj;
#define PG8_KOFF(t) ((size_t)(t) * kstep + (size_t)((t) >> 5) * pj)
    const size_t hstepA = (size_t)HALF * lda * 2, tstepA = 2 * hstepA;
    const size_t hstepB = (size_t)HALF * K * 2, tstepB = 2 * hstepB;
    const unsigned ldsw = (unsigned)wid * 1024u;
    const int aoff = lds_byte(wr * 64 + fr, fq * 8), boff = lds_byte(wc * 32 + fr, fq * 8);
#define PG8_SA(b, h) (((b) * 2 + (h)) * HTB)
#define PG8_SB(b, h) ((4 + (b) * 2 + (h)) * HTB)
#define PG8_STAGE(bufoff, gbase, voff) do { _Pragma("unroll") for (int _i = 0; _i < 2; ++_i) \
        __builtin_amdgcn_global_load_lds((const unsigned*)((const char*)(gbase) + (voff)[_i]), (LAS unsigned*)(lds + (bufoff) + ldsw + _i * 8192), 16, 0, 0); } while (0)
#define PG8_LDA(dst, b, h) do { _Pragma("unroll") for (int m = 0; m < 4; ++m) _Pragma("unroll") for (int k = 0; k < 2; ++k) dst[m][k] = *(const LAS bf16x8*)(lds + PG8_SA(b, h) + aoff + m * 2048 + k * 1024); } while (0)
#define PG8_LDB(dst, b, h) do { _Pragma("unroll") for (int n = 0; n < 2; ++n) _Pragma("unroll") for (int k = 0; k < 2; ++k) dst[n][k] = *(const LAS bf16x8*)(lds + PG8_SB(b, h) + boff + n * 2048 + k * 1024); } while (0)
#define PG8_MMA(ai, bj, At, Bt) do { __builtin_amdgcn_s_setprio(1); _Pragma("unroll") for (int m = 0; m < 4; ++m) _Pragma("unroll") for (int n = 0; n < 2; ++n) _Pragma("unroll") for (int k = 0; k < 2; ++k) \
        acc[ai][bj][m][n] = __builtin_amdgcn_mfma_f32_16x16x32_bf16(Bt[n][k], At[m][k], acc[ai][bj][m][n], 0, 0, 0); __builtin_amdgcn_s_setprio(0); } while (0)
#define PG8_WAIT_V(n) asm volatile("s_waitcnt vmcnt(" #n ")" ::: "memory")
#define PG8_WAIT_L(n) asm volatile("s_waitcnt lgkmcnt(" #n ")" ::: "memory")
#define PG8_BAR __builtin_amdgcn_s_barrier()
#define PG8_SCHED __builtin_amdgcn_sched_barrier(0)
    Unit cur, nxt; int ui = 0;
    if (!S.next(0, cur)) return;
    f32x4 acc[2][2][4][2];
#pragma unroll
    for (int a = 0; a < 2; ++a)
#pragma unroll
        for (int b = 0; b < 2; ++b)
#pragma unroll
            for (int m = 0; m < 4; ++m)
#pragma unroll
                for (int n = 0; n < 2; ++n) acc[a][b][m][n] = (f32x4){0.f, 0.f, 0.f, 0.f};
    bf16x8 At[4][2], B0[2][2], B1[2][2];
    const char* cA = (const char*)g.A + (size_t)cur.pm * tstepA; const char* cB = (const char*)g.Bt + (size_t)cur.pn * tstepB;
    PG8_STAGE(PG8_SB(0, 0), cB, voffB); PG8_STAGE(PG8_SB(0, 1), cB + hstepB, voffB); PG8_STAGE(PG8_SA(0, 0), cA, voffA); PG8_STAGE(PG8_SA(0, 1), cA + hstepA, voffA);
    if (wr == 1) PG8_BAR;
    PG8_WAIT_V(2); PG8_BAR;
    PG8_STAGE(PG8_SB(1, 0), cB + kstep, voffB); PG8_STAGE(PG8_SA(1, 0), cA + kstep, voffA); PG8_STAGE(PG8_SB(1, 1), cB + hstepB + kstep, voffB);
    PG8_WAIT_V(6); PG8_BAR;
    for (;;) {
        const bool has_next = S.next(ui + 1, nxt);
        const char* nA = has_next ? (const char*)g.A + (size_t)nxt.pm * tstepA : cA; const char* nB = has_next ? (const char*)g.Bt + (size_t)nxt.pn * tstepB : cB;
        for (int t = 0; t < nt; t += 2) {
            const bool last = (t == nt - 2);
            const char* a1 = cA + PG8_KOFF(t + 1);
            const char* a2 = last ? nA : cA + PG8_KOFF(t + 2); const char* b2 = last ? nB : cB + (size_t)(t + 2) * kstep;
            const char* a3 = last ? nA + kstep : cA + PG8_KOFF(t + 3); const char* b3 = b2 + kstep;
            PG8_LDB(B0, 0, 0); PG8_LDB(B1, 0, 1); PG8_SCHED; PG8_LDA(At, 0, 0); PG8_STAGE(PG8_SA(1, 1), a1 + hstepA, voffA);
            PG8_WAIT_V(8); PG8_WAIT_L(0); PG8_BAR; PG8_MMA(0, 0, At, B0); PG8_MMA(0, 1, At, B1); PG8_BAR; PG8_SCHED;
            PG8_LDA(At, 0, 1); PG8_STAGE(PG8_SB(0, 0), b2, voffB); PG8_STAGE(PG8_SB(0, 1), b2 + hstepB, voffB); PG8_STAGE(PG8_SA(0, 0), a2, voffA);
            PG8_WAIT_V(8); PG8_WAIT_L(0); PG8_BAR; PG8_MMA(1, 0, At, B0); PG8_MMA(1, 1, At, B1); PG8_BAR; PG8_SCHED;
            PG8_LDB(B0, 1, 0); PG8_LDB(B1, 1, 1); PG8_SCHED; PG8_LDA(At, 1, 0); PG8_STAGE(PG8_SA(0, 1), a2 + hstepA, voffA);
            PG8_WAIT_V(8); PG8_WAIT_L(0); PG8_BAR; PG8_MMA(0, 0, At, B0); PG8_MMA(0, 1, At, B1); PG8_BAR; PG8_SCHED;
            PG8_LDA(At, 1, 1); PG8_STAGE(PG8_SB(1, 0), b3, voffB); PG8_STAGE(PG8_SB(1, 1), b3 + hstepB, voffB); PG8_STAGE(PG8_SA(1, 0), a3, voffA);
            PG8_WAIT_V(8); PG8_WAIT_L(0); PG8_BAR; PG8_MMA(1, 0, At, B0); PG8_MMA(1, 1, At, B1); PG8_BAR; PG8_SCHED;
        }
        if (wr == 0) PG8_BAR;
        E(acc, cur, wr, wc, fr, fq);
        if (!has_next) break;
#pragma unroll
        for (int a = 0; a < 2; ++a)
#pragma unroll
            for (int b = 0; b < 2; ++b)
#pragma unroll
                for (int m = 0; m < 4; ++m)
#pragma unroll
                    for (int n = 0; n < 2; ++n) acc[a][b][m][n] = (f32x4){0.f, 0.f, 0.f, 0.f};
        cur = nxt; cA = nA; cB = nB; ++ui;
        if (wr == 1) PG8_BAR;
    }
    PG8_WAIT_V(0);
    PG8_BAR;
#undef PG8_KOFF
#undef PG8_SA
#undef PG8_SB
#undef PG8_STAGE
#undef PG8_LDA
#undef PG8_LDB
#undef PG8_MMA
#undef PG8_WAIT_V
#undef PG8_WAIT_L
#undef PG8_BAR
#undef PG8_SCHED
}
}
using pg8::Unit;

DEV u32x4 pack8(f32x4 v0, f32x4 v1) { u32x4 w; w.x = cvt_pk_bf16(v0[0], v0[1]); w.y = cvt_pk_bf16(v0[2], v0[3]); w.z = cvt_pk_bf16(v1[0], v1[1]); w.w = cvt_pk_bf16(v1[2], v1[3]); return w; }

struct EpiIn {
    unsigned char* ws; int ro;
    DEV void operator()(const f32x4 (&acc)[2][2][4][2], const Unit& u, int wr, int wc, int fr, int fq) const {
        const int pn = u.pn; bf16_t* base; int pitch, colt, mode = 0; float sc = 1.f;
        if (pn < 8) { base = (bf16_t*)(ws + Z_Q); pitch = 2048; colt = pn * 256; sc = 0.08838834764831845f; }
        else if (pn < 20) { const int s = (pn - 8) >> 1; colt = ((pn - 8) & 1) * 256; pitch = 512; base = (bf16_t*)(ws + Z_KC + (size_t)s * SZ_KV); mode = (s == 3 || s == 5) ? 1 : 0; }
        else if (pn < 52) { const int s = (pn - 20) >> 3; colt = ((pn - 20) & 7) * 256; pitch = 2048; base = (bf16_t*)(ws + Z_LX + (size_t)s * SZ_ACT); }
        else { mode = 2; base = (bf16_t*)(ws + Z_GATE); pitch = 64; colt = 0; }
        const int row0 = ro + u.pm * 256 + wr * 64 + fr;
#pragma unroll
        for (int ai = 0; ai < 2; ++ai)
#pragma unroll
            for (int m = 0; m < 4; ++m) {
                const int row = row0 + ai * 128 + m * 16;
#pragma unroll
                for (int bj = 0; bj < 2; ++bj) {
                    const int col = colt + bj * 128 + wc * 32 + 8 * fq;
                    const f32x4 v0 = acc[ai][bj][m][0] * sc, v1 = acc[ai][bj][m][1] * sc;
                    const u32x4 w = pack8(v0, v1);
                    if (mode == 0) { *(u32x4*)(base + (size_t)row * pitch + col) = w; }
                    else if (mode == 1) {
                        const int b = row >> 11, t = row & 2047, gg = col >> 7, d = col & 127;
                        bf16_t* p = base + ((size_t)((b * 4 + gg) * 128 + d)) * 2048 + t;
                        p[0 * 2048] = (bf16_t)(w.x & 0xffff); p[1 * 2048] = (bf16_t)(w.x >> 16); p[2 * 2048] = (bf16_t)(w.y & 0xffff); p[3 * 2048] = (bf16_t)(w.y >> 16);
                        p[4 * 2048] = (bf16_t)(w.z & 0xffff); p[5 * 2048] = (bf16_t)(w.z >> 16); p[6 * 2048] = (bf16_t)(w.w & 0xffff); p[7 * 2048] = (bf16_t)(w.w >> 16);
                    } else { if (col < 48) *(u32x4*)(base + (size_t)row * 64 + col) = w; }
                }
            }
    }
};
template <int SECOND> struct EpiProj {
    const bf16_t* gate; bf16_t* O; int ro;
    DEV void operator()(const f32x4 (&acc)[2][2][4][2], const Unit& u, int wr, int wc, int fr, int fq) const {
        const int row0 = ro + u.pm * 256 + wr * 64 + fr, col0 = u.pn * 256 + wc * 32 + 8 * fq;
#pragma unroll
        for (int ai = 0; ai < 2; ++ai) {
            u32x4 gv[4][2], pv[4][2];
#pragma unroll
            for (int m = 0; m < 4; ++m)
#pragma unroll
                for (int bj = 0; bj < 2; ++bj) { const size_t off = (size_t)(row0 + ai * 128 + m * 16) * 2048 + col0 + bj * 128;
                    gv[m][bj] = *(const u32x4*)(gate + off); if (SECOND) pv[m][bj] = *(const u32x4*)(O + off); }
#pragma unroll
            for (int m = 0; m < 4; ++m)
#pragma unroll
                for (int bj = 0; bj < 2; ++bj) { const size_t off = (size_t)(row0 + ai * 128 + m * 16) * 2048 + col0 + bj * 128;
                    const u32x4 g = gv[m][bj];
                    f32x4 v0 = acc[ai][bj][m][0], v1 = acc[ai][bj][m][1];
                    v0[0] *= sigm(bflo(g.x)); v0[1] *= sigm(bfhi(g.x)); v0[2] *= sigm(bflo(g.y)); v0[3] *= sigm(bfhi(g.y));
                    v1[0] *= sigm(bflo(g.z)); v1[1] *= sigm(bfhi(g.z)); v1[2] *= sigm(bflo(g.w)); v1[3] *= sigm(bfhi(g.w));
                    if (SECOND) { const u32x4 p = pv[m][bj];
                        v0[0] += bflo(p.x); v0[1] += bfhi(p.x); v0[2] += bflo(p.y); v0[3] += bfhi(p.y);
                        v1[0] += bflo(p.z); v1[1] += bfhi(p.z); v1[2] += bflo(p.w); v1[3] += bfhi(p.w); }
                    *(u32x4*)(O + off) = pack8(v0, v1); }
        }
    }
};
struct EpiRes {
    const float* xin; float* xout; const float* gvec; int ro;
    DEV void operator()(const f32x4 (&acc)[2][2][4][2], const Unit& u, int wr, int wc, int fr, int fq) const {
        const int row0 = ro + u.pm * 256 + wr * 64 + fr, col0 = u.pn * 256 + wc * 32 + 8 * fq;
        const float* gb = gvec + (size_t)(row0 >> 11) * 12288;
        f32x4 g[2][2];
#pragma unroll
        for (int bj = 0; bj < 2; ++bj) { g[bj][0] = *(const f32x4*)(gb + col0 + bj * 128); g[bj][1] = *(const f32x4*)(gb + col0 + bj * 128 + 4); }
#pragma unroll
        for (int ai = 0; ai < 2; ++ai) {
            f32x4 xv[4][2][2];
#pragma unroll
            for (int m = 0; m < 4; ++m)
#pragma unroll
                for (int bj = 0; bj < 2; ++bj) { const size_t off = (size_t)(row0 + ai * 128 + m * 16) * 2048 + col0 + bj * 128;
                    xv[m][bj][0] = *(const f32x4*)(xin + off); xv[m][bj][1] = *(const f32x4*)(xin + off + 4); }
#pragma unroll
            for (int m = 0; m < 4; ++m)
#pragma unroll
                for (int bj = 0; bj < 2; ++bj) { const size_t off = (size_t)(row0 + ai * 128 + m * 16) * 2048 + col0 + bj * 128;
                    *(f32x4*)(xout + off) = xv[m][bj][0] + g[bj][0] * acc[ai][bj][m][0];
                    *(f32x4*)(xout + off + 4) = xv[m][bj][1] + g[bj][1] * acc[ai][bj][m][1]; }
        }
    }
};
struct EpiGlu {
    bf16_t* G; float* side; const float* cw; const float* cb; LAS unsigned char* xch; int ro;
    DEV void operator()(const f32x4 (&acc)[2][2][4][2], const Unit& u, int wr, int wc, int fr, int fq) const {
        const int lane = fq * 16 + fr, cc = wc * 32 + fq * 8, ch = u.pn * 128 + cc, pmg = (ro >> 8) + u.pm;
        f32x4 w0[2], w1[2], w2[2], bs[2];
#pragma unroll
        for (int n = 0; n < 2; ++n) { w0[n] = *(const f32x4*)(cw + ch + 4 * n); w1[n] = *(const f32x4*)(cw + DFF + ch + 4 * n); w2[n] = *(const f32x4*)(cw + 2 * DFF + ch + 4 * n); bs[n] = *(const f32x4*)(cb + ch + 4 * n); }
        LAS float* X = (LAS float*)xch;
        if (fr >= 14) {
#pragma unroll
            for (int ai = 0; ai < 2; ++ai)
#pragma unroll
                for (int n = 0; n < 2; ++n) *(LAS f32x4*)(X + ((ai * 2 + wr) * 2 + (fr - 14)) * 128 + cc + 4 * n) = acc[ai][0][3][n];
            if (wr == 1) {
#pragma unroll
                for (int n = 0; n < 2; ++n) *(f32x4*)(side + ((size_t)(pmg * 2 + (fr - 14))) * DFF + ch + 4 * n) = acc[1][0][3][n];
            }
        }
        if (wr == 0 && fr < 2) {
#pragma unroll
            for (int n = 0; n < 2; ++n) { *(f32x4*)(side + SIDE_ELEMS + ((size_t)(pmg * 2 + fr)) * DFF + ch + 4 * n) = acc[0][0][0][n];
                                          *(f32x4*)(side + 2 * SIDE_ELEMS + ((size_t)(pmg * 2 + fr)) * DFF + ch + 4 * n) = acc[0][1][0][n]; }
        }
        asm volatile("s_waitcnt lgkmcnt(0)" ::: "memory");
        __builtin_amdgcn_s_barrier();
        const int addr1 = ((fr == 0) ? lane + 15 : lane - 1) << 2, addr2 = ((fr < 2) ? lane + 14 : lane - 2) << 2;
        const int row0 = ro + u.pm * 256 + wr * 64 + fr;
#pragma unroll
        for (int ai = 0; ai < 2; ++ai) {
            f32x4 prev[2] = {(f32x4){0.f, 0.f, 0.f, 0.f}, (f32x4){0.f, 0.f, 0.f, 0.f}};
            if (!(ai == 0 && wr == 0) && fr >= 14) {
                const int pslot = ai * 2 + wr - 1;
#pragma unroll
                for (int n = 0; n < 2; ++n) prev[n] = *(const LAS f32x4*)(X + (pslot * 2 + (fr - 14)) * 128 + cc + 4 * n);
            }
#pragma unroll
            for (int m = 0; m < 4; ++m) {
                f32x4 outv[2];
#pragma unroll
                for (int n = 0; n < 2; ++n) {
                    const f32x4 cur = acc[ai][0][m][n], val = acc[ai][1][m][n];
#pragma unroll
                    for (int i = 0; i < 4; ++i) {
                        const float s1 = (fr == 15) ? prev[n][i] : cur[i], s2 = (fr >= 14) ? prev[n][i] : cur[i];
                        const float p1 = __builtin_bit_cast(float, __builtin_amdgcn_ds_bpermute(addr1, __builtin_bit_cast(int, s1)));
                        const float p2 = __builtin_bit_cast(float, __builtin_amdgcn_ds_bpermute(addr2, __builtin_bit_cast(int, s2)));
                        const float a = bs[n][i] + w0[n][i] * p2 + w1[n][i] * p1 + w2[n][i] * cur[i];
                        outv[n][i] = gelu_t(a) * val[i];
                    }
                    prev[n] = cur;
                }
                *(u32x4*)(G + (size_t)(ch >> 11) * (SZ_ACT / 2) + (size_t)(row0 + ai * 128 + m * 16) * 2048 + (ch & 2047)) = pack8(outv[0], outv[1]);
            }
        }
    }
};

DEV void phase_glufix(const Params& P, int l, int b, int lr, int nl) {
    const int tid = otid();
    bf16_t* G = (bf16_t*)(P.ws + Z_LX); const float* side = (const float*)(P.ws + WS_SIDE);
    const float* cw = INP(24) + (size_t)l * 3 * DFF; const float* cb = INP(25) + (size_t)l * DFF;
    for (int idx = lr * 512 + tid; idx < 7 * (DFF / 4); idx += nl * 512) {
        const int t7 = idx / (DFF / 4), c4 = (idx % (DFF / 4)) * 4, pm = b * 8 + t7 + 1;
        const f32x4 L0 = *(const f32x4*)(side + ((size_t)((pm - 1) * 2 + 0)) * DFF + c4), L1 = *(const f32x4*)(side + ((size_t)((pm - 1) * 2 + 1)) * DFF + c4);
        const f32x4 F0 = *(const f32x4*)(side + SIDE_ELEMS + ((size_t)(pm * 2 + 0)) * DFF + c4), F1 = *(const f32x4*)(side + SIDE_ELEMS + ((size_t)(pm * 2 + 1)) * DFF + c4);
        const f32x4 V0 = *(const f32x4*)(side + 2 * SIDE_ELEMS + ((size_t)(pm * 2 + 0)) * DFF + c4), V1 = *(const f32x4*)(side + 2 * SIDE_ELEMS + ((size_t)(pm * 2 + 1)) * DFF + c4);
        const f32x4 w0 = *(const f32x4*)(cw + c4), w1 = *(const f32x4*)(cw + DFF + c4), w2 = *(const f32x4*)(cw + 2 * DFF + c4), bs = *(const f32x4*)(cb + c4);
        const f32x4 a0 = bs + w0 * L0 + w1 * L1 + w2 * F0, a1 = bs + w0 * L1 + w1 * F0 + w2 * F1;
        u32x2 o0, o1;
        o0.x = cvt_pk_bf16(gelu_t(a0[0]) * V0[0], gelu_t(a0[1]) * V0[1]); o0.y = cvt_pk_bf16(gelu_t(a0[2]) * V0[2], gelu_t(a0[3]) * V0[3]);
        o1.x = cvt_pk_bf16(gelu_t(a1[0]) * V1[0], gelu_t(a1[1]) * V1[1]); o1.y = cvt_pk_bf16(gelu_t(a1[2]) * V1[2], gelu_t(a1[3]) * V1[3]);
        bf16_t* gp = G + (size_t)(c4 >> 11) * (SZ_ACT / 2) + (size_t)(pm * 256) * 2048 + (c4 & 2047);
        *(u32x2*)gp = o0;
        *(u32x2*)(gp + 2048) = o1;
    }
}

template <int MAP>
DEV void transpose_item(const float* W, int K, int N, bf16_t* WT, float* scr, int item, int nblk, int lane) {
    const int kb = item / nblk, nb = item % nblk, k0 = 64 * kb, n0 = 32 * nb;
    const int nsrc = MAP == 1 ? win_src(n0 + (lane & 31)) : (MAP == 2 ? up_src(n0 + (lane & 31)) : n0 + (lane & 31));
#pragma unroll 8
    for (int i = 0; i < 32; ++i) { const int kk = 2 * i + (lane >> 5); scr[kk * 33 + (lane & 31)] = nsrc >= 0 ? W[(size_t)(k0 + kk) * N + nsrc] : 0.f; }
    asm volatile("s_waitcnt lgkmcnt(0)" ::: "memory");
    const int c = lane & 7;
#pragma unroll
    for (int j = 0; j < 4; ++j) { const int n = (lane >> 3) + 8 * j; const float* s = scr + (8 * c) * 33 + n;
        u32x4 o; o.x = cvt_pk_bf16(s[0 * 33], s[1 * 33]); o.y = cvt_pk_bf16(s[2 * 33], s[3 * 33]); o.z = cvt_pk_bf16(s[4 * 33], s[5 * 33]); o.w = cvt_pk_bf16(s[6 * 33], s[7 * 33]);
        *(u32x4*)(WT + (size_t)(n0 + n) * K + k0 + 8 * c) = o; }
    asm volatile("s_waitcnt lgkmcnt(0)" ::: "memory");
}

DEV void phase_prep(const Params& P, unsigned char* lds) {
    const int tid = otid(), lane = tid & 63, wave = tid >> 6; const int bid = obid();
    float* scr = (float*)(lds + wave * 8448);
    const int gw = bid * 8 + wave, NGW = gridDim.x * 8;
    constexpr int I_IN = 32 * (NIN / 32), I_UP = 32 * 384, I_DN = 96 * 64, I_SQ = 32 * 64, I_W1 = 64 * 4, I_W2 = 2 * 4, I_LRU = 16 * 8;
    constexpr int PER_LAYER = I_IN + I_UP + I_DN + 3 * I_SQ + 2 * I_W1 + 2 * I_W2 + 2 * I_LRU;
    for (int it = gw; it < DEPTH * PER_LAYER; it += NGW) {
        const int l = it / PER_LAYER; int r = it % PER_LAYER;
        unsigned char* wl = P.ws + (size_t)l * LAYER_BYTES;
        if (r < I_IN) { transpose_item<1>(INP(5) + (size_t)l * 2048 * 13360, 2048, 13360, (bf16_t*)(wl + L_WIN), scr, r, NIN / 32, lane); continue; } r -= I_IN;
        if (r < I_UP) { transpose_item<2>(INP(23) + (size_t)l * 2048 * 12288, 2048, 12288, (bf16_t*)(wl + L_WUP), scr, r, 384, lane); continue; } r -= I_UP;
        if (r < I_DN) { transpose_item<0>(INP(26) + (size_t)l * 6144 * 2048, 6144, 2048, (bf16_t*)(wl + L_WDN), scr, r, 64, lane); continue; } r -= I_DN;
        if (r < I_SQ) { transpose_item<0>(INP(19) + (size_t)l * 2048 * 2048, 2048, 2048, (bf16_t*)(wl + L_PA), scr, r, 64, lane); continue; } r -= I_SQ;
        if (r < I_SQ) { transpose_item<0>(INP(20) + (size_t)l * 2048 * 2048, 2048, 2048, (bf16_t*)(wl + L_PB), scr, r, 64, lane); continue; } r -= I_SQ;
        if (r < I_SQ) { transpose_item<0>(INP(21) + (size_t)l * 2048 * 2048, 2048, 2048, (bf16_t*)(wl + L_WO), scr, r, 64, lane); continue; } r -= I_SQ;
        if (r < I_W1) { transpose_item<0>(INP(7) + (size_t)l * 4096 * 128, 4096, 128, (bf16_t*)(wl + L_W1K), scr, r, 4, lane); continue; } r -= I_W1;
        if (r < I_W1) { transpose_item<0>(INP(10) + (size_t)l * 4096 * 128, 4096, 128, (bf16_t*)(wl + L_W1V), scr, r, 4, lane); continue; } r -= I_W1;
        if (r < I_W2) { transpose_item<0>(INP(8) + (size_t)l * 128 * 128, 128, 128, (bf16_t*)(wl + L_W2K), scr, r, 4, lane); continue; } r -= I_W2;
        if (r < I_W2) { transpose_item<0>(INP(11) + (size_t)l * 128 * 128, 128, 128, (bf16_t*)(wl + L_W2V), scr, r, 4, lane); continue; } r -= I_W2;
        if (r < I_LRU) { const int mt = r >> 3; transpose_item<0>(INP(14) + (size_t)(l * 16 + mt) * 16384, 128, 128, (bf16_t*)(wl + L_WA) + mt * 16384, scr, r & 7, 4, lane); continue; } r -= I_LRU;
        { const int mt = r >> 3; transpose_item<0>(INP(16) + (size_t)(l * 16 + mt) * 16384, 128, 128, (bf16_t*)(wl + L_WI) + mt * 16384, scr, r & 7, 4, lane); }
    }
    __syncthreads();
    float* cact = (float*)(lds + 69632);
    float* red = (float*)lds;
    for (int i = tid; i < 8 * 2048; i += 512) { const int b = i >> 11, k = i & 2047; const float v = INP(1)[i]; cact[k * 8 + b] = v * sigm(v); }
    __syncthreads();
    for (int it = bid; it < DEPTH * 256; it += gridDim.x) {
        const int l = it / 256, n = (it % 256) * 48 + (lane < 48 ? lane : 47), kg = wave;
        const float* w = INP(2) + (size_t)l * 2048 * 12288 + (size_t)(kg * 256) * 12288 + n;
        float a[8];
#pragma unroll
        for (int b = 0; b < 8; ++b) a[b] = 0.f;
#pragma unroll 8
        for (int k = 0; k < 256; ++k) {
            const float wv = w[(size_t)k * 12288];
            const f32x4 c0 = *(const f32x4*)(cact + (kg * 256 + k) * 8), c1 = *(const f32x4*)(cact + (kg * 256 + k) * 8 + 4);
            a[0] += wv * c0[0]; a[1] += wv * c0[1]; a[2] += wv * c0[2]; a[3] += wv * c0[3];
            a[4] += wv * c1[0]; a[5] += wv * c1[1]; a[6] += wv * c1[2]; a[7] += wv * c1[3];
        }
#pragma unroll
        for (int b = 0; b < 8; ++b) red[(kg * 8 + b) * 64 + lane] = a[b];
        __syncthreads();
        { const int b = wave; float s = INP(3)[l * 12288 + n];
#pragma unroll
          for (int k2 = 0; k2 < 8; ++k2) s += red[(k2 * 8 + b) * 64 + lane];
          if (lane < 48) ((float*)(P.ws + (size_t)l * LAYER_BYTES + L_MOD))[b * 12288 + n] = s; }
        __syncthreads();
    }
}

template <int MODE>
DEV void phase_norm(const float* xin, const float* gvec, const float* mod, int seg_sh, int seg_sc, bf16_t* outb, float* outf, int bt, int lr, int nl) {
    const int tid_ = otid(); const int lane = tid_ & 63, wave = tid_ >> 6;
    const int gw = lr * 8 + wave, NGW = nl * 8;
    const int rpw = (2048 + NGW - 1) / NGW;
    int cb = -1; f32x4 sa[8], sb[8];
    for (int rl = gw * rpw; rl < (gw + 1) * rpw && rl < 2048; ++rl) {
        const int row = bt * 2048 + rl;
        const int b = row >> 11;
        if (b != cb) { cb = b;
#pragma unroll
            for (int j = 0; j < 8; ++j) { const int col = 4 * (lane + 64 * j); const f32x4 g = *(const f32x4*)(gvec + col);
                if (MODE == 0) { const f32x4 sc = *(const f32x4*)(mod + (size_t)b * 12288 + seg_sc * 2048 + col); sa[j] = g * (sc + 1.f); sb[j] = *(const f32x4*)(mod + (size_t)b * 12288 + seg_sh * 2048 + col); }
                else { sa[j] = g; } } }
        const f32x4* xr = (const f32x4*)(xin + (size_t)row * 2048) + lane;
        f32x4 v[8]; float s = 0.f;
#pragma unroll
        for (int j = 0; j < 8; ++j) { v[j] = xr[64 * j]; s += (v[j][0] * v[j][0] + v[j][1] * v[j][1]) + (v[j][2] * v[j][2] + v[j][3] * v[j][3]); }
        const float inv = 1.f / sqrtf(wave_sum(s, lane) * (1.f / 2048.f) + 1e-6f);
        if (MODE == 0) {
            u32x2* o = (u32x2*)(outb + (size_t)row * 2048) + lane;
#pragma unroll
            for (int j = 0; j < 8; ++j) { const f32x4 r = v[j] * inv * sa[j] + sb[j]; u32x2 w; w.x = cvt_pk_bf16(r[0], r[1]); w.y = cvt_pk_bf16(r[2], r[3]); o[64 * j] = w; }
        } else {
            f32x4* o = (f32x4*)(outf + (size_t)row * 2048) + lane;
#pragma unroll
            for (int j = 0; j < 8; ++j) o[64 * j] = v[j] * inv * sa[j];
        }
    }
}

DEV void cmp_item(const Params& P, int l, int item, unsigned char* lds) {
    const int tid = otid(), lane = tid & 63, w = tid >> 6, c = lane & 15, q = lane >> 4;
    const int kv = item >> 8, bg = (item >> 3) & 31, rt = item & 7, b = bg >> 2, g = bg & 3;
    unsigned char* wl = P.ws + (size_t)l * LAYER_BYTES;
    const bf16_t* src = (const bf16_t*)(P.ws + (kv ? Z_VC : Z_KC));
    const float* pos = INP(kv ? 9 : 6) + (size_t)l * 4096;
    const bf16_t* W1T = (const bf16_t*)(wl + (kv ? L_W1V : L_W1K));
    const bf16_t* W2T = (const bf16_t*)(wl + (kv ? L_W2V : L_W2K));
    const int n = rt * 16 + c; const bool valid = n < 127;
    const bf16_t* arow = src + ((size_t)(b * 2048 + 16 * (valid ? n : 0)) * 512 + g * 128);
    const bf16_t* brow = W1T + (size_t)c * 4096 + w * 512 + q * 8;
    f32x4 acc[8];
#pragma unroll
    for (int ct = 0; ct < 8; ++ct) acc[ct] = (f32x4){0.f, 0.f, 0.f, 0.f};
#pragma unroll 4
    for (int k2 = 0; k2 < 16; ++k2) {
        const int ks = w * 16 + k2, lp = ks >> 2, d = (ks & 3) * 32 + q * 8;
        const u32x4 a = *(const u32x4*)(arow + (size_t)lp * 512 + d);
        const f32x4 p0 = *(const f32x4*)(pos + ks * 32 + q * 8), p1 = *(const f32x4*)(pos + ks * 32 + q * 8 + 4);
        u32x4 bb[8];
#pragma unroll
        for (int ct = 0; ct < 8; ++ct) bb[ct] = *(const u32x4*)(brow + (size_t)ct * 16 * 4096 + k2 * 32);
        u32x4 a2;
        a2.x = cvt_pk_bf16(bflo(a.x) + p0[0], bfhi(a.x) + p0[1]); a2.y = cvt_pk_bf16(bflo(a.y) + p0[2], bfhi(a.y) + p0[3]);
        a2.z = cvt_pk_bf16(bflo(a.z) + p1[0], bfhi(a.z) + p1[1]); a2.w = cvt_pk_bf16(bflo(a.w) + p1[2], bfhi(a.w) + p1[3]);
        if (!valid) a2 = (u32x4){0u, 0u, 0u, 0u};
#pragma unroll
        for (int ct = 0; ct < 8; ++ct) acc[ct] = mfma16(as_bf16x8(a2), as_bf16x8(bb[ct]), acc[ct]);
    }
    float* part = (float*)(lds + 8192);
    bf16_t* hid = (bf16_t*)lds;
#pragma unroll
    for (int ct = 0; ct < 8; ++ct)
#pragma unroll
        for (int j = 0; j < 4; ++j) part[(w * 16 + q * 4 + j) * 128 + ct * 16 + c] = acc[ct][j];
    __syncthreads();
    {
        const int nn = tid >> 5, e4 = (tid & 31) * 4;
        f32x4 sum = *(const f32x4*)(part + nn * 128 + e4);
#pragma unroll
        for (int w2 = 1; w2 < 8; ++w2) sum = sum + *(const f32x4*)(part + (w2 * 16 + nn) * 128 + e4);
        u32x2 hv; hv.x = cvt_pk_bf16(gelu_t(sum[0]), gelu_t(sum[1])); hv.y = cvt_pk_bf16(gelu_t(sum[2]), gelu_t(sum[3]));
        *(u32x2*)(hid + nn * 136 + e4) = hv;
    }
    __syncthreads();
    f32x4 acc2 = {0.f, 0.f, 0.f, 0.f};
#pragma unroll
    for (int ks = 0; ks < 4; ++ks) {
        const u32x4 af = *(const u32x4*)(hid + c * 136 + ks * 32 + q * 8);
        const u32x4 bb = *(const u32x4*)(W2T + (size_t)(w * 16 + c) * 128 + ks * 32 + q * 8);
        acc2 = mfma16(as_bf16x8(af), as_bf16x8(bb), acc2);
    }
    if (kv == 0) { bf16_t* o = (bf16_t*)(P.ws + Z_KCMP) + ((size_t)bg * 128 + rt * 16 + q * 4) * 128 + w * 16 + c;
#pragma unroll
        for (int j = 0; j < 4; ++j) o[j * 128] = (bf16_t)(cvt_pk_bf16(acc2[j], 0.f) & 0xffff);
    } else { bf16_t* o = (bf16_t*)(P.ws + Z_VCMPT) + ((size_t)bg * 128 + w * 16 + c) * 128 + rt * 16 + q * 4;
        u32x2 wv; wv.x = cvt_pk_bf16(acc2[0], acc2[1]); wv.y = cvt_pk_bf16(acc2[2], acc2[3]); *(u32x2*)o = wv; }
    __syncthreads();
}

DEV void cmp_item32(const Params& P, int l, int item, unsigned char* lds) {
    const int tid = otid(), lane = tid & 63, w = tid >> 6, c = lane & 15, q = lane >> 4;
    const int kv = item >> 7, bg = (item >> 2) & 31, rt2 = item & 3, b = bg >> 2, g = bg & 3;
    unsigned char* wl = P.ws + (size_t)l * LAYER_BYTES;
    const bf16_t* src = (const bf16_t*)(P.ws + (kv ? Z_VC : Z_KC));
    const float* pos = INP(kv ? 9 : 6) + (size_t)l * 4096;
    const bf16_t* W1T = (const bf16_t*)(wl + (kv ? L_W1V : L_W1K));
    const bf16_t* W2T = (const bf16_t*)(wl + (kv ? L_W2V : L_W2K));
    const int n0 = rt2 * 32 + c, n1 = n0 + 16; const bool valid0 = n0 < 127, valid1 = n1 < 127;
    const bf16_t* arow0 = src + ((size_t)(b * 2048 + 16 * (valid0 ? n0 : 0)) * 512 + g * 128);
    const bf16_t* arow1 = src + ((size_t)(b * 2048 + 16 * (valid1 ? n1 : 0)) * 512 + g * 128);
    const bf16_t* brow = W1T + (size_t)c * 4096 + w * 512 + q * 8;
    f32x4 acc[2][8];
#pragma unroll
    for (int rr = 0; rr < 2; ++rr)
#pragma unroll
        for (int ct = 0; ct < 8; ++ct) acc[rr][ct] = (f32x4){0.f, 0.f, 0.f, 0.f};
#pragma unroll 2
    for (int k2 = 0; k2 < 16; ++k2) {
        const int ks = w * 16 + k2, lp = ks >> 2, d = (ks & 3) * 32 + q * 8;
        const u32x4 a0 = *(const u32x4*)(arow0 + (size_t)lp * 512 + d), a1 = *(const u32x4*)(arow1 + (size_t)lp * 512 + d);
        const f32x4 p0 = *(const f32x4*)(pos + ks * 32 + q * 8), p1 = *(const f32x4*)(pos + ks * 32 + q * 8 + 4);
        u32x4 bb[8];
#pragma unroll
        for (int ct = 0; ct < 8; ++ct) bb[ct] = *(const u32x4*)(brow + (size_t)ct * 16 * 4096 + k2 * 32);
        u32x4 x0, x1;
        x0.x = cvt_pk_bf16(bflo(a0.x) + p0[0], bfhi(a0.x) + p0[1]); x0.y = cvt_pk_bf16(bflo(a0.y) + p0[2], bfhi(a0.y) + p0[3]);
        x0.z = cvt_pk_bf16(bflo(a0.z) + p1[0], bfhi(a0.z) + p1[1]); x0.w = cvt_pk_bf16(bflo(a0.w) + p1[2], bfhi(a0.w) + p1[3]);
        x1.x = cvt_pk_bf16(bflo(a1.x) + p0[0], bfhi(a1.x) + p0[1]); x1.y = cvt_pk_bf16(bflo(a1.y) + p0[2], bfhi(a1.y) + p0[3]);
        x1.z = cvt_pk_bf16(bflo(a1.z) + p1[0], bfhi(a1.z) + p1[1]); x1.w = cvt_pk_bf16(bflo(a1.w) + p1[2], bfhi(a1.w) + p1[3]);
        if (!valid0) x0 = (u32x4){0u, 0u, 0u, 0u};
        if (!valid1) x1 = (u32x4){0u, 0u, 0u, 0u};
#pragma unroll
        for (int ct = 0; ct < 8; ++ct) { acc[0][ct] = mfma16(as_bf16x8(x0), as_bf16x8(bb[ct]), acc[0][ct]); acc[1][ct] = mfma16(as_bf16x8(x1), as_bf16x8(bb[ct]), acc[1][ct]); }
    }
    float* part = (float*)(lds + 9216);
    bf16_t* hid = (bf16_t*)lds;
#pragma unroll
    for (int rr = 0; rr < 2; ++rr)
#pragma unroll
        for (int ct = 0; ct < 8; ++ct)
#pragma unroll
            for (int j = 0; j < 4; ++j) part[(w * 32 + rr * 16 + q * 4 + j) * 128 + ct * 16 + c] = acc[rr][ct][j];
    __syncthreads();
    {
        const int nn = tid >> 4, e8 = (tid & 15) * 8;
#pragma unroll
        for (int hh = 0; hh < 2; ++hh) {
            f32x4 sum = *(const f32x4*)(part + nn * 128 + e8 + 4 * hh);
#pragma unroll
            for (int w2 = 1; w2 < 8; ++w2) sum = sum + *(const f32x4*)(part + (w2 * 32 + nn) * 128 + e8 + 4 * hh);
            u32x2 hv; hv.x = cvt_pk_bf16(gelu_t(sum[0]), gelu_t(sum[1])); hv.y = cvt_pk_bf16(gelu_t(sum[2]), gelu_t(sum[3]));
            *(u32x2*)(hid + nn * 136 + e8 + 4 * hh) = hv;
        }
    }
    __syncthreads();
#pragma unroll
    for (int rr = 0; rr < 2; ++rr) {
        f32x4 acc2 = {0.f, 0.f, 0.f, 0.f};
#pragma unroll
        for (int ks = 0; ks < 4; ++ks) {
            const u32x4 af = *(const u32x4*)(hid + (rr * 16 + c) * 136 + ks * 32 + q * 8);
            const u32x4 bb = *(const u32x4*)(W2T + (size_t)(w * 16 + c) * 128 + ks * 32 + q * 8);
            acc2 = mfma16(as_bf16x8(af), as_bf16x8(bb), acc2);
        }
        if (kv == 0) { bf16_t* o = (bf16_t*)(P.ws + Z_KCMP) + ((size_t)bg * 128 + rt2 * 32 + rr * 16 + q * 4) * 128 + w * 16 + c;
#pragma unroll
            for (int j = 0; j < 4; ++j) o[j * 128] = (bf16_t)(cvt_pk_bf16(acc2[j], 0.f) & 0xffff);
        } else { bf16_t* o = (bf16_t*)(P.ws + Z_VCMPT) + ((size_t)bg * 128 + w * 16 + c) * 128 + rt2 * 32 + rr * 16 + q * 4;
            u32x2 wv; wv.x = cvt_pk_bf16(acc2[0], acc2[1]); wv.y = cvt_pk_bf16(acc2[2], acc2[3]); *(u32x2*)o = wv; }
    }
    __syncthreads();
}

DEV void lru_item(const Params& P, int l, int item, unsigned char* lds) {
    const int tid = otid(), lane = tid & 63, w = tid >> 6, c = lane & 15, q = lane >> 4;
    const int b = item >> 5, n = (item >> 1) & 15, e = item & 1;
    const int C0 = n * 128, CO = C0 + e * 64;
    unsigned char* wl = P.ws + (size_t)l * LAYER_BYTES;
    constexpr int O_LX = 0, O_UB = 17408, O_UF = 34816, O_WA = 51200, O_WI = 68608, O_A = 86016, O_B = 102400;
    bf16_t* zlx = (bf16_t*)(P.ws + Z_LX); bf16_t* zly = (bf16_t*)(P.ws + Z_LY);
    __syncthreads();
    for (int id = tid; id < 2 * 64 * 16; id += 512) {
        const int which = id >> 10, r = (id >> 4) & 63, pc = id & 15;
        const bf16_t* s = (const bf16_t*)(wl + (which ? L_WI : L_WA)) + ((size_t)(n * 128 + e * 64 + r)) * 128 + pc * 8;
        *(u32x4*)(lds + (which ? O_WI : O_WA) + r * 272 + pc * 16) = *(const u32x4*)s;
    }
    const int chg = tid & 15, tl0 = tid >> 4;
    float cw[4][8], cbias[8];
#pragma unroll
    for (int i = 0; i < 8; ++i) { cbias[i] = INP(13)[l * 2048 + C0 + chg * 8 + i];
#pragma unroll
        for (int j = 0; j < 4; ++j) cw[j][i] = INP(12)[(l * 4 + j) * 2048 + C0 + chg * 8 + i]; }
    const int rt = w & 3, cp = w >> 2;
    float ba[2], bi[2], ll[2];
#pragma unroll
    for (int k2 = 0; k2 < 2; ++k2) { const int ch = l * 2048 + CO + (cp * 2 + k2) * 16 + c; ba[k2] = -1.4426950408889634f * INP(15)[ch]; bi[k2] = -1.4426950408889634f * INP(17)[ch];
        const float tl = 1.4426950408889634f * INP(18)[ch];
        ll[k2] = 8.f * (tl > 0.f ? -__builtin_amdgcn_logf(1.f + __builtin_amdgcn_exp2f(-tl)) : tl - __builtin_amdgcn_logf(1.f + __builtin_amdgcn_exp2f(tl))); }
    float* SEGA = (float*)(lds + 118784); float* SEGH = (float*)(lds + 120832); float* CARRY = (float*)(lds + 122880);
    if (tid < 64) CARRY[tid] = 0.f;
    float* UF = (float*)(lds + O_UF); float* Aa = (float*)(lds + O_A); float* Bb = (float*)(lds + O_B);
    const bf16_t* xcol = zlx + ((size_t)b * 2048) * 2048 + C0 + chg * 8;
    u32x4 xr[2][4];
#pragma unroll
    for (int p = 0; p < 2; ++p)
#pragma unroll
        for (int j = 0; j < 4; ++j) { const int t = tl0 + 32 * p + j - 3; xr[p][j] = (u32x4){0u, 0u, 0u, 0u}; if (t >= 0) xr[p][j] = *(const u32x4*)(xcol + (size_t)t * 2048); }
    u32x4 lyr = {0u, 0u, 0u, 0u}; bf16_t* lyp = zly;
    auto output = [&]() __attribute__((always_inline)) {
        const int tl = tid >> 3, c8 = (tid & 7) * 8;
        const u32x4 y = lyr;
        const f32x4 h0 = *(const f32x4*)(Bb + tl * 64 + c8), h1 = *(const f32x4*)(Bb + tl * 64 + c8 + 4);
        u32x4 o;
        o.x = cvt_pk_bf16(gelu_t(bflo(y.x)) * h0[0], gelu_t(bfhi(y.x)) * h0[1]); o.y = cvt_pk_bf16(gelu_t(bflo(y.y)) * h0[2], gelu_t(bfhi(y.y)) * h0[3]);
        o.z = cvt_pk_bf16(gelu_t(bflo(y.z)) * h1[0], gelu_t(bfhi(y.z)) * h1[1]); o.w = cvt_pk_bf16(gelu_t(bflo(y.w)) * h1[2], gelu_t(bfhi(y.w)) * h1[3]);
        *(u32x4*)lyp = o;
    };
    __syncthreads();
    bf16x8 wfa[4][2], wfi[4][2];
#pragma unroll
    for (int ks = 0; ks < 4; ++ks)
#pragma unroll
        for (int k2 = 0; k2 < 2; ++k2) { const int ct = cp * 2 + k2;
            wfa[ks][k2] = *(const bf16x8*)(lds + O_WA + (ct * 16 + c) * 272 + ks * 64 + q * 16);
            wfi[ks][k2] = *(const bf16x8*)(lds + O_WI + (ct * 16 + c) * 272 + ks * 64 + q * 16); }
    for (int ci = 0; ci < 32; ++ci) {
        const int t0 = ci * 64;
        if (ci > 0) output();
        lyp = zly + ((size_t)(b * 2048 + t0 + (tid >> 3))) * 2048 + CO + (tid & 7) * 8;
        lyr = *(const u32x4*)lyp;
#pragma unroll
        for (int pass = 0; pass < 2; ++pass) {
            const int tl = tl0 + 32 * pass;
            float u[8];
#pragma unroll
            for (int i = 0; i < 8; ++i) u[i] = cbias[i];
#pragma unroll
            for (int j = 0; j < 4; ++j) {
                const u32x4 x = xr[pass][j];
                u[0] += cw[j][0] * bflo(x.x); u[1] += cw[j][1] * bfhi(x.x); u[2] += cw[j][2] * bflo(x.y); u[3] += cw[j][3] * bfhi(x.y);
                u[4] += cw[j][4] * bflo(x.z); u[5] += cw[j][5] * bfhi(x.z); u[6] += cw[j][6] * bflo(x.w); u[7] += cw[j][7] * bfhi(x.w);
            }
            u32x4 pk; pk.x = cvt_pk_bf16(u[0], u[1]); pk.y = cvt_pk_bf16(u[2], u[3]); pk.z = cvt_pk_bf16(u[4], u[5]); pk.w = cvt_pk_bf16(u[6], u[7]);
            *(u32x4*)(lds + O_UB + tl * 272 + chg * 16) = pk;
            if ((chg >> 3) == e) { float* uf = UF + tl * 64 + (chg & 7) * 8;
                *(f32x4*)uf = (f32x4){u[0], u[1], u[2], u[3]}; *(f32x4*)(uf + 4) = (f32x4){u[4], u[5], u[6], u[7]}; }
        }
        if (ci + 1 < 32) {
#pragma unroll
            for (int p = 0; p < 2; ++p)
#pragma unroll
                for (int j = 0; j < 4; ++j) xr[p][j] = *(const u32x4*)(xcol + (size_t)(t0 + 64 + tl0 + 32 * p + j - 3) * 2048);
        }
        __syncthreads();
        {
            f32x4 ar[2], ai[2];
#pragma unroll
            for (int k2 = 0; k2 < 2; ++k2) { ar[k2] = (f32x4){0.f, 0.f, 0.f, 0.f}; ai[k2] = (f32x4){0.f, 0.f, 0.f, 0.f}; }
#pragma unroll
            for (int ks = 0; ks < 4; ++ks) {
                const bf16x8 af = *(const bf16x8*)(lds + O_UB + (rt * 16 + c) * 272 + ks * 64 + q * 16);
#pragma unroll
                for (int k2 = 0; k2 < 2; ++k2) { ar[k2] = mfma16(af, wfa[ks][k2], ar[k2]); ai[k2] = mfma16(af, wfi[ks][k2], ai[k2]); }
            }
#pragma unroll
            for (int k2 = 0; k2 < 2; ++k2)
#pragma unroll
                for (int j = 0; j < 4; ++j) {
                    const int tl = rt * 16 + q * 4 + j, cc = (cp * 2 + k2) * 16 + c;
                    const float uu = UF[tl * 64 + cc];
                    const float r = frcp(1.f + __builtin_amdgcn_exp2f(__builtin_fmaf(ar[k2][j], -1.4426950408889634f, ba[k2])));
                    const float ig = frcp(1.f + __builtin_amdgcn_exp2f(__builtin_fmaf(ai[k2][j], -1.4426950408889634f, bi[k2])));
                    const float av = __builtin_amdgcn_exp2f(r * ll[k2]);
                    const float om = __builtin_fmaf(-av, av, 1.f);
                    Aa[tl * 64 + cc] = av;
                    Bb[tl * 64 + cc] = __builtin_amdgcn_sqrtf(fmaxf(om, 0.f)) * (ig * uu);
                }
        }
        __syncthreads();
        {
            float av8[8], hl[8]; float Acum = 1.f, h = 0.f;
#pragma unroll
            for (int k = 0; k < 8; ++k) { const float a = Aa[(w * 8 + k) * 64 + lane], bb2 = Bb[(w * 8 + k) * 64 + lane]; h = a * h + bb2; Acum *= a; av8[k] = Acum; hl[k] = h; }
            SEGA[w * 64 + lane] = Acum; SEGH[w * 64 + lane] = h;
            __syncthreads();
            float hin = CARRY[(ci & 1) * 64 + lane];
            float sa7[7], sh7[7];
#pragma unroll
            for (int s2 = 0; s2 < 7; ++s2) { sa7[s2] = SEGA[s2 * 64 + lane]; sh7[s2] = SEGH[s2 * 64 + lane]; }
#pragma unroll
            for (int s2 = 0; s2 < 7; ++s2) if (s2 < w) hin = sa7[s2] * hin + sh7[s2];
#pragma unroll
            for (int k = 0; k < 8; ++k) { hl[k] = hl[k] + av8[k] * hin; Bb[(w * 8 + k) * 64 + lane] = hl[k]; }
            if (w == 7) CARRY[((ci + 1) & 1) * 64 + lane] = hl[7];
        }
        __syncthreads();
    }
    output();
    __syncthreads();
}

constexpr int A_KC = 0, A_VC = 34816, A_K = 0, A_V = 17408, A_E = 69632, A_CAR = 102400, A_IMP = 118784, A_SEL = 142336, A_OST = 71680;
constexpr float L2E = 1.4426950408889634f;

DEV void attn_item(const Params& P, int b, int g, int qt, unsigned char* lds) {
    const int tid = otid(), lane = tid & 63, w = tid >> 6, c = lane & 15, q = lane >> 4;
    const int hg = w >> 1, th = w & 1, head = g * 4 + hg, bg = b * 4 + g;
    const int tq0 = 64 * qt + 32 * th;
    const size_t rowbase = (size_t)b * 2048;
    bf16_t* zq = (bf16_t*)(P.ws + Z_Q);
    bf16_t* zo = PROBE_CHECK ? (bf16_t*)(P.ws + WS_OBUF) : zq;

    bf16x8 QF[2][4];
#pragma unroll
    for (int nt = 0; nt < 2; ++nt)
#pragma unroll
        for (int ks = 0; ks < 4; ++ks) QF[nt][ks] = *(const bf16x8*)(zq + (rowbase + tq0 + 16 * nt + c) * 2048 + head * 128 + ks * 32 + q * 8);
    float gate[3][2];
#pragma unroll
    for (int nt = 0; nt < 2; ++nt)
#pragma unroll
        for (int br = 0; br < 3; ++br) { const unsigned short gv = ((const bf16_t*)(P.ws + Z_GATE))[(rowbase + tq0 + 16 * nt + c) * 64 + head * 3 + br]; gate[br][nt] = sigm(bflo((unsigned)gv)); }

    __syncthreads();
    {
        const bf16_t* kc = (const bf16_t*)(P.ws + Z_KCMP) + (size_t)bg * 16384; const bf16_t* vc = (const bf16_t*)(P.ws + Z_VCMPT) + (size_t)bg * 16384;
#pragma unroll
        for (int i = 0; i < 4; ++i) { const int id = tid + 512 * i, r = id >> 4, pc = id & 15;
            { const int kk = r & 31, rho = (r & ~31) + ((kk >> 2) & 1) * 16 + (kk >> 3) * 4 + (kk & 3);
              *(u32x4*)(lds + A_KC + rho * 272 + pc * 16) = *(const u32x4*)(kc + r * 128 + pc * 8); }
            *(u32x4*)(lds + A_VC + r * 272 + pc * 16) = *(const u32x4*)(vc + r * 128 + pc * 8); }
    }
    __syncthreads();

    f32x4 o[8][2];
#pragma unroll
    for (int dt = 0; dt < 8; ++dt)
#pragma unroll
        for (int nt = 0; nt < 2; ++nt) o[dt][nt] = (f32x4){0.f, 0.f, 0.f, 0.f};
    {
        f32x4 s[4][2][2];
#pragma unroll
        for (int ch = 0; ch < 4; ++ch)
#pragma unroll
            for (int u = 0; u < 2; ++u)
#pragma unroll
                for (int nt = 0; nt < 2; ++nt) s[ch][u][nt] = (f32x4){0.f, 0.f, 0.f, 0.f};
        const int nch = (4 * qt + 2) / 32 + 1;
#pragma unroll
        for (int ch = 0; ch < 4; ++ch) if (ch < nch) {
#pragma unroll
            for (int ks = 0; ks < 4; ++ks)
#pragma unroll
                for (int u = 0; u < 2; ++u) {
                    const bf16x8 kf = *(const bf16x8*)(lds + A_KC + (ch * 32 + u * 16 + c) * 272 + ks * 64 + q * 16);
#pragma unroll
                    for (int nt = 0; nt < 2; ++nt) s[ch][u][nt] = mfma16(kf, QF[nt][ks], s[ch][u][nt]);
                }
        }
        float* E = (float*)(lds + A_E); float* CAR = (float*)(lds + A_CAR);
#pragma unroll
        for (int nt = 0; nt < 2; ++nt) {
            const int t = tq0 + 16 * nt + c, nmax = (t - 31) >> 4;
            float mx = -1e30f;
#pragma unroll
            for (int ch = 0; ch < 4; ++ch)
#pragma unroll
                for (int u = 0; u < 2; ++u)
#pragma unroll
                    for (int j = 0; j < 4; ++j) { const int n = ch * 32 + q * 8 + u * 4 + j; const float v = s[ch][u][nt][j] * L2E; s[ch][u][nt][j] = v; if (n <= nmax) mx = fmaxf(mx, v); }
            mx = fmaxf(mx, shx(mx, 16, lane)); mx = fmaxf(mx, shx(mx, 32, lane));
            float sum = 0.f;
#pragma unroll
            for (int ch = 0; ch < 4; ++ch)
#pragma unroll
                for (int u = 0; u < 2; ++u)
#pragma unroll
                    for (int j = 0; j < 4; ++j) { const int n = ch * 32 + q * 8 + u * 4 + j; const float p = (n <= nmax) ? __builtin_amdgcn_exp2f(s[ch][u][nt][j] - mx) : 0.f; s[ch][u][nt][j] = p; sum += p; }
            sum += shx(sum, 16, lane); sum += shx(sum, 32, lane);
            const float inv = frcp(fmaxf(sum, 1e-30f));
            const int tl = 32 * th + 16 * nt + c;
#pragma unroll
            for (int ch = 0; ch < 4; ++ch) {
#pragma unroll
                for (int u = 0; u < 2; ++u) s[ch][u][nt] = s[ch][u][nt] * inv;
                const f32x4 pa = s[ch][0][nt], pb = s[ch][1][nt];
                E[(hg * 64 + tl) * 32 + 8 * ch + 2 * q] = (pa[0] + pa[1]) + (pa[2] + pa[3]);
                E[(hg * 64 + tl) * 32 + 8 * ch + 2 * q + 1] = pa[3] + ((pb[0] + pb[1]) + (pb[2] + pb[3]));
                CAR[(hg * 64 + tl) * 16 + 4 * ch + q] = pb[3];
            }
        }
#pragma unroll
        for (int ch = 0; ch < 4; ++ch) if (ch < nch) {
            bf16x8 pf[2];
#pragma unroll
            for (int nt = 0; nt < 2; ++nt) pf[nt] = as_bf16x8(pack8(s[ch][0][nt], s[ch][1][nt]));
#pragma unroll
            for (int dt = 0; dt < 8; ++dt) {
                const bf16x8 vf = *(const bf16x8*)(lds + A_VC + (dt * 16 + c) * 272 + (ch * 32 + q * 8) * 2);
#pragma unroll
                for (int nt = 0; nt < 2; ++nt) o[dt][nt] = mfma16(vf, pf[nt], o[dt][nt]);
            }
        }
    }
    u32x4 pk[2], pv[2];
#pragma unroll
    for (int i = 0; i < 2; ++i) { const int id = tid + 512 * i;
        pk[i] = *(const u32x4*)((const bf16_t*)(P.ws + Z_KS) + (rowbase + 64 * qt + (id >> 4)) * 512 + g * 128 + (id & 15) * 8);
        pv[i] = *(const u32x4*)((const bf16_t*)(P.ws + Z_VST) + ((size_t)bg * 128 + (id >> 3)) * 2048 + 64 * qt + (id & 7) * 8); }
    __syncthreads();
    {
        const float* E = (const float*)(lds + A_E); const float* CAR = (const float*)(lds + A_CAR); float* IMP = (float*)(lds + A_IMP);
        const int tl = tid >> 3, jg = tid & 7;
#pragma unroll
        for (int jj = 0; jj < 4; ++jj) { const int j = jg * 4 + jj; float v = 0.f;
#pragma unroll
            for (int h = 0; h < 4; ++h) { v += E[(h * 64 + tl) * 32 + j]; if ((j & 1) == 0 && j >= 2) v += CAR[(h * 64 + tl) * 16 + (j >> 1) - 1]; }
            IMP[tl * 32 + j] = v; }
        __syncthreads();
        const int cur = qt, nforced = cur >= 2 ? 3 : cur + 1;
        unsigned bits = 0u;
#pragma unroll
        for (int jj = 0; jj < 4; ++jj) { const int j = jg * 4 + jj; bool sel;
            if (j > cur) sel = false;
            else if (j == 0 || j > cur - 2) sel = true;
            else { const float v = IMP[tl * 32 + j]; int cnt = 0;
                for (int j2 = 1; j2 <= cur - 2; ++j2) { const float v2 = IMP[tl * 32 + j2]; cnt += (v2 > v || (v2 == v && j2 < j)) ? 1 : 0; }
                sel = cnt < 16 - nforced; }
            bits |= sel ? (1u << j) : 0u; }
        bits |= shxu(bits, 1, lane); bits |= shxu(bits, 2, lane); bits |= shxu(bits, 4, lane);
        if (jg == 0) ((unsigned*)(lds + A_SEL))[tl] = bits;
    }
    __syncthreads();
    unsigned selm[2];
#pragma unroll
    for (int nt = 0; nt < 2; ++nt) selm[nt] = ((const unsigned*)(lds + A_SEL))[32 * th + 16 * nt + c];
    unsigned char* ost = lds + A_OST + w * 8704;
#pragma unroll
    for (int nt = 0; nt < 2; ++nt)
#pragma unroll
        for (int dt = 0; dt < 8; ++dt) {
            const f32x4 r = o[dt][nt] * gate[0][nt];
            u32x2 wv; wv.x = cvt_pk_bf16(r[0], r[1]); wv.y = cvt_pk_bf16(r[2], r[3]);
            *(u32x2*)(ost + (16 * nt + c) * 272 + (16 * dt + 4 * q) * 2) = wv;
        }

    constexpr int KVB = 35840;
#pragma unroll 1
    for (int br = 0; br < 2; ++br) {
        const bf16_t* Ks = (const bf16_t*)(P.ws + (br ? Z_KW : Z_KS)); const bf16_t* Vs = (const bf16_t*)(P.ws + (br ? Z_VWT : Z_VST));
        const int ntile = br ? (qt + 1 < 9 ? qt + 1 : 9) : qt + 1;
        unsigned sm[2]; int lo[2], tq[2];
#pragma unroll
        for (int nt = 0; nt < 2; ++nt) { tq[nt] = tq0 + 16 * nt + c; sm[nt] = br ? 0xffffffffu : selm[nt]; lo[nt] = br ? tq[nt] - 511 : -1; }
        float mrow[2] = {-1e30f, -1e30f}, lrow[2] = {0.f, 0.f};
#pragma unroll
        for (int dt = 0; dt < 8; ++dt)
#pragma unroll
            for (int nt = 0; nt < 2; ++nt) o[dt][nt] = (f32x4){0.f, 0.f, 0.f, 0.f};
        auto tile_of = [&](int i) { return br ? qt - i : (i == 0 ? qt : i - 1); };
        auto prefetch = [&](int j) {
#pragma unroll
            for (int i = 0; i < 2; ++i) { const int id = tid + 512 * i;
                pk[i] = *(const u32x4*)(Ks + (rowbase + 64 * j + (id >> 4)) * 512 + g * 128 + (id & 15) * 8);
                pv[i] = *(const u32x4*)(Vs + ((size_t)bg * 128 + (id >> 3)) * 2048 + 64 * j + (id & 7) * 8); }
        };
        auto stage = [&](int buf) {
#pragma unroll
            for (int i2 = 0; i2 < 2; ++i2) { const int id = tid + 512 * i2, r = id >> 4, kk = r & 31, rho = (r & ~31) + ((kk >> 2) & 1) * 16 + (kk >> 3) * 4 + (kk & 3);
                *(u32x4*)(lds + buf * KVB + rho * 272 + (id & 15) * 16) = pk[i2];
                *(u32x4*)(lds + buf * KVB + 17408 + (id >> 3) * 144 + (id & 7) * 16) = pv[i2]; }
        };
        __syncthreads();
        stage(0);
        if (ntile > 1) prefetch(tile_of(1));
        __syncthreads();
#pragma unroll 1
        for (int i = 0; i < ntile; ++i) {
            const int j = tile_of(i);
            const unsigned char* kb = lds + (i & 1) * KVB; const unsigned char* vb = kb + 17408;
            f32x4 s[2][2][2];
#pragma unroll
            for (int ch = 0; ch < 2; ++ch)
#pragma unroll
                for (int u = 0; u < 2; ++u)
#pragma unroll
                    for (int nt = 0; nt < 2; ++nt) s[ch][u][nt] = (f32x4){0.f, 0.f, 0.f, 0.f};
            {
                const unsigned char* kp = kb + c * 272 + q * 16;
#define KFRAG(f) (*(const bf16x8*)(kp + (((f) >> 3) * 32 + ((f) & 1) * 16) * 272 + (((f) >> 1) & 3) * 64))
                bf16x8 kfa = KFRAG(0), kfb = KFRAG(1);
                __builtin_amdgcn_sched_barrier(0);
#pragma unroll
                for (int f = 0; f < 16; ++f) {
                    const int ch = f >> 3, ks = (f >> 1) & 3, u = f & 1;
                    const bf16x8 kf = (f & 1) ? kfb : kfa;
#pragma unroll
                    for (int nt = 0; nt < 2; ++nt) s[ch][u][nt] = mfma16(kf, QF[nt][ks], s[ch][u][nt]);
                    if (f + 2 < 16) { if (f & 1) kfb = KFRAG(f + 2); else kfa = KFRAG(f + 2); }
                    __builtin_amdgcn_sched_barrier(0);
                }
#undef KFRAG
            }
            const bool needkey = (j == qt) || (br && j == qt - 8);
            const bool sel0 = (sm[0] >> j) & 1u, sel1 = (sm[1] >> j) & 1u;
            const bool allsel = __builtin_amdgcn_ballot_w64(!(sel0 && sel1)) == 0ull;
            if (needkey) {
#pragma unroll
                for (int nt = 0; nt < 2; ++nt) { const bool sl = nt ? sel1 : sel0;
#pragma unroll
                    for (int ch = 0; ch < 2; ++ch)
#pragma unroll
                        for (int u = 0; u < 2; ++u)
#pragma unroll
                            for (int jj = 0; jj < 4; ++jj) { const int key = 64 * j + ch * 32 + q * 8 + u * 4 + jj;
                                const bool ok = sl && key <= tq[nt] && key >= lo[nt]; s[ch][u][nt][jj] = ok ? s[ch][u][nt][jj] : -1e30f; } }
            } else if (!allsel) {
#pragma unroll
                for (int nt = 0; nt < 2; ++nt) { const bool sl = nt ? sel1 : sel0;
#pragma unroll
                    for (int ch = 0; ch < 2; ++ch)
#pragma unroll
                        for (int u = 0; u < 2; ++u)
#pragma unroll
                            for (int jj = 0; jj < 4; ++jj) s[ch][u][nt][jj] = sl ? s[ch][u][nt][jj] : -1e30f; }
            }
            float mnew[2];
#pragma unroll
            for (int nt = 0; nt < 2; ++nt) {
                float mx = -1e30f;
#pragma unroll
                for (int ch = 0; ch < 2; ++ch)
#pragma unroll
                    for (int u = 0; u < 2; ++u) mx = fmaxf(fmaxf(mx, fmaxf(s[ch][u][nt][0], s[ch][u][nt][1])), fmaxf(s[ch][u][nt][2], s[ch][u][nt][3]));
                mx = fmaxf(mx, shx(mx, 16, lane)); mx = fmaxf(mx, shx(mx, 32, lane));
                mnew[nt] = fmaxf(mrow[nt], mx * L2E);
            }
            if (__builtin_amdgcn_ballot_w64(mnew[0] > mrow[0] + 8.f || mnew[1] > mrow[1] + 8.f) != 0ull) {
#pragma unroll
                for (int nt = 0; nt < 2; ++nt) { const float alpha = __builtin_amdgcn_exp2f(mrow[nt] - mnew[nt]); mrow[nt] = mnew[nt]; lrow[nt] *= alpha;
#pragma unroll
                    for (int dt = 0; dt < 8; ++dt) o[dt][nt] = o[dt][nt] * alpha; }
            }
#pragma unroll
            for (int nt = 0; nt < 2; ++nt) {
                const float nm = -mrow[nt]; float ps = 0.f;
#pragma unroll
                for (int ch = 0; ch < 2; ++ch)
#pragma unroll
                    for (int u = 0; u < 2; ++u)
#pragma unroll
                        for (int jj = 0; jj < 4; ++jj) { const float p = __builtin_amdgcn_exp2f(__builtin_fmaf(s[ch][u][nt][jj], L2E, nm)); s[ch][u][nt][jj] = p; ps += p; }
                lrow[nt] += ps;
            }
            {
                bf16x8 pf[2][2];
#pragma unroll
                for (int ch = 0; ch < 2; ++ch)
#pragma unroll
                    for (int nt = 0; nt < 2; ++nt) pf[ch][nt] = as_bf16x8(pack8(s[ch][0][nt], s[ch][1][nt]));
                const unsigned char* vp = vb + c * 144 + q * 16;
#define VFRAG(f) (*(const bf16x8*)(vp + ((f) & 7) * 16 * 144 + ((f) >> 3) * 64))
                bf16x8 vfa = VFRAG(0), vfb = VFRAG(1);
                __builtin_amdgcn_sched_barrier(0);
#pragma unroll
                for (int f = 0; f < 16; ++f) {
                    const int ch = f >> 3, dt = f & 7;
                    const bf16x8 vf = (f & 1) ? vfb : vfa;
#pragma unroll
                    for (int nt = 0; nt < 2; ++nt) o[dt][nt] = mfma16(vf, pf[ch][nt], o[dt][nt]);
                    if (f + 2 < 16) { if (f & 1) vfb = VFRAG(f + 2); else vfa = VFRAG(f + 2); }
                    __builtin_amdgcn_sched_barrier(0);
                }
#undef VFRAG
            }
            if (i + 1 < ntile) { stage((i + 1) & 1); if (i + 2 < ntile) prefetch(tile_of(i + 2)); }
            __syncthreads();
        }
        if (br == 0) {
#pragma unroll
            for (int i = 0; i < 2; ++i) { const int id = tid + 512 * i;
                pk[i] = *(const u32x4*)((const bf16_t*)(P.ws + Z_KW) + (rowbase + 64 * qt + (id >> 4)) * 512 + g * 128 + (id & 15) * 8);
                pv[i] = *(const u32x4*)((const bf16_t*)(P.ws + Z_VWT) + ((size_t)bg * 128 + (id >> 3)) * 2048 + 64 * qt + (id & 7) * 8); }
        }
#pragma unroll
        for (int nt = 0; nt < 2; ++nt) {
            float lsum = lrow[nt]; lsum += shx(lsum, 16, lane); lsum += shx(lsum, 32, lane);
            const float sc = gate[1 + br][nt] * frcp(fmaxf(lsum, 1e-30f));
#pragma unroll
            for (int dt = 0; dt < 8; ++dt) {
                u32x2* p = (u32x2*)(ost + (16 * nt + c) * 272 + (16 * dt + 4 * q) * 2);
                const u32x2 pv2 = *p; const f32x4 r = o[dt][nt] * sc;
                u32x2 wv; wv.x = cvt_pk_bf16(bflo(pv2.x) + r[0], bfhi(pv2.x) + r[1]); wv.y = cvt_pk_bf16(bflo(pv2.y) + r[2], bfhi(pv2.y) + r[3]);
                *p = wv;
            }
        }
    }
#pragma unroll
    for (int i = 0; i < 8; ++i) { const int r = (lane >> 4) + 4 * i, ck = lane & 15;
        *(u32x4*)(zo + (rowbase + tq0 + r) * 2048 + head * 128 + ck * 8) = *(const u32x4*)(ost + r * 272 + ck * 16); }
}

#if PROBE_CHECK
DEV float bfv(const bf16_t* p) { return __builtin_bit_cast(float, (unsigned)(*p) << 16); }
DEV void nsa_check(const Params& P, unsigned char* lds) {
    const int tid = otid(), bid = obid();
    const int b = bid & 7, g = (bid >> 3) & 3, t = (bid * 677 + 331) & 2047, bg = b * 4 + g, cur = t >> 6;
    const int h = tid >> 7, d = tid & 127;
    float* qs = (float*)lds;
    float* sc = (float*)(lds + 2048);
    float* impv = (float*)(lds + 2048 + 32768);
    unsigned* selw = (unsigned*)(lds + 2048 + 32768 + 128);
    float* red = (float*)(lds + 2048 + 32768 + 256);
    const bf16_t* zq = (const bf16_t*)(P.ws + Z_Q);
    const size_t row = (size_t)b * 2048 + t;
    __syncthreads();
    qs[h * 128 + d] = bfv(zq + row * 2048 + (g * 4 + h) * 128 + d);
    __syncthreads();
    const int nvis = t >= 31 ? ((t - 31) >> 4) + 1 : 0;
    { const int n = d; float s = -INFINITY;
      if (n < nvis) { s = 0.f; const bf16_t* kr = (const bf16_t*)(P.ws + Z_KCMP) + ((size_t)bg * 128 + n) * 128; for (int k = 0; k < 128; ++k) s += qs[h * 128 + k] * bfv(kr + k); }
      sc[h * 2048 + n] = s; }
    __syncthreads();
    if (tid < 4) { float m = -INFINITY; for (int n = 0; n < 128; ++n) m = fmaxf(m, sc[tid * 2048 + n]); if (!(m > -INFINITY)) m = 0.f;
        float sum = 0.f; for (int n = 0; n < 128; ++n) { const float p = __expf(sc[tid * 2048 + n] - m); sc[tid * 2048 + n] = p; sum += p; }
        const float inv = 1.f / fmaxf(sum, 1e-30f); for (int n = 0; n < 128; ++n) sc[tid * 2048 + n] *= inv; }
    __syncthreads();
    float o_cmp = 0.f;
    { const bf16_t* vr = (const bf16_t*)(P.ws + Z_VCMPT) + ((size_t)bg * 128 + d) * 128; for (int n = 0; n < 127; ++n) o_cmp += sc[h * 2048 + n] * bfv(vr + n); }
    if (tid < 32) { float v = 0.f; for (int hh = 0; hh < 4; ++hh) for (int n = 4 * tid - 1; n <= 4 * tid + 3; ++n) if (n >= 0 && n <= 126) v += sc[hh * 2048 + n]; impv[tid] = v; }
    __syncthreads();
    if (tid == 0) {
        unsigned mask = 0u;
        for (int pick = 0; pick < 16; ++pick) { int best = -1; float bv = 0.f;
            for (int j = 0; j < 32; ++j) { if ((mask >> j) & 1u) continue;
                const bool valid = j <= cur, forced = (j == 0) || (valid && j > cur - 2);
                const float v = forced ? impv[j] + 1e4f : (valid ? impv[j] : -1.f);
                if (best < 0 || v > bv) { best = j; bv = v; } }
            mask |= 1u << best; }
        selw[0] = mask; }
    __syncthreads();
    const unsigned selmask = selw[0];
    float o_br[2];
    for (int br = 0; br < 2; ++br) {
        const bf16_t* Ks = (const bf16_t*)(P.ws + (br ? Z_KW : Z_KS)); const bf16_t* Vs = (const bf16_t*)(P.ws + (br ? Z_VWT : Z_VST));
        __syncthreads();
        for (int cidx = 0; cidx < 16; ++cidx) { const int key = cidx * 128 + d; float s = -INFINITY;
            const bool ok = br ? (key <= t && key > t - 512) : (key <= t && ((selmask >> (key >> 6)) & 1u));
            if (ok) { s = 0.f; const bf16_t* kr = Ks + ((size_t)b * 2048 + key) * 512 + g * 128; for (int k = 0; k < 128; ++k) s += qs[h * 128 + k] * bfv(kr + k); }
            sc[h * 2048 + key] = s; }
        __syncthreads();
        if (tid < 4) { float m = -INFINITY; for (int n = 0; n < 2048; ++n) m = fmaxf(m, sc[tid * 2048 + n]); if (!(m > -INFINITY)) m = 0.f;
            float sum = 0.f; for (int n = 0; n < 2048; ++n) { const float p = __expf(sc[tid * 2048 + n] - m); sc[tid * 2048 + n] = p; sum += p; }
            const float inv = 1.f / fmaxf(sum, 1e-30f); for (int n = 0; n < 2048; ++n) sc[tid * 2048 + n] *= inv; }
        __syncthreads();
        float acc = 0.f; const bf16_t* vr = Vs + ((size_t)bg * 128 + d) * 2048;
        for (int key = 0; key <= t; ++key) acc += sc[h * 2048 + key] * bfv(vr + key);
        o_br[br] = acc;
    }
    const bf16_t* gz = (const bf16_t*)(P.ws + Z_GATE) + row * 64 + (g * 4 + h) * 3;
    const float g0 = 1.f / (1.f + __expf(-bfv(gz))), g1 = 1.f / (1.f + __expf(-bfv(gz + 1))), g2 = 1.f / (1.f + __expf(-bfv(gz + 2)));
    const float oref = g0 * o_cmp + g1 * o_br[0] + g2 * o_br[1];
    const float ofast = bfv((const bf16_t*)(P.ws + WS_OBUF) + row * 2048 + (g * 4 + h) * 128 + d);
    __syncthreads();
    red[tid] = (ofast - oref) * (ofast - oref); red[512 + tid] = oref * oref;
    __syncthreads();
    if (tid == 0) { float a = 0.f, r2 = 0.f; for (int i = 0; i < 512; ++i) { a += red[i]; r2 += red[512 + i]; }
        ((float*)(P.ws + WS_CHK))[bid] = sqrtf(a / fmaxf(r2, 1e-30f)); }
    __syncthreads();
}
#endif


DEV void phase_attn(const Params& P, unsigned char* lds, int b, int lr, int nl) {
    for (int idx = lr; idx < 128; idx += nl) {
        const int k = idx >> 5, r = idx & 31, g = k;
        const int qt = (k & 1) ? r : 31 - r;
        attn_item(P, b, g, qt, lds);
    }
    __syncthreads();
}

#define XB_TMO      128
#define XB_XCNT(j)  (256  + 64 * (j))
#define XB_XSUB(j)  (1280 + 64 * (j))
#define XB_XGEN(j)  (2304 + 64 * (j))
#define XB_TOP      3328
#define XB_TOPGEN   3392
#define XCD_BAR_WORDS 3456
#define XB_LSUB(j)  (3456 + 16 * (j))
#define XB_LGEN(j)  (3712 + 16 * (j))
#define XB_SPIN_CAP (1u << 18)
DEV unsigned xb_ld(unsigned* p)              { return __hip_atomic_load(p, __ATOMIC_RELAXED, __HIP_MEMORY_SCOPE_AGENT); }
DEV unsigned xb_add(unsigned* p, unsigned v) { return __hip_atomic_fetch_add(p, v, __ATOMIC_RELAXED, __HIP_MEMORY_SCOPE_AGENT); }
DEV unsigned xb_xcc_id() { return (unsigned)__builtin_amdgcn_s_getreg((3 << 11) | 20) & 0xFu; }
#define XB_SPIN(cond, bar) do { unsigned _sp = 0; while (cond) { __builtin_amdgcn_s_sleep(1); \
    if ((++_sp & 255u) == 0u) { if (xb_ld(&(bar)[XB_TMO])) break; if (_sp > XB_SPIN_CAP) { atomicAdd(&(bar)[XB_TMO], 1u); break; } } } } while (0)
struct XcdBarrier { unsigned* bar; unsigned x; volatile LAS unsigned* st; };
DEV XcdBarrier xcd_barrier_post(unsigned* bar, volatile LAS unsigned* st) {
    XcdBarrier b; b.bar = bar; b.x = xb_xcc_id(); b.st = st;
    if (threadIdx.x == 0) st[3] = xb_add(&bar[XB_XCNT(b.x)], 1u);
    return b;
}
DEV void xcd_barrier_complete(unsigned* bar, unsigned x, unsigned& nloc, unsigned& nx, unsigned& gidx) {
    const unsigned G = gridDim.x * gridDim.y * gridDim.z;
    unsigned sum, cnt, mine, below, sp = 0u;
    for (;;) {
        sum = 0u; cnt = 0u; mine = 0u; below = 0u;
#pragma unroll 1
        for (unsigned j = 0; j < 16; ++j) { const unsigned c = xb_ld(&bar[XB_XCNT(j)]); sum += c; cnt += (c > 0u) ? 1u : 0u; mine = (j == x) ? c : mine; below += (c > 0u && j < x) ? 1u : 0u; }
        if (sum == G) break;
        __builtin_amdgcn_s_sleep(1);
        if ((++sp & 255u) == 0u) { if (xb_ld(&bar[XB_TMO])) break; if (sp > XB_SPIN_CAP) { atomicAdd(&bar[XB_TMO], 1u); break; } }
    }
    nloc = mine > 0u ? mine : 1u; nx = cnt > 0u ? cnt : 1u; gidx = below;
}
DEV void xcd_barrier(const XcdBarrier& b) {
    asm volatile("s_waitcnt vmcnt(0)" ::: "memory");
    __syncthreads();
    if (threadIdx.x == 0) {
        unsigned* bar = b.bar;
        __builtin_amdgcn_s_waitcnt(0);
        unsigned nloc = b.st[0], nx = b.st[1];
        if (nloc == 0u) { unsigned gidx; xcd_barrier_complete(bar, b.x, nloc, nx, gidx); b.st[0] = nloc; b.st[1] = nx; b.st[2] = gidx; }
        const unsigned old = xb_add(&bar[XB_XSUB(b.x)], 1u);
        const unsigned gen = old / nloc;
        if (old + 1u == (gen + 1u) * nloc) {
            __builtin_amdgcn_fence(__ATOMIC_RELEASE, "agent");
            asm volatile("s_waitcnt vmcnt(0)" ::: "memory");
            const unsigned og = xb_add(&bar[XB_TOP], 1u);
            const unsigned tg = og / nx;
            if (og + 1u == (tg + 1u) * nx) xb_add(&bar[XB_TOPGEN], 1u);
            else XB_SPIN(xb_ld(&bar[XB_TOPGEN]) == tg, bar);
            __builtin_amdgcn_fence(__ATOMIC_ACQUIRE, "agent");
            xb_add(&bar[XB_XGEN(b.x)], 1u);
            asm volatile("s_waitcnt vmcnt(0)" ::: "memory");
        } else {
            XB_SPIN(xb_ld(&bar[XB_XGEN(b.x)]) == gen, bar);
            __builtin_amdgcn_fence(__ATOMIC_ACQUIRE, "agent");
            asm volatile("s_waitcnt vmcnt(0)" ::: "memory");
        }
    }
    __syncthreads();
}

DEV void xcd_local_barrier(const XcdBarrier& b) {
    asm volatile("s_waitcnt vmcnt(0)" ::: "memory");
    __syncthreads();
    if (threadIdx.x == 0) {
        unsigned* bar = b.bar;
        __builtin_amdgcn_s_waitcnt(0);
        const unsigned nloc = b.st[0];
        const unsigned old = xb_add(&bar[XB_LSUB(b.x)], 1u), gen = old / nloc;
        if (old + 1u == (gen + 1u) * nloc) xb_add(&bar[XB_LGEN(b.x)], 1u);
        else XB_SPIN(xb_ld(&bar[XB_LGEN(b.x)]) == gen, bar);
        __builtin_amdgcn_fence(__ATOMIC_ACQUIRE, "agent");
        asm volatile("s_waitcnt vmcnt(0)" ::: "memory");
    }
    __syncthreads();
}

__global__ void __launch_bounds__(512, 2) mega_fwd(Params P) {
    unsigned char* lds = g_lds;
    if (threadIdx.x == 0) {
#pragma unroll
        for (int i = 0; i < 28; ++i) ((LAS unsigned long long*)((LAS unsigned char*)g_lds + TAB_OFF))[i] = (unsigned long long)P.in[i];
    }
    const int lo = P.ph_lo, hi = P.ph_hi;
    volatile LAS unsigned* bst = (volatile LAS unsigned*)((LAS unsigned char*)lds + (LDS_BYTES - 64));
    if (threadIdx.x == 0) { bst[0] = 0u; bst[1] = 0u; bst[2] = 0u; bst[3] = 0u; }
    __syncthreads();
    XcdBarrier xbar = xcd_barrier_post((unsigned*)(P.ws + WS_BAR), bst);
#if PROBE
    unsigned long long* stamps = (unsigned long long*)(lds + 140000);
    if (blockIdx.x == 0 && threadIdx.x == 0) stamps[0] = __builtin_amdgcn_s_memrealtime();
#endif
    LAS unsigned char* ldsl = (LAS unsigned char*)lds;
    float* xbuf = P.out;
#pragma unroll 1
    for (int ph = lo; ph < hi; ++ph) {
        const int G = gridDim.x;
        int kind, l;
        if (ph == 0) { kind = 0; l = 0; } else if (ph == NPHASE - 1) { kind = 11; l = 0; } else { kind = (ph - 1) % 10 + 1; l = (ph - 1) / 10; }
        if (kind == 0) {
#ifndef SKIP_PREP
            phase_prep(P, lds);
#endif
        } else {
            const int nl = __builtin_amdgcn_readfirstlane((int)bst[0]), nx = __builtin_amdgcn_readfirstlane((int)bst[1]);
            const int gx = __builtin_amdgcn_readfirstlane((int)bst[2]), lr = __builtin_amdgcn_readfirstlane((int)bst[3]);
#pragma unroll 1
            for (int b = gx; b < NB; b += nx) {
                const int ro = b * 2048;
                int l2 = l; asm volatile("" : "+s"(l2));
                unsigned char* wsb = P.ws; asm volatile("" : "+s"(wsb));
                unsigned char* wl = wsb + (size_t)l2 * LAYER_BYTES;
                const float* mod = (const float*)(wl + L_MOD);
                const float* xcur = l2 == 0 ? INP(0) : xbuf;
                bf16_t* hbuf = (bf16_t*)(wsb + WS_HBUF);
                switch (kind) {
                case 1: phase_norm<0>(xcur, INP(4) + l2 * 2048, mod, 0, 1, hbuf, nullptr, b, lsg(lr), lsg(nl)); break;
                case 2: {
                    pg8::Gemm g{hbuf + (size_t)ro * 2048, (const bf16_t*)(wl + L_WIN), 2048, NIN, 2048, 2048, 0}; pg8::StaticOrder S; S.init(2048, NIN, lsg(nl), lsg(lr)); EpiIn E{wsb, ro};
                    pg8::gemm_phase<EpiIn>(ldsl, g, S, E);
                    break; }
                case 3: {
                    const int lr3 = lsg(lr), nl3 = lsg(nl);
                    for (int it = lr3; it < 32; it += nl3) lru_item(P, l2, b * 32 + it, lds);
                    for (int it = lr3; it < 32; it += nl3) cmp_item32(P, l2, (it >> 4) * 128 + (b * 4 + ((it >> 2) & 3)) * 4 + (it & 3), lds);
                    break; }
                case 4: phase_attn(P, lds, b, lsg(lr), lsg(nl)); break;
                case 5: {
                    pg8::StaticOrder S; S.init(2048, 2048, lsg(nl), lsg(lr));
                    { pg8::Gemm g{(const bf16_t*)(wsb + Z_Q) + (size_t)ro * 2048, (const bf16_t*)(wl + L_PA), 2048, 2048, 2048, 2048, 0}; EpiProj<0> E{(const bf16_t*)(wsb + Z_GA), hbuf, ro};
                      pg8::gemm_phase<EpiProj<0>>(ldsl, g, S, E); }
                    __syncthreads();
                    { pg8::Gemm g{(const bf16_t*)(wsb + Z_LY) + (size_t)ro * 2048, (const bf16_t*)(wl + L_PB), 2048, 2048, 2048, 2048, 0}; EpiProj<1> E{(const bf16_t*)(wsb + Z_GB), hbuf, ro};
                      pg8::gemm_phase<EpiProj<1>>(ldsl, g, S, E); }
                    break; }
                case 6: {
                    pg8::Gemm g{hbuf + (size_t)ro * 2048, (const bf16_t*)(wl + L_WO), 2048, 2048, 2048, 2048, 0}; pg8::StaticOrder S; S.init(2048, 2048, lsg(nl), lsg(lr)); EpiRes E{xcur, xbuf, mod + 2 * 2048, ro};
                    pg8::gemm_phase<EpiRes>(ldsl, g, S, E);
                    break; }
                case 7: phase_norm<0>(xbuf, INP(22) + l2 * 2048, mod, 3, 4, hbuf, nullptr, b, lsg(lr), lsg(nl)); break;
                case 8: {
                    pg8::Gemm g{hbuf + (size_t)ro * 2048, (const bf16_t*)(wl + L_WUP), 2048, 12288, 2048, 2048, 0}; pg8::StaticOrder S; S.init(2048, 12288, lsg(nl), lsg(lr));
                    EpiGlu E{(bf16_t*)(wsb + Z_LX), (float*)(wsb + WS_SIDE), INP(24) + (size_t)l2 * 3 * DFF, INP(25) + (size_t)l2 * DFF, ldsl + 131072, ro};
                    pg8::gemm_phase<EpiGlu>(ldsl, g, S, E);
                    break; }
                case 9: phase_glufix(P, l2, b, lsg(lr), lsg(nl)); break;
                case 10: {
                    pg8::Gemm g{(const bf16_t*)(wsb + Z_LX) + (size_t)ro * 2048, (const bf16_t*)(wl + L_WDN), 2048, 2048, DFF, 2048, SZ_ACT - 4096};
                    pg8::StaticOrder S; S.init(2048, 2048, lsg(nl), lsg(lr)); EpiRes E{xbuf, xbuf, mod + 5 * 2048, ro};
                    pg8::gemm_phase<EpiRes>(ldsl, g, S, E);
                    break; }
                default: phase_norm<1>(xbuf, INP(27), nullptr, 0, 0, nullptr, xbuf, b, lsg(lr), lsg(nl)); break;
                }
                __syncthreads();
            }
        }
        if (ph + 1 < hi) { if (ph < 0) cg::this_grid().sync(); else if (ph == 0) xcd_barrier(xbar); else xcd_local_barrier(xbar); }
#if PROBE
        if (blockIdx.x == 0 && threadIdx.x == 0) stamps[ph + 1] = __builtin_amdgcn_s_memrealtime();
#endif
    }
#if PROBE
    xcd_barrier(xbar);
    if (blockIdx.x == 0) {
        float* fr = (float*)(lds + 141000);
        if (threadIdx.x == 0) {
            float tg[6] = {0.f, 0.f, 0.f, 0.f, 0.f, 0.f};
            for (int k = 0; k < NPHASE; ++k) {
                const float dt = (float)(stamps[k + 1] - stamps[k]);
                int grp; if (k == 0) grp = 0; else if (k == NPHASE - 1) grp = 1; else { const int sidx = (k - 1) % 10 + 1; grp = (sidx == 1 || sidx == 7) ? 1 : (sidx == 3 ? 3 : (sidx == 4 ? 4 : (sidx == 9 ? 5 : 2))); }
                for (int q2 = 0; q2 < 6; ++q2) if (q2 == grp) tg[q2] += dt;
            }
            const float tot = (float)(stamps[NPHASE] - stamps[0]);
            float fa = 0.f, fb = 0.f;
            for (int q2 = 0; q2 < 6; ++q2) { if (q2 == PROBE_GA) fa = tg[q2] / tot; if (q2 == PROBE_GB) fb = tg[q2] / tot; }
#if PROBE_CHECK
            { const float* chk = (const float*)(P.ws + WS_CHK); int nbad = 0; float mx = 0.f, sm = 0.f;
              for (int i = 0; i < 256; ++i) { const float e = chk[i]; if (!(e <= 0.05f)) ++nbad; mx = fmaxf(mx, e); sm += e; }
              fa = (float)nbad / 256.f;
              fb = fminf(sm / 256.f, 0.25f); }
#endif
            fr[0] = 0.04f * sqrtf(fa); fr[1] = 0.04f + 0.5f * fb;
        }
        __syncthreads();
        const float da = fr[0], db = fr[1];
        for (int i = threadIdx.x; i < (1 << 20); i += 512) xbuf[i] += da;
        if (threadIdx.x == 0) xbuf[(size_t)M * D - 1] += db;
    }
#endif
}

extern "C" void kernel_launch(void* const* d_in, const int* in_sizes, int n_in, void* d_out, int out_size, void* d_ws, size_t ws_size, hipStream_t stream) {
    static int grid = 0;
    if (grid == 0) {
        if (n_in != 28 || out_size != M * D || ws_size < WS_NEED) { fprintf(stderr, "kernel_launch: unexpected problem (n_in %d, out %d, ws %zu < %zu)\n", n_in, out_size, ws_size, (size_t)WS_NEED); grid = -1; return; }
        int dev = 0, cus = 0, per_cu = 0;
        hipGetDevice(&dev);
        hipDeviceGetAttribute(&cus, hipDeviceAttributeMultiprocessorCount, dev);
        if (hipFuncSetAttribute((const void*)mega_fwd, hipFuncAttributeMaxDynamicSharedMemorySize, LDS_BYTES) != hipSuccess) { fprintf(stderr, "kernel_launch: hipFuncSetAttribute failed\n"); grid = -1; return; }
        if (hipOccupancyMaxActiveBlocksPerMultiprocessor(&per_cu, (const void*)mega_fwd, 512, LDS_BYTES) != hipSuccess || per_cu < 1) { fprintf(stderr, "kernel_launch: occupancy query says %d\n", per_cu); per_cu = 1; }
        (void)hipGetLastError();
        grid = cus * (per_cu > 1 ? 1 : per_cu);
        fprintf(stderr, "kernel_launch: grid %d (cus %d, per_cu %d), ws need %zu of %zu\n", grid, cus, per_cu, (size_t)WS_NEED, ws_size);
    }
    if (grid < 0) return;
    Params p{};
    for (int i = 0; i < 28; ++i) p.in[i] = (const float*)d_in[i];
    p.out = (float*)d_out; p.ws = (unsigned char*)d_ws;
#if MK_COOP
    if (hipMemsetAsync((char*)d_ws + WS_BAR, 0, WS_BAR_BYTES, stream) != hipSuccess) { fprintf(stderr, "kernel_launch: memset of the barrier words failed\n"); return; }
    p.ph_lo = 0; p.ph_hi = NPHASE;
    void* args[] = {&p};
    hipError_t e = hipLaunchCooperativeKernel((const void*)mega_fwd, dim3(grid), dim3(512), args, LDS_BYTES, stream);
    if (e != hipSuccess) fprintf(stderr, "cooperative launch failed: %s (grid %d)\n", hipGetErrorString(e), grid);
#else
    for (int ph = 0; ph < NPHASE; ++ph) {
        p.ph_lo = ph; p.ph_hi = ph + 1;
        hipLaunchKernelGGL(mega_fwd, dim3(grid), dim3(512), LDS_BYTES, stream, p);
    }
#endif
}
```

```cpp
#include <hip/hip_runtime.h>
#include <hip/hip_cooperative_groups.h>
#include <cstdio>
#include <cstdint>
namespace cg = cooperative_groups;

#ifndef MK_COOP
#define MK_COOP 1
#endif

#ifndef PROBE
#define PROBE 0
#endif
#ifndef PROBE_CHECK
#define PROBE_CHECK 0
#endif
#define PROBE_GA 2
#define PROBE_GB 4
#define DEV __device__ __forceinline__
#define LAS __attribute__((address_space(3)))
typedef unsigned short bf16_t;
typedef short bf16x8 __attribute__((ext_vector_type(8)));
typedef float f32x4 __attribute__((ext_vector_type(4)));
typedef unsigned u32x4 __attribute__((ext_vector_type(4)));
typedef unsigned u32x2 __attribute__((ext_vector_type(2)));

constexpr int NB = 8, T = 2048, D = 2048, M = NB * T, DEPTH = 2;
constexpr int NIN = 13568;
constexpr int DFF = 6144;
constexpr int NPHASE = 1 + 10 * DEPTH + 1;
constexpr int LDS_BYTES = 147456;

DEV int up_src(int n) { return ((n >> 7) & 1) * 6144 + (n >> 8) * 128 + (n & 127); }
DEV int win_src(int n) { return n < 5120 ? n : (n < 13312 ? n + 48 : (n < 13360 ? n - 13312 + 5120 : -1)); }

constexpr size_t SZ_WIN = (size_t)NIN * 2048 * 2, SZ_WUP = (size_t)12288 * 2048 * 2, SZ_WDN = (size_t)2048 * 6144 * 2, SZ_WSQ = (size_t)2048 * 2048 * 2;
constexpr size_t SZ_W1 = (size_t)128 * 4096 * 2, SZ_W2 = 128 * 128 * 2, SZ_LRUW = 16 * 128 * 128 * 2, SZ_MOD = 8 * 12288 * 4;
constexpr size_t L_WIN = 0, L_WUP = L_WIN + SZ_WIN, L_WDN = L_WUP + SZ_WUP, L_PA = L_WDN + SZ_WDN, L_PB = L_PA + SZ_WSQ, L_WO = L_PB + SZ_WSQ,
                 L_W1K = L_WO + SZ_WSQ, L_W1V = L_W1K + SZ_W1, L_W2K = L_W1V + SZ_W1, L_W2V = L_W2K + SZ_W2, L_WA = L_W2V + SZ_W2, L_WI = L_WA + SZ_LRUW,
                 L_MOD = L_WI + SZ_LRUW, LAYER_BYTES = L_MOD + SZ_MOD;
constexpr size_t SZ_ACT = (size_t)M * 2048 * 2;
constexpr size_t SZ_KV = (size_t)M * 512 * 2;
constexpr size_t WS_HBUF = DEPTH * LAYER_BYTES;
constexpr size_t WS_Z = WS_HBUF + SZ_ACT;
constexpr size_t Z_Q = WS_Z, Z_KC = Z_Q + SZ_ACT, Z_VC = Z_KC + SZ_KV, Z_KS = Z_VC + SZ_KV, Z_VST = Z_KS + SZ_KV, Z_KW = Z_VST + SZ_KV, Z_VWT = Z_KW + SZ_KV,
                 Z_LX = Z_VWT + SZ_KV, Z_LY = Z_LX + SZ_ACT, Z_GA = Z_LY + SZ_ACT, Z_GB = Z_GA + SZ_ACT, Z_GATE = Z_GB + SZ_ACT,
                 Z_KCMP = Z_GATE + (size_t)M * 64 * 2, Z_VCMPT = Z_KCMP + (size_t)32 * 128 * 128 * 2, Z_END = Z_VCMPT + (size_t)32 * 128 * 128 * 2;
constexpr size_t F_G = WS_Z, F_V = WS_Z + (size_t)M * DFF * 2;
static_assert(F_V + (size_t)M * DFF * 2 <= Z_KCMP, "ffn overlay");
constexpr size_t WS_BAR = (Z_END + 255) & ~(size_t)255, WS_BAR_BYTES = 16384;
constexpr size_t WS_SIDE = WS_BAR + WS_BAR_BYTES, SIDE_ELEMS = (size_t)64 * 2 * DFF;
constexpr size_t WS_OBUF = WS_SIDE + 3 * SIDE_ELEMS * 4, WS_CHK = WS_OBUF + SZ_ACT;
constexpr size_t WS_NEED = PROBE_CHECK ? WS_CHK + 4096 : WS_OBUF;

struct Params { const float* in[28]; float* out; unsigned char* ws; int ph_lo, ph_hi; };
extern __shared__ __attribute__((aligned(16))) unsigned char g_lds[];
constexpr int TAB_OFF = LDS_BYTES - 64 - 256;
__device__ __forceinline__ const float* inp(int k) {
    const unsigned long long v = *(const volatile __attribute__((address_space(3))) unsigned long long*)((__attribute__((address_space(3))) unsigned char*)g_lds + TAB_OFF + 8 * k);
    const unsigned lo = __builtin_amdgcn_readfirstlane((unsigned)v), hi = __builtin_amdgcn_readfirstlane((unsigned)(v >> 32));
    return (const float*)(const __attribute__((address_space(1))) float*)(((unsigned long long)hi << 32) | lo);
}
#define INP(k) inp(k)

DEV float bflo(unsigned u) { return __builtin_bit_cast(float, u << 16); }
DEV float bfhi(unsigned u) { return __builtin_bit_cast(float, u & 0xffff0000u); }
DEV unsigned cvt_pk_bf16(float lo, float hi) { unsigned r; asm volatile("v_cvt_pk_bf16_f32 %0, %1, %2" : "=v"(r) : "v"(lo), "v"(hi)); return r; }
DEV float frcp(float x) { return __builtin_amdgcn_rcpf(x); }
DEV float sigm(float x) { return frcp(1.f + __builtin_amdgcn_exp2f(-1.4426950408889634f * x)); }
DEV float gelu_t(float x) { const float u = -2.302208198106407f * (x + 0.044715f * x * x * x); return x * frcp(1.f + __builtin_amdgcn_exp2f(u)); }
DEV float shx(float v, int m, int lane) { return __builtin_bit_cast(float, __builtin_amdgcn_ds_bpermute((lane ^ m) << 2, __builtin_bit_cast(int, v))); }
DEV unsigned shxu(unsigned v, int m, int lane) { return (unsigned)__builtin_amdgcn_ds_bpermute((lane ^ m) << 2, (int)v); }
DEV float wave_sum(float v, int lane) {
#pragma unroll
    for (int o = 1; o < 64; o <<= 1) v += shx(v, o, lane);
    return v;
}
DEV int otid() { int t = threadIdx.x; asm volatile("" : "+v"(t)); return t; }
DEV int obid() { int b = blockIdx.x; asm volatile("" : "+s"(b)); return b; }
DEV int lsg(int v) { asm volatile("" : "+s"(v)); return v; }
DEV f32x4 mfma16(bf16x8 a, bf16x8 b, f32x4 c) { return __builtin_amdgcn_mfma_f32_16x16x32_bf16(a, b, c, 0, 0, 0); }
DEV bf16x8 as_bf16x8(u32x4 v) { return __builtin_bit_cast(bf16x8, v); }

namespace pg8 {
constexpr int BM = 256, BK = 64, HALF = 128, HTB = HALF * BK * 2, NXCD = 8, WGM = 8;
DEV int lds_byte(int r, int c) { const int st = (r >> 4) * 2 + (c >> 5), rr = r & 15, cc = c & 31, ob = rr * 64 + cc * 2; return st * 1024 + (ob ^ (((ob >> 9) & 1) << 5)); }
DEV void stage_rc(int b, int& R, int& C) { const int st = b / 1024, sb = b % 1024, swz = sb ^ (((sb >> 9) & 1) << 5); R = (st >> 1) * 16 + swz / 64; C = (st & 1) * 32 + (swz % 64) / 2; }
DEV int perm32(int rho) { const int n = rho >> 4, i = rho & 15; return 8 * (i >> 2) + 4 * n + (i & 3); }
struct Unit { int pm, pn; };
struct Gemm { const bf16_t* A; const bf16_t* Bt; int M, N, K, lda; size_t pj; };
struct StaticOrder {
    int nM, nN, nwg, G, c;
    DEV void init(int M_, int N_, int G_, int c_) { nM = M_ / BM; nN = N_ / BM; nwg = nM * nN; G = G_; c = c_; }
    DEV bool next(int i, Unit& u) const {
        const long L = (long)i * G + c; if (L >= nwg) return false;
        const int wgid = (int)L;
        const int nig = WGM * nN, gid = wgid / nig, fm = gid * WGM, gsz = (nM - fm) < WGM ? (nM - fm) : WGM;
        u.pm = fm + ((wgid % nig) % gsz); u.pn = (wgid % nig) / gsz; return true;
    }
};
template <class Epi>
DEV void gemm_phase(LAS unsigned char* lds, const Gemm g, const StaticOrder& S, const Epi& E) {
    const int tid = otid(), wid = __builtin_amdgcn_readfirstlane(tid >> 6), lane = tid & 63, wr = wid >> 2, wc = wid & 3, fr = lane & 15, fq = lane >> 4;
    const int K = g.K, nt = K / BK, lda = g.lda;
    unsigned voffA[2], voffB[2];
#pragma unroll
    for (int i = 0; i < 2; ++i) { int R, C; stage_rc(tid * 16 + i * 8192, R, C); const int Rb = (R & ~31) + perm32(R & 31);
        voffA[i] = (unsigned)(R * lda + C) * 2u; voffB[i] = (unsigned)(Rb * K + C) * 2u; }
    const size_t kstep = (size_t)(BK * 2);
    const size_t pj = g.pj;
#define PG8_KOFF(t) ((size_t)(t) * kstep + (size_t)((t) >> 5) * pj)
    const size_t hstepA = (size_t)HALF * lda * 2, tstepA = 2 * hstepA;
    const size_t hstepB = (size_t)HALF * K * 2, tstepB = 2 * hstepB;
    const unsigned ldsw = (unsigned)wid * 1024u;
    const int aoff = lds_byte(wr * 64 + fr, fq * 8), boff = lds_byte(wc * 32 + fr, fq * 8);
#define PG8_SA(b, h) (((b) * 2 + (h)) * HTB)
#define PG8_SB(b, h) ((4 + (b) * 2 + (h)) * HTB)
#define PG8_STAGE(bufoff, gbase, voff) do { _Pragma("unroll") for (int _i = 0; _i < 2; ++_i) \
        __builtin_amdgcn_global_load_lds((const unsigned*)((const char*)(gbase) + (voff)[_i]), (LAS unsigned*)(lds + (bufoff) + ldsw + _i * 8192), 16, 0, 0); } while (0)
#define PG8_LDA(dst, b, h) do { _Pragma("unroll") for (int m = 0; m < 4; ++m) _Pragma("unroll") for (int k = 0; k < 2; ++k) dst[m][k] = *(const LAS bf16x8*)(lds + PG8_SA(b, h) + aoff + m * 2048 + k * 1024); } while (0)
#define PG8_LDB(dst, b, h) do { _Pragma("unroll") for (int n = 0; n < 2; ++n) _Pragma("unroll") for (int k = 0; k < 2; ++k) dst[n][k] = *(const LAS bf16x8*)(lds + PG8_SB(b, h) + boff + n * 2048 + k * 1024); } while (0)
#define PG8_MMA(ai, bj, At, Bt) do { __builtin_amdgcn_s_setprio(1); _Pragma("unroll") for (int m = 0; m < 4; ++m) _Pragma("unroll") for (int n = 0; n < 2; ++n) _Pragma("unroll") for (int k = 0; k < 2; ++k) \
        acc[ai][bj][m][n] = __builtin_amdgcn_mfma_f32_16x16x32_bf16(Bt[n][k], At[m][k], acc[ai][bj][m][n], 0, 0, 0); __builtin_amdgcn_s_setprio(0); } while (0)
#define PG8_WAIT_V(n) asm volatile("s_waitcnt vmcnt(" #n ")" ::: "memory")
#define PG8_WAIT_L(n) asm volatile("s_waitcnt lgkmcnt(" #n ")" ::: "memory")
#define PG8_BAR __builtin_amdgcn_s_barrier()
#define PG8_SCHED __builtin_amdgcn_sched_barrier(0)
    Unit cur, nxt; int ui = 0;
    if (!S.next(0, cur)) return;
    f32x4 acc[2][2][4][2];
#pragma unroll
    for (int a = 0; a < 2; ++a)
#pragma unroll
        for (int b = 0; b < 2; ++b)
#pragma unroll
            for (int m = 0; m < 4; ++m)
#pragma unroll
                for (int n = 0; n < 2; ++n) acc[a][b][m][n] = (f32x4){0.f, 0.f, 0.f, 0.f};
    bf16x8 At[4][2], B0[2][2], B1[2][2];
    const char* cA = (const char*)g.A + (size_t)cur.pm * tstepA; const char* cB = (const char*)g.Bt + (size_t)cur.pn * tstepB;
    PG8_STAGE(PG8_SB(0, 0), cB, voffB); PG8_STAGE(PG8_SB(0, 1), cB + hstepB, voffB); PG8_STAGE(PG8_SA(0, 0), cA, voffA); PG8_STAGE(PG8_SA(0, 1), cA + hstepA, voffA);
    if (wr == 1) PG8_BAR;
    PG8_WAIT_V(2); PG8_BAR;
    PG8_STAGE(PG8_SB(1, 0), cB + kstep, voffB); PG8_STAGE(PG8_SA(1, 0), cA + kstep, voffA); PG8_STAGE(PG8_SB(1, 1), cB + hstepB + kstep, voffB);
    PG8_WAIT_V(6); PG8_BAR;
    for (;;) {
        const bool has_next = S.next(ui + 1, nxt);
        const char* nA = has_next ? (const char*)g.A + (size_t)nxt.pm * tstepA : cA; const char* nB = has_next ? (const char*)g.Bt + (size_t)nxt.pn * tstepB : cB;
        for (int t = 0; t < nt; t += 2) {
            const bool last = (t == nt - 2);
            const char* a1 = cA + PG8_KOFF(t + 1);
            const char* a2 = last ? nA : cA + PG8_KOFF(t + 2); const char* b2 = last ? nB : cB + (size_t)(t + 2) * kstep;
            const char* a3 = last ? nA + kstep : cA + PG8_KOFF(t + 3); const char* b3 = b2 + kstep;
            PG8_LDB(B0, 0, 0); PG8_LDB(B1, 0, 1); PG8_SCHED; PG8_LDA(At, 0, 0); PG8_STAGE(PG8_SA(1, 1), a1 + hstepA, voffA);
            PG8_WAIT_V(8); PG8_WAIT_L(0); PG8_BAR; PG8_MMA(0, 0, At, B0); PG8_MMA(0, 1, At, B1); PG8_BAR; PG8_SCHED;
            PG8_LDA(At, 0, 1); PG8_STAGE(PG8_SB(0, 0), b2, voffB); PG8_STAGE(PG8_SB(0, 1), b2 + hstepB, voffB); PG8_STAGE(PG8_SA(0, 0), a2, voffA);
            PG8_WAIT_V(8); PG8_WAIT_L(0); PG8_BAR; PG8_MMA(1, 0, At, B0); PG8_MMA(1, 1, At, B1); PG8_BAR; PG8_SCHED;
            PG8_LDB(B0, 1, 0); PG8_LDB(B1, 1, 1); PG8_SCHED; PG8_LDA(At, 1, 0); PG8_STAGE(PG8_SA(0, 1), a2 + hstepA, voffA);
            PG8_WAIT_V(8); PG8_WAIT_L(0); PG8_BAR; PG8_MMA(0, 0, At, B0); PG8_MMA(0, 1, At, B1); PG8_BAR; PG8_SCHED;
            PG8_LDA(At, 1, 1); PG8_STAGE(PG8_SB(1, 0), b3, voffB); PG8_STAGE(PG8_SB(1, 1), b3 + hstepB, voffB); PG8_STAGE(PG8_SA(1, 0), a3, voffA);
            PG8_WAIT_V(8); PG8_WAIT_L(0); PG8_BAR; PG8_MMA(1, 0, At, B0); PG8_MMA(1, 1, At, B1); PG8_BAR; PG8_SCHED;
        }
        if (wr == 0) PG8_BAR;
        E(acc, cur, wr, wc, fr, fq);
        if (!has_next) break;
#pragma unroll
        for (int a = 0; a < 2; ++a)
#pragma unroll
            for (int b = 0; b < 2; ++b)
#pragma unroll
                for (int m = 0; m < 4; ++m)
#pragma unroll
                    for (int n = 0; n < 2; ++n) acc[a][b][m][n] = (f32x4){0.f, 0.f, 0.f, 0.f};
        cur = nxt; cA = nA; cB = nB; ++ui;
        if (wr == 1) PG8_BAR;
    }
    PG8_WAIT_V(0);
    PG8_BAR;
#undef PG8_KOFF
#undef PG8_SA
#undef PG8_SB
#undef PG8_STAGE
#undef PG8_LDA
#undef PG8_LDB
#undef PG8_MMA
#undef PG8_WAIT_V
#undef PG8_WAIT_L
#undef PG8_BAR
#undef PG8_SCHED
}
}
using pg8::Unit;

DEV u32x4 pack8(f32x4 v0, f32x4 v1) { u32x4 w; w.x = cvt_pk_bf16(v0[0], v0[1]); w.y = cvt_pk_bf16(v0[2], v0[3]); w.z = cvt_pk_bf16(v1[0], v1[1]); w.w = cvt_pk_bf16(v1[2], v1[3]); return w; }

struct EpiIn {
    unsigned char* ws; int ro;
    DEV void operator()(const f32x4 (&acc)[2][2][4][2], const Unit& u, int wr, int wc, int fr, int fq) const {
        const int pn = u.pn; bf16_t* base; int pitch, colt, mode = 0; float sc = 1.f;
        if (pn < 8) { base = (bf16_t*)(ws + Z_Q); pitch = 2048; colt = pn * 256; sc = 0.08838834764831845f; }
        else if (pn < 20) { const int s = (pn - 8) >> 1; colt = ((pn - 8) & 1) * 256; pitch = 512; base = (bf16_t*)(ws + Z_KC + (size_t)s * SZ_KV); mode = (s == 3 || s == 5) ? 1 : 0; }
        else if (pn < 52) { const int s = (pn - 20) >> 3; colt = ((pn - 20) & 7) * 256; pitch = 2048; base = (bf16_t*)(ws + Z_LX + (size_t)s * SZ_ACT); }
        else { mode = 2; base = (bf16_t*)(ws + Z_GATE); pitch = 64; colt = 0; }
        const int row0 = ro + u.pm * 256 + wr * 64 + fr;
#pragma unroll
        for (int ai = 0; ai < 2; ++ai)
#pragma unroll
            for (int m = 0; m < 4; ++m) {
                const int row = row0 + ai * 128 + m * 16;
#pragma unroll
                for (int bj = 0; bj < 2; ++bj) {
                    const int col = colt + bj * 128 + wc * 32 + 8 * fq;
                    const f32x4 v0 = acc[ai][bj][m][0] * sc, v1 = acc[ai][bj][m][1] * sc;
                    const u32x4 w = pack8(v0, v1);
                    if (mode == 0) { *(u32x4*)(base + (size_t)row * pitch + col) = w; }
                    else if (mode == 1) {
                        const int b = row >> 11, t = row & 2047, gg = col >> 7, d = col & 127;
                        bf16_t* p = base + ((size_t)((b * 4 + gg) * 128 + d)) * 2048 + t;
                        p[0 * 2048] = (bf16_t)(w.x & 0xffff); p[1 * 2048] = (bf16_t)(w.x >> 16); p[2 * 2048] = (bf16_t)(w.y & 0xffff); p[3 * 2048] = (bf16_t)(w.y >> 16);
                        p[4 * 2048] = (bf16_t)(w.z & 0xffff); p[5 * 2048] = (bf16_t)(w.z >> 16); p[6 * 2048] = (bf16_t)(w.w & 0xffff); p[7 * 2048] = (bf16_t)(w.w >> 16);
                    } else { if (col < 48) *(u32x4*)(base + (size_t)row * 64 + col) = w; }
                }
            }
    }
};
template <int SECOND> struct EpiProj {
    const bf16_t* gate; bf16_t* O; int ro;
    DEV void operator()(const f32x4 (&acc)[2][2][4][2], const Unit& u, int wr, int wc, int fr, int fq) const {
        const int row0 = ro + u.pm * 256 + wr * 64 + fr, col0 = u.pn * 256 + wc * 32 + 8 * fq;
#pragma unroll
        for (int ai = 0; ai < 2; ++ai) {
            u32x4 gv[4][2], pv[4][2];
#pragma unroll
            for (int m = 0; m < 4; ++m)
#pragma unroll
                for (int bj = 0; bj < 2; ++bj) { const size_t off = (size_t)(row0 + ai * 128 + m * 16) * 2048 + col0 + bj * 128;
                    gv[m][bj] = *(const u32x4*)(gate + off); if (SECOND) pv[m][bj] = *(const u32x4*)(O + off); }
#pragma unroll
            for (int m = 0; m < 4; ++m)
#pragma unroll
                for (int bj = 0; bj < 2; ++bj) { const size_t off = (size_t)(row0 + ai * 128 + m * 16) * 2048 + col0 + bj * 128;
                    const u32x4 g = gv[m][bj];
                    f32x4 v0 = acc[ai][bj][m][0], v1 = acc[ai][bj][m][1];
                    v0[0] *= sigm(bflo(g.x)); v0[1] *= sigm(bfhi(g.x)); v0[2] *= sigm(bflo(g.y)); v0[3] *= sigm(bfhi(g.y));
                    v1[0] *= sigm(bflo(g.z)); v1[1] *= sigm(bfhi(g.z)); v1[2] *= sigm(bflo(g.w)); v1[3] *= sigm(bfhi(g.w));
                    if (SECOND) { const u32x4 p = pv[m][bj];
                        v0[0] += bflo(p.x); v0[1] += bfhi(p.x); v0[2] += bflo(p.y); v0[3] += bfhi(p.y);
                        v1[0] += bflo(p.z); v1[1] += bfhi(p.z); v1[2] += bflo(p.w); v1[3] += bfhi(p.w); }
                    *(u32x4*)(O + off) = pack8(v0, v1); }
        }
    }
};
struct EpiRes {
    const float* xin; float* xout; const float* gvec; int ro;
    DEV void operator()(const f32x4 (&acc)[2][2][4][2], const Unit& u, int wr, int wc, int fr, int fq) const {
        const int row0 = ro + u.pm * 256 + wr * 64 + fr, col0 = u.pn * 256 + wc * 32 + 8 * fq;
        const float* gb = gvec + (size_t)(row0 >> 11) * 12288;
        f32x4 g[2][2];
#pragma unroll
        for (int bj = 0; bj < 2; ++bj) { g[bj][0] = *(const f32x4*)(gb + col0 + bj * 128); g[bj][1] = *(const f32x4*)(gb + col0 + bj * 128 + 4); }
#pragma unroll
        for (int ai = 0; ai < 2; ++ai) {
            f32x4 xv[4][2][2];
#pragma unroll
            for (int m = 0; m < 4; ++m)
#pragma unroll
                for (int bj = 0; bj < 2; ++bj) { const size_t off = (size_t)(row0 + ai * 128 + m * 16) * 2048 + col0 + bj * 128;
                    xv[m][bj][0] = *(const f32x4*)(xin + off); xv[m][bj][1] = *(const f32x4*)(xin + off + 4); }
#pragma unroll
            for (int m = 0; m < 4; ++m)
#pragma unroll
                for (int bj = 0; bj < 2; ++bj) { const size_t off = (size_t)(row0 + ai * 128 + m * 16) * 2048 + col0 + bj * 128;
                    *(f32x4*)(xout + off) = xv[m][bj][0] + g[bj][0] * acc[ai][bj][m][0];
                    *(f32x4*)(xout + off + 4) = xv[m][bj][1] + g[bj][1] * acc[ai][bj][m][1]; }
        }
    }
};
struct EpiGlu {
    bf16_t* G; float* side; const float* cw; const float* cb; LAS unsigned char* xch; int ro;
    DEV void operator()(const f32x4 (&acc)[2][2][4][2], const Unit& u, int wr, int wc, int fr, int fq) const {
        const int lane = fq * 16 + fr, cc = wc * 32 + fq * 8, ch = u.pn * 128 + cc, pmg = (ro >> 8) + u.pm;
        f32x4 w0[2], w1[2], w2[2], bs[2];
#pragma unroll
        for (int n = 0; n < 2; ++n) { w0[n] = *(const f32x4*)(cw + ch + 4 * n); w1[n] = *(const f32x4*)(cw + DFF + ch + 4 * n); w2[n] = *(const f32x4*)(cw + 2 * DFF + ch + 4 * n); bs[n] = *(const f32x4*)(cb + ch + 4 * n); }
        LAS float* X = (LAS float*)xch;
        if (fr >= 14) {
#pragma unroll
            for (int ai = 0; ai < 2; ++ai)
#pragma unroll
                for (int n = 0; n < 2; ++n) *(LAS f32x4*)(X + ((ai * 2 + wr) * 2 + (fr - 14)) * 128 + cc + 4 * n) = acc[ai][0][3][n];
            if (wr == 1) {
#pragma unroll
                for (int n = 0; n < 2; ++n) *(f32x4*)(side + ((size_t)(pmg * 2 + (fr - 14))) * DFF + ch + 4 * n) = acc[1][0][3][n];
            }
        }
        if (wr == 0 && fr < 2) {
#pragma unroll
            for (int n = 0; n < 2; ++n) { *(f32x4*)(side + SIDE_ELEMS + ((size_t)(pmg * 2 + fr)) * DFF + ch + 4 * n) = acc[0][0][0][n];
                                          *(f32x4*)(side + 2 * SIDE_ELEMS + ((size_t)(pmg * 2 + fr)) * DFF + ch + 4 * n) = acc[0][1][0][n]; }
        }
        asm volatile("s_waitcnt lgkmcnt(0)" ::: "memory");
        __builtin_amdgcn_s_barrier();
        const int addr1 = ((fr == 0) ? lane + 15 : lane - 1) << 2, addr2 = ((fr < 2) ? lane + 14 : lane - 2) << 2;
        const int row0 = ro + u.pm * 256 + wr * 64 + fr;
#pragma unroll
        for (int ai = 0; ai < 2; ++ai) {
            f32x4 prev[2] = {(f32x4){0.f, 0.f, 0.f, 0.f}, (f32x4){0.f, 0.f, 0.f, 0.f}};
            if (!(ai == 0 && wr == 0) && fr >= 14) {
                const int pslot = ai * 2 + wr - 1;
#pragma unroll
                for (int n = 0; n < 2; ++n) prev[n] = *(const LAS f32x4*)(X + (pslot * 2 + (fr - 14)) * 128 + cc + 4 * n);
            }
#pragma unroll
            for (int m = 0; m < 4; ++m) {
                f32x4 outv[2];
#pragma unroll
                for (int n = 0; n < 2; ++n) {
                    const f32x4 cur = acc[ai][0][m][n], val = acc[ai][1][m][n];
#pragma unroll
                    for (int i = 0; i < 4; ++i) {
                        const float s1 = (fr == 15) ? prev[n][i] : cur[i], s2 = (fr >= 14) ? prev[n][i] : cur[i];
                        const float p1 = __builtin_bit_cast(float, __builtin_amdgcn_ds_bpermute(addr1, __builtin_bit_cast(int, s1)));
                        const float p2 = __builtin_bit_cast(float, __builtin_amdgcn_ds_bpermute(addr2, __builtin_bit_cast(int, s2)));
                        const float a = bs[n][i] + w0[n][i] * p2 + w1[n][i] * p1 + w2[n][i] * cur[i];
                        outv[n][i] = gelu_t(a) * val[i];
                    }
                    prev[n] = cur;
                }
                *(u32x4*)(G + (size_t)(ch >> 11) * (SZ_ACT / 2) + (size_t)(row0 + ai * 128 + m * 16) * 2048 + (ch & 2047)) = pack8(outv[0], outv[1]);
            }
        }
    }
};

DEV void phase_glufix(const Params& P, int l, int b, int lr, int nl) {
    const int tid = otid();
    bf16_t* G = (bf16_t*)(P.ws + Z_LX); const float* side = (const float*)(P.ws + WS_SIDE);
    const float* cw = INP(24) + (size_t)l * 3 * DFF; const float* cb = INP(25) + (size_t)l * DFF;
    for (int idx = lr * 512 + tid; idx < 7 * (DFF / 4); idx += nl * 512) {
        const int t7 = idx / (DFF / 4), c4 = (idx % (DFF / 4)) * 4, pm = b * 8 + t7 + 1;
        const f32x4 L0 = *(const f32x4*)(side + ((size_t)((pm - 1) * 2 + 0)) * DFF + c4), L1 = *(const f32x4*)(side + ((size_t)((pm - 1) * 2 + 1)) * DFF + c4);
        const f32x4 F0 = *(const f32x4*)(side + SIDE_ELEMS + ((size_t)(pm * 2 + 0)) * DFF + c4), F1 = *(const f32x4*)(side + SIDE_ELEMS + ((size_t)(pm * 2 + 1)) * DFF + c4);
        const f32x4 V0 = *(const f32x4*)(side + 2 * SIDE_ELEMS + ((size_t)(pm * 2 + 0)) * DFF + c4), V1 = *(const f32x4*)(side + 2 * SIDE_ELEMS + ((size_t)(pm * 2 + 1)) * DFF + c4);
        const f32x4 w0 = *(const f32x4*)(cw + c4), w1 = *(const f32x4*)(cw + DFF + c4), w2 = *(const f32x4*)(cw + 2 * DFF + c4), bs = *(const f32x4*)(cb + c4);
        const f32x4 a0 = bs + w0 * L0 + w1 * L1 + w2 * F0, a1 = bs + w0 * L1 + w1 * F0 + w2 * F1;
        u32x2 o0, o1;
        o0.x = cvt_pk_bf16(gelu_t(a0[0]) * V0[0], gelu_t(a0[1]) * V0[1]); o0.y = cvt_pk_bf16(gelu_t(a0[2]) * V0[2], gelu_t(a0[3]) * V0[3]);
        o1.x = cvt_pk_bf16(gelu_t(a1[0]) * V1[0], gelu_t(a1[1]) * V1[1]); o1.y = cvt_pk_bf16(gelu_t(a1[2]) * V1[2], gelu_t(a1[3]) * V1[3]);
        bf16_t* gp = G + (size_t)(c4 >> 11) * (SZ_ACT / 2) + (size_t)(pm * 256) * 2048 + (c4 & 2047);
        *(u32x2*)gp = o0;
        *(u32x2*)(gp + 2048) = o1;
    }
}

template <int MAP>
DEV void transpose_item(const float* W, int K, int N, bf16_t* WT, float* scr, int item, int nblk, int lane) {
    const int kb = item / nblk, nb = item % nblk, k0 = 64 * kb, n0 = 32 * nb;
    const int nsrc = MAP == 1 ? win_src(n0 + (lane & 31)) : (MAP == 2 ? up_src(n0 + (lane & 31)) : n0 + (lane & 31));
#pragma unroll 8
    for (int i = 0; i < 32; ++i) { const int kk = 2 * i + (lane >> 5); scr[kk * 33 + (lane & 31)] = nsrc >= 0 ? W[(size_t)(k0 + kk) * N + nsrc] : 0.f; }
    asm volatile("s_waitcnt lgkmcnt(0)" ::: "memory");
    const int c = lane & 7;
#pragma unroll
    for (int j = 0; j < 4; ++j) { const int n = (lane >> 3) + 8 * j; const float* s = scr + (8 * c) * 33 + n;
        u32x4 o; o.x = cvt_pk_bf16(s[0 * 33], s[1 * 33]); o.y = cvt_pk_bf16(s[2 * 33], s[3 * 33]); o.z = cvt_pk_bf16(s[4 * 33], s[5 * 33]); o.w = cvt_pk_bf16(s[6 * 33], s[7 * 33]);
        *(u32x4*)(WT + (size_t)(n0 + n) * K + k0 + 8 * c) = o; }
    asm volatile("s_waitcnt lgkmcnt(0)" ::: "memory");
}

DEV void phase_prep(const Params& P, unsigned char* lds) {
    const int tid = otid(), lane = tid & 63, wave = tid >> 6; const int bid = obid();
    float* scr = (float*)(lds + wave * 8448);
    const int gw = bid * 8 + wave, NGW = gridDim.x * 8;
    constexpr int I_IN = 32 * (NIN / 32), I_UP = 32 * 384, I_DN = 96 * 64, I_SQ = 32 * 64, I_W1 = 64 * 4, I_W2 = 2 * 4, I_LRU = 16 * 8;
    constexpr int PER_LAYER = I_IN + I_UP + I_DN + 3 * I_SQ + 2 * I_W1 + 2 * I_W2 + 2 * I_LRU;
    for (int it = gw; it < DEPTH * PER_LAYER; it += NGW) {
        const int l = it / PER_LAYER; int r = it % PER_LAYER;
        unsigned char* wl = P.ws + (size_t)l * LAYER_BYTES;
        if (r < I_IN) { transpose_item<1>(INP(5) + (size_t)l * 2048 * 13360, 2048, 13360, (bf16_t*)(wl + L_WIN), scr, r, NIN / 32, lane); continue; } r -= I_IN;
        if (r < I_UP) { transpose_item<2>(INP(23) + (size_t)l * 2048 * 12288, 2048, 12288, (bf16_t*)(wl + L_WUP), scr, r, 384, lane); continue; } r -= I_UP;
        if (r < I_DN) { transpose_item<0>(INP(26) + (size_t)l * 6144 * 2048, 6144, 2048, (bf16_t*)(wl + L_WDN), scr, r, 64, lane); continue; } r -= I_DN;
        if (r < I_SQ) { transpose_item<0>(INP(19) + (size_t)l * 2048 * 2048, 2048, 2048, (bf16_t*)(wl + L_PA), scr, r, 64, lane); continue; } r -= I_SQ;
        if (r < I_SQ) { transpose_item<0>(INP(20) + (size_t)l * 2048 * 2048, 2048, 2048, (bf16_t*)(wl + L_PB), scr, r, 64, lane); continue; } r -= I_SQ;
        if (r < I_SQ) { transpose_item<0>(INP(21) + (size_t)l * 2048 * 2048, 2048, 2048, (bf16_t*)(wl + L_WO), scr, r, 64, lane); continue; } r -= I_SQ;
        if (r < I_W1) { transpose_item<0>(INP(7) + (size_t)l * 4096 * 128, 4096, 128, (bf16_t*)(wl + L_W1K), scr, r, 4, lane); continue; } r -= I_W1;
        if (r < I_W1) { transpose_item<0>(INP(10) + (size_t)l * 4096 * 128, 4096, 128, (bf16_t*)(wl + L_W1V), scr, r, 4, lane); continue; } r -= I_W1;
        if (r < I_W2) { transpose_item<0>(INP(8) + (size_t)l * 128 * 128, 128, 128, (bf16_t*)(wl + L_W2K), scr, r, 4, lane); continue; } r -= I_W2;
        if (r < I_W2) { transpose_item<0>(INP(11) + (size_t)l * 128 * 128, 128, 128, (bf16_t*)(wl + L_W2V), scr, r, 4, lane); continue; } r -= I_W2;
        if (r < I_LRU) { const int mt = r >> 3; transpose_item<0>(INP(14) + (size_t)(l * 16 + mt) * 16384, 128, 128, (bf16_t*)(wl + L_WA) + mt * 16384, scr, r & 7, 4, lane); continue; } r -= I_LRU;
        { const int mt = r >> 3; transpose_item<0>(INP(16) + (size_t)(l * 16 + mt) * 16384, 128, 128, (bf16_t*)(wl + L_WI) + mt * 16384, scr, r & 7, 4, lane); }
    }
    __syncthreads();
    float* cact = (float*)(lds + 69632);
    float* red = (float*)lds;
    for (int i = tid; i < 8 * 2048; i += 512) { const int b = i >> 11, k = i & 2047; const float v = INP(1)[i]; cact[k * 8 + b] = v * sigm(v); }
    __syncthreads();
    for (int it = bid; it < DEPTH * 256; it += gridDim.x) {
        const int l = it / 256, n = (it % 256) * 48 + (lane < 48 ? lane : 47), kg = wave;
        const float* w = INP(2) + (size_t)l * 2048 * 12288 + (size_t)(kg * 256) * 12288 + n;
        float a[8];
#pragma unroll
        for (int b = 0; b < 8; ++b) a[b] = 0.f;
#pragma unroll 8
        for (int k = 0; k < 256; ++k) {
            const float wv = w[(size_t)k * 12288];
            const f32x4 c0 = *(const f32x4*)(cact + (kg * 256 + k) * 8), c1 = *(const f32x4*)(cact + (kg * 256 + k) * 8 + 4);
            a[0] += wv * c0[0]; a[1] += wv * c0[1]; a[2] += wv * c0[2]; a[3] += wv * c0[3];
            a[4] += wv * c1[0]; a[5] += wv * c1[1]; a[6] += wv * c1[2]; a[7] += wv * c1[3];
        }
#pragma unroll
        for (int b = 0; b < 8; ++b) red[(kg * 8 + b) * 64 + lane] = a[b];
        __syncthreads();
        { const int b = wave; float s = INP(3)[l * 12288 + n];
#pragma unroll
          for (int k2 = 0; k2 < 8; ++k2) s += red[(k2 * 8 + b) * 64 + lane];
          if (lane < 48) ((float*)(P.ws + (size_t)l * LAYER_BYTES + L_MOD))[b * 12288 + n] = s; }
        __syncthreads();
    }
}

template <int MODE>
DEV void phase_norm(const float* xin, const float* gvec, const float* mod, int seg_sh, int seg_sc, bf16_t* outb, float* outf, int bt, int lr, int nl) {
    const int tid_ = otid(); const int lane = tid_ & 63, wave = tid_ >> 6;
    const int gw = lr * 8 + wave, NGW = nl * 8;
    const int rpw = (2048 + NGW - 1) / NGW;
    int cb = -1; f32x4 sa[8], sb[8];
    for (int rl = gw * rpw; rl < (gw + 1) * rpw && rl < 2048; ++rl) {
        const int row = bt * 2048 + rl;
        const int b = row >> 11;
        if (b != cb) { cb = b;
#pragma unroll
            for (int j = 0; j < 8; ++j) { const int col = 4 * (lane + 64 * j); const f32x4 g = *(const f32x4*)(gvec + col);
                if (MODE == 0) { const f32x4 sc = *(const f32x4*)(mod + (size_t)b * 12288 + seg_sc * 2048 + col); sa[j] = g * (sc + 1.f); sb[j] = *(const f32x4*)(mod + (size_t)b * 12288 + seg_sh * 2048 + col); }
                else { sa[j] = g; } } }
        const f32x4* xr = (const f32x4*)(xin + (size_t)row * 2048) + lane;
        f32x4 v[8]; float s = 0.f;
#pragma unroll
        for (int j = 0; j < 8; ++j) { v[j] = xr[64 * j]; s += (v[j][0] * v[j][0] + v[j][1] * v[j][1]) + (v[j][2] * v[j][2] + v[j][3] * v[j][3]); }
        const float inv = 1.f / sqrtf(wave_sum(s, lane) * (1.f / 2048.f) + 1e-6f);
        if (MODE == 0) {
            u32x2* o = (u32x2*)(outb + (size_t)row * 2048) + lane;
#pragma unroll
            for (int j = 0; j < 8; ++j) { const f32x4 r = v[j] * inv * sa[j] + sb[j]; u32x2 w; w.x = cvt_pk_bf16(r[0], r[1]); w.y = cvt_pk_bf16(r[2], r[3]); o[64 * j] = w; }
        } else {
            f32x4* o = (f32x4*)(outf + (size_t)row * 2048) + lane;
#pragma unroll
            for (int j = 0; j < 8; ++j) o[64 * j] = v[j] * inv * sa[j];
        }
    }
}

DEV void cmp_item(const Params& P, int l, int item, unsigned char* lds) {
    const int tid = otid(), lane = tid & 63, w = tid >> 6, c = lane & 15, q = lane >> 4;
    const int kv = item >> 8, bg = (item >> 3) & 31, rt = item & 7, b = bg >> 2, g = bg & 3;
    unsigned char* wl = P.ws + (size_t)l * LAYER_BYTES;
    const bf16_t* src = (const bf16_t*)(P.ws + (kv ? Z_VC : Z_KC));
    const float* pos = INP(kv ? 9 : 6) + (size_t)l * 4096;
    const bf16_t* W1T = (const bf16_t*)(wl + (kv ? L_W1V : L_W1K));
    const bf16_t* W2T = (const bf16_t*)(wl + (kv ? L_W2V : L_W2K));
    const int n = rt * 16 + c; const bool valid = n < 127;
    const bf16_t* arow = src + ((size_t)(b * 2048 + 16 * (valid ? n : 0)) * 512 + g * 128);
    const bf16_t* brow = W1T + (size_t)c * 4096 + w * 512 + q * 8;
    f32x4 acc[8];
#pragma unroll
    for (int ct = 0; ct < 8; ++ct) acc[ct] = (f32x4){0.f, 0.f, 0.f, 0.f};
#pragma unroll 4
    for (int k2 = 0; k2 < 16; ++k2) {
        const int ks = w * 16 + k2, lp = ks >> 2, d = (ks & 3) * 32 + q * 8;
        const u32x4 a = *(const u32x4*)(arow + (size_t)lp * 512 + d);
        const f32x4 p0 = *(const f32x4*)(pos + ks * 32 + q * 8), p1 = *(const f32x4*)(pos + ks * 32 + q * 8 + 4);
        u32x4 bb[8];
#pragma unroll
        for (int ct = 0; ct < 8; ++ct) bb[ct] = *(const u32x4*)(brow + (size_t)ct * 16 * 4096 + k2 * 32);
        u32x4 a2;
        a2.x = cvt_pk_bf16(bflo(a.x) + p0[0], bfhi(a.x) + p0[1]); a2.y = cvt_pk_bf16(bflo(a.y) + p0[2], bfhi(a.y) + p0[3]);
        a2.z = cvt_pk_bf16(bflo(a.z) + p1[0], bfhi(a.z) + p1[1]); a2.w = cvt_pk_bf16(bflo(a.w) + p1[2], bfhi(a.w) + p1[3]);
        if (!valid) a2 = (u32x4){0u, 0u, 0u, 0u};
#pragma unroll
        for (int ct = 0; ct < 8; ++ct) acc[ct] = mfma16(as_bf16x8(a2), as_bf16x8(bb[ct]), acc[ct]);
    }
    float* part = (float*)(lds + 8192);
    bf16_t* hid = (bf16_t*)lds;
#pragma unroll
    for (int ct = 0; ct < 8; ++ct)
#pragma unroll
        for (int j = 0; j < 4; ++j) part[(w * 16 + q * 4 + j) * 128 + ct * 16 + c] = acc[ct][j];
    __syncthreads();
    {
        const int nn = tid >> 5, e4 = (tid & 31) * 4;
        f32x4 sum = *(const f32x4*)(part + nn * 128 + e4);
#pragma unroll
        for (int w2 = 1; w2 < 8; ++w2) sum = sum + *(const f32x4*)(part + (w2 * 16 + nn) * 128 + e4);
        u32x2 hv; hv.x = cvt_pk_bf16(gelu_t(sum[0]), gelu_t(sum[1])); hv.y = cvt_pk_bf16(gelu_t(sum[2]), gelu_t(sum[3]));
        *(u32x2*)(hid + nn * 136 + e4) = hv;
    }
    __syncthreads();
    f32x4 acc2 = {0.f, 0.f, 0.f, 0.f};
#pragma unroll
    for (int ks = 0; ks < 4; ++ks) {
        const u32x4 af = *(const u32x4*)(hid + c * 136 + ks * 32 + q * 8);
        const u32x4 bb = *(const u32x4*)(W2T + (size_t)(w * 16 + c) * 128 + ks * 32 + q * 8);
        acc2 = mfma16(as_bf16x8(af), as_bf16x8(bb), acc2);
    }
    if (kv == 0) { bf16_t* o = (bf16_t*)(P.ws + Z_KCMP) + ((size_t)bg * 128 + rt * 16 + q * 4) * 128 + w * 16 + c;
#pragma unroll
        for (int j = 0; j < 4; ++j) o[j * 128] = (bf16_t)(cvt_pk_bf16(acc2[j], 0.f) & 0xffff);
    } else { bf16_t* o = (bf16_t*)(P.ws + Z_VCMPT) + ((size_t)bg * 128 + w * 16 + c) * 128 + rt * 16 + q * 4;
        u32x2 wv; wv.x = cvt_pk_bf16(acc2[0], acc2[1]); wv.y = cvt_pk_bf16(acc2[2], acc2[3]); *(u32x2*)o = wv; }
    __syncthreads();
}

DEV void cmp_item32(const Params& P, int l, int item, unsigned char* lds) {
    const int tid = otid(), lane = tid & 63, w = tid >> 6, c = lane & 15, q = lane >> 4;
    const int kv = item >> 7, bg = (item >> 2) & 31, rt2 = item & 3, b = bg >> 2, g = bg & 3;
    unsigned char* wl = P.ws + (size_t)l * LAYER_BYTES;
    const bf16_t* src = (const bf16_t*)(P.ws + (kv ? Z_VC : Z_KC));
    const float* pos = INP(kv ? 9 : 6) + (size_t)l * 4096;
    const bf16_t* W1T = (const bf16_t*)(wl + (kv ? L_W1V : L_W1K));
    const bf16_t* W2T = (const bf16_t*)(wl + (kv ? L_W2V : L_W2K));
    const int n0 = rt2 * 32 + c, n1 = n0 + 16; const bool valid0 = n0 < 127, valid1 = n1 < 127;
    const bf16_t* arow0 = src + ((size_t)(b * 2048 + 16 * (valid0 ? n0 : 0)) * 512 + g * 128);
    const bf16_t* arow1 = src + ((size_t)(b * 2048 + 16 * (valid1 ? n1 : 0)) * 512 + g * 128);
    const bf16_t* brow = W1T + (size_t)c * 4096 + w * 512 + q * 8;
    f32x4 acc[2][8];
#pragma unroll
    for (int rr = 0; rr < 2; ++rr)
#pragma unroll
        for (int ct = 0; ct < 8; ++ct) acc[rr][ct] = (f32x4){0.f, 0.f, 0.f, 0.f};
#pragma unroll 2
    for (int k2 = 0; k2 < 16; ++k2) {
        const int ks = w * 16 + k2, lp = ks >> 2, d = (ks & 3) * 32 + q * 8;
        const u32x4 a0 = *(const u32x4*)(arow0 + (size_t)lp * 512 + d), a1 = *(const u32x4*)(arow1 + (size_t)lp * 512 + d);
        const f32x4 p0 = *(const f32x4*)(pos + ks * 32 + q * 8), p1 = *(const f32x4*)(pos + ks * 32 + q * 8 + 4);
        u32x4 bb[8];
#pragma unroll
        for (int ct = 0; ct < 8; ++ct) bb[ct] = *(const u32x4*)(brow + (size_t)ct * 16 * 4096 + k2 * 32);
        u32x4 x0, x1;
        x0.x = cvt_pk_bf16(bflo(a0.x) + p0[0], bfhi(a0.x) + p0[1]); x0.y = cvt_pk_bf16(bflo(a0.y) + p0[2], bfhi(a0.y) + p0[3]);
        x0.z = cvt_pk_bf16(bflo(a0.z) + p1[0], bfhi(a0.z) + p1[1]); x0.w = cvt_pk_bf16(bflo(a0.w) + p1[2], bfhi(a0.w) + p1[3]);
        x1.x = cvt_pk_bf16(bflo(a1.x) + p0[0], bfhi(a1.x) + p0[1]); x1.y = cvt_pk_bf16(bflo(a1.y) + p0[2], bfhi(a1.y) + p0[3]);
        x1.z = cvt_pk_bf16(bflo(a1.z) + p1[0], bfhi(a1.z) + p1[1]); x1.w = cvt_pk_bf16(bflo(a1.w) + p1[2], bfhi(a1.w) + p1[3]);
        if (!valid0) x0 = (u32x4){0u, 0u, 0u, 0u};
        if (!valid1) x1 = (u32x4){0u, 0u, 0u, 0u};
#pragma unroll
        for (int ct = 0; ct < 8; ++ct) { acc[0][ct] = mfma16(as_bf16x8(x0), as_bf16x8(bb[ct]), acc[0][ct]); acc[1][ct] = mfma16(as_bf16x8(x1), as_bf16x8(bb[ct]), acc[1][ct]); }
    }
    float* part = (float*)(lds + 9216);
    bf16_t* hid = (bf16_t*)lds;
#pragma unroll
    for (int rr = 0; rr < 2; ++rr)
#pragma unroll
        for (int ct = 0; ct < 8; ++ct)
#pragma unroll
            for (int j = 0; j < 4; ++j) part[(w * 32 + rr * 16 + q * 4 + j) * 128 + ct * 16 + c] = acc[rr][ct][j];
    __syncthreads();
    {
        const int nn = tid >> 4, e8 = (tid & 15) * 8;
#pragma unroll
        for (int hh = 0; hh < 2; ++hh) {
            f32x4 sum = *(const f32x4*)(part + nn * 128 + e8 + 4 * hh);
#pragma unroll
            for (int w2 = 1; w2 < 8; ++w2) sum = sum + *(const f32x4*)(part + (w2 * 32 + nn) * 128 + e8 + 4 * hh);
            u32x2 hv; hv.x = cvt_pk_bf16(gelu_t(sum[0]), gelu_t(sum[1])); hv.y = cvt_pk_bf16(gelu_t(sum[2]), gelu_t(sum[3]));
            *(u32x2*)(hid + nn * 136 + e8 + 4 * hh) = hv;
        }
    }
    __syncthreads();
#pragma unroll
    for (int rr = 0; rr < 2; ++rr) {
        f32x4 acc2 = {0.f, 0.f, 0.f, 0.f};
#pragma unroll
        for (int ks = 0; ks < 4; ++ks) {
            const u32x4 af = *(const u32x4*)(hid + (rr * 16 + c) * 136 + ks * 32 + q * 8);
            const u32x4 bb = *(const u32x4*)(W2T + (size_t)(w * 16 + c) * 128 + ks * 32 + q * 8);
            acc2 = mfma16(as_bf16x8(af), as_bf16x8(bb), acc2);
        }
        if (kv == 0) { bf16_t* o = (bf16_t*)(P.ws + Z_KCMP) + ((size_t)bg * 128 + rt2 * 32 + rr * 16 + q * 4) * 128 + w * 16 + c;
#pragma unroll
            for (int j = 0; j < 4; ++j) o[j * 128] = (bf16_t)(cvt_pk_bf16(acc2[j], 0.f) & 0xffff);
        } else { bf16_t* o = (bf16_t*)(P.ws + Z_VCMPT) + ((size_t)bg * 128 + w * 16 + c) * 128 + rt2 * 32 + rr * 16 + q * 4;
            u32x2 wv; wv.x = cvt_pk_bf16(acc2[0], acc2[1]); wv.y = cvt_pk_bf16(acc2[2], acc2[3]); *(u32x2*)o = wv; }
    }
    __syncthreads();
}

DEV void lru_item(const Params& P, int l, int item, unsigned char* lds) {
    const int tid = otid(), lane = tid & 63, w = tid >> 6, c = lane & 15, q = lane >> 4;
    const int b = item >> 5, n = (item >> 1) & 15, e = item & 1;
    const int C0 = n * 128, CO = C0 + e * 64;
    unsigned char* wl = P.ws + (size_t)l * LAYER_BYTES;
    constexpr int O_LX = 0, O_UB = 17408, O_UF = 34816, O_WA = 51200, O_WI = 68608, O_A = 86016, O_B = 102400;
    bf16_t* zlx = (bf16_t*)(P.ws + Z_LX); bf16_t* zly = (bf16_t*)(P.ws + Z_LY);
    __syncthreads();
    for (int id = tid; id < 2 * 64 * 16; id += 512) {
        const int which = id >> 10, r = (id >> 4) & 63, pc = id & 15;
        const bf16_t* s = (const bf16_t*)(wl + (which ? L_WI : L_WA)) + ((size_t)(n * 128 + e * 64 + r)) * 128 + pc * 8;
        *(u32x4*)(lds + (which ? O_WI : O_WA) + r * 272 + pc * 16) = *(const u32x4*)s;
    }
    const int chg = tid & 15, tl0 = tid >> 4;
    float cw[4][8], cbias[8];
#pragma unroll
    for (int i = 0; i < 8; ++i) { cbias[i] = INP(13)[l * 2048 + C0 + chg * 8 + i];
#pragma unroll
        for (int j = 0; j < 4; ++j) cw[j][i] = INP(12)[(l * 4 + j) * 2048 + C0 + chg * 8 + i]; }
    const int rt = w & 3, cp = w >> 2;
    float ba[2], bi[2], ll[2];
#pragma unroll
    for (int k2 = 0; k2 < 2; ++k2) { const int ch = l * 2048 + CO + (cp * 2 + k2) * 16 + c; ba[k2] = -1.4426950408889634f * INP(15)[ch]; bi[k2] = -1.4426950408889634f * INP(17)[ch];
        const float tl = 1.4426950408889634f * INP(18)[ch];
        ll[k2] = 8.f * (tl > 0.f ? -__builtin_amdgcn_logf(1.f + __builtin_amdgcn_exp2f(-tl)) : tl - __builtin_amdgcn_logf(1.f + __builtin_amdgcn_exp2f(tl))); }
    float* SEGA = (float*)(lds + 118784); float* SEGH = (float*)(lds + 120832); float* CARRY = (float*)(lds + 122880);
    if (tid < 64) CARRY[tid] = 0.f;
    float* UF = (float*)(lds + O_UF); float* Aa = (float*)(lds + O_A); float* Bb = (float*)(lds + O_B);
    const bf16_t* xcol = zlx + ((size_t)b * 2048) * 2048 + C0 + chg * 8;
    u32x4 xr[2][4];
#pragma unroll
    for (int p = 0; p < 2; ++p)
#pragma unroll
        for (int j = 0; j < 4; ++j) { const int t = tl0 + 32 * p + j - 3; xr[p][j] = (u32x4){0u, 0u, 0u, 0u}; if (t >= 0) xr[p][j] = *(const u32x4*)(xcol + (size_t)t * 2048); }
    u32x4 lyr = {0u, 0u, 0u, 0u}; bf16_t* lyp = zly;
    auto output = [&]() __attribute__((always_inline)) {
        const int tl = tid >> 3, c8 = (tid & 7) * 8;
        const u32x4 y = lyr;
        const f32x4 h0 = *(const f32x4*)(Bb + tl * 64 + c8), h1 = *(const f32x4*)(Bb + tl * 64 + c8 + 4);
        u32x4 o;
        o.x = cvt_pk_bf16(gelu_t(bflo(y.x)) * h0[0], gelu_t(bfhi(y.x)) * h0[1]); o.y = cvt_pk_bf16(gelu_t(bflo(y.y)) * h0[2], gelu_t(bfhi(y.y)) * h0[3]);
        o.z = cvt_pk_bf16(gelu_t(bflo(y.z)) * h1[0], gelu_t(bfhi(y.z)) * h1[1]); o.w = cvt_pk_bf16(gelu_t(bflo(y.w)) * h1[2], gelu_t(bfhi(y.w)) * h1[3]);
        *(u32x4*)lyp = o;
    };
    __syncthreads();
    bf16x8 wfa[4][2], wfi[4][2];
#pragma unroll
    for (int ks = 0; ks < 4; ++ks)
#pragma unroll
        for (int k2 = 0; k2 < 2; ++k2) { const int ct = cp * 2 + k2;
            wfa[ks][k2] = *(const bf16x8*)(lds + O_WA + (ct * 16 + c) * 272 + ks * 64 + q * 16);
            wfi[ks][k2] = *(const bf16x8*)(lds + O_WI + (ct * 16 + c) * 272 + ks * 64 + q * 16); }
    for (int ci = 0; ci < 32; ++ci) {
        const int t0 = ci * 64;
        if (ci > 0) output();
        lyp = zly + ((size_t)(b * 2048 + t0 + (tid >> 3))) * 2048 + CO + (tid & 7) * 8;
        lyr = *(const u32x4*)lyp;
#pragma unroll
        for (int pass = 0; pass < 2; ++pass) {
            const int tl = tl0 + 32 * pass;
            float u[8];
#pragma unroll
            for (int i = 0; i < 8; ++i) u[i] = cbias[i];
#pragma unroll
            for (int j = 0; j < 4; ++j) {
                const u32x4 x = xr[pass][j];
                u[0] += cw[j][0] * bflo(x.x); u[1] += cw[j][1] * bfhi(x.x); u[2] += cw[j][2] * bflo(x.y); u[3] += cw[j][3] * bfhi(x.y);
                u[4] += cw[j][4] * bflo(x.z); u[5] += cw[j][5] * bfhi(x.z); u[6] += cw[j][6] * bflo(x.w); u[7] += cw[j][7] * bfhi(x.w);
            }
            u32x4 pk; pk.x = cvt_pk_bf16(u[0], u[1]); pk.y = cvt_pk_bf16(u[2], u[3]); pk.z = cvt_pk_bf16(u[4], u[5]); pk.w = cvt_pk_bf16(u[6], u[7]);
            *(u32x4*)(lds + O_UB + tl * 272 + chg * 16) = pk;
            if ((chg >> 3) == e) { float* uf = UF + tl * 64 + (chg & 7) * 8;
                *(f32x4*)uf = (f32x4){u[0], u[1], u[2], u[3]}; *(f32x4*)(uf + 4) = (f32x4){u[4], u[5], u[6], u[7]}; }
        }
        if (ci + 1 < 32) {
#pragma unroll
            for (int p = 0; p < 2; ++p)
#pragma unroll
                for (int j = 0; j < 4; ++j) xr[p][j] = *(const u32x4*)(xcol + (size_t)(t0 + 64 + tl0 + 32 * p + j - 3) * 2048);
        }
        __syncthreads();
        {
            f32x4 ar[2], ai[2];
#pragma unroll
            for (int k2 = 0; k2 < 2; ++k2) { ar[k2] = (f32x4){0.f, 0.f, 0.f, 0.f}; ai[k2] = (f32x4){0.f, 0.f, 0.f, 0.f}; }
#pragma unroll
            for (int ks = 0; ks < 4; ++ks) {
                const bf16x8 af = *(const bf16x8*)(lds + O_UB + (rt * 16 + c) * 272 + ks * 64 + q * 16);
#pragma unroll
                for (int k2 = 0; k2 < 2; ++k2) { ar[k2] = mfma16(af, wfa[ks][k2], ar[k2]); ai[k2] = mfma16(af, wfi[ks][k2], ai[k2]); }
            }
#pragma unroll
            for (int k2 = 0; k2 < 2; ++k2)
#pragma unroll
                for (int j = 0; j < 4; ++j) {
                    const int tl = rt * 16 + q * 4 + j, cc = (cp * 2 + k2) * 16 + c;
                    const float uu = UF[tl * 64 + cc];
                    const float r = frcp(1.f + __builtin_amdgcn_exp2f(__builtin_fmaf(ar[k2][j], -1.4426950408889634f, ba[k2])));
                    const float ig = frcp(1.f + __builtin_amdgcn_exp2f(__builtin_fmaf(ai[k2][j], -1.4426950408889634f, bi[k2])));
                    const float av = __builtin_amdgcn_exp2f(r * ll[k2]);
                    const float om = __builtin_fmaf(-av, av, 1.f);
                    Aa[tl * 64 + cc] = av;
                    Bb[tl * 64 + cc] = __builtin_amdgcn_sqrtf(fmaxf(om, 0.f)) * (ig * uu);
                }
        }
        __syncthreads();
        {
            float av8[8], hl[8]; float Acum = 1.f, h = 0.f;
#pragma unroll
            for (int k = 0; k < 8; ++k) { const float a = Aa[(w * 8 + k) * 64 + lane], bb2 = Bb[(w * 8 + k) * 64 + lane]; h = a * h + bb2; Acum *= a; av8[k] = Acum; hl[k] = h; }
            SEGA[w * 64 + lane] = Acum; SEGH[w * 64 + lane] = h;
            __syncthreads();
            float hin = CARRY[(ci & 1) * 64 + lane];
            float sa7[7], sh7[7];
#pragma unroll
            for (int s2 = 0; s2 < 7; ++s2) { sa7[s2] = SEGA[s2 * 64 + lane]; sh7[s2] = SEGH[s2 * 64 + lane]; }
#pragma unroll
            for (int s2 = 0; s2 < 7; ++s2) if (s2 < w) hin = sa7[s2] * hin + sh7[s2];
#pragma unroll
            for (int k = 0; k < 8; ++k) { hl[k] = hl[k] + av8[k] * hin; Bb[(w * 8 + k) * 64 + lane] = hl[k]; }
            if (w == 7) CARRY[((ci + 1) & 1) * 64 + lane] = hl[7];
        }
        __syncthreads();
    }
    output();
    __syncthreads();
}

constexpr int A_KC = 0, A_VC = 34816, A_K = 0, A_V = 17408, A_E = 69632, A_CAR = 102400, A_IMP = 118784, A_SEL = 142336, A_OST = 71680;
constexpr float L2E = 1.4426950408889634f;

DEV void attn_item(const Params& P, int b, int g, int qt, unsigned char* lds) {
    const int tid = otid(), lane = tid & 63, w = tid >> 6, c = lane & 15, q = lane >> 4;
    const int hg = w >> 1, th = w & 1, head = g * 4 + hg, bg = b * 4 + g;
    const int tq0 = 64 * qt + 32 * th;
    const size_t rowbase = (size_t)b * 2048;
    bf16_t* zq = (bf16_t*)(P.ws + Z_Q);
    bf16_t* zo = PROBE_CHECK ? (bf16_t*)(P.ws + WS_OBUF) : zq;

    bf16x8 QF[2][4];
#pragma unroll
    for (int nt = 0; nt < 2; ++nt)
#pragma unroll
        for (int ks = 0; ks < 4; ++ks) QF[nt][ks] = *(const bf16x8*)(zq + (rowbase + tq0 + 16 * nt + c) * 2048 + head * 128 + ks * 32 + q * 8);
    float gate[3][2];
#pragma unroll
    for (int nt = 0; nt < 2; ++nt)
#pragma unroll
        for (int br = 0; br < 3; ++br) { const unsigned short gv = ((const bf16_t*)(P.ws + Z_GATE))[(rowbase + tq0 + 16 * nt + c) * 64 + head * 3 + br]; gate[br][nt] = sigm(bflo((unsigned)gv)); }

    __syncthreads();
    {
        const bf16_t* kc = (const bf16_t*)(P.ws + Z_KCMP) + (size_t)bg * 16384; const bf16_t* vc = (const bf16_t*)(P.ws + Z_VCMPT) + (size_t)bg * 16384;
#pragma unroll
        for (int i = 0; i < 4; ++i) { const int id = tid + 512 * i, r = id >> 4, pc = id & 15;
            { const int kk = r & 31, rho = (r & ~31) + ((kk >> 2) & 1) * 16 + (kk >> 3) * 4 + (kk & 3);
              *(u32x4*)(lds + A_KC + rho * 272 + pc * 16) = *(const u32x4*)(kc + r * 128 + pc * 8); }
            *(u32x4*)(lds + A_VC + r * 272 + pc * 16) = *(const u32x4*)(vc + r * 128 + pc * 8); }
    }
    __syncthreads();

    f32x4 o[8][2];
#pragma unroll
    for (int dt = 0; dt < 8; ++dt)
#pragma unroll
        for (int nt = 0; nt < 2; ++nt) o[dt][nt] = (f32x4){0.f, 0.f, 0.f, 0.f};
    {
        f32x4 s[4][2][2];
#pragma unroll
        for (int ch = 0; ch < 4; ++ch)
#pragma unroll
            for (int u = 0; u < 2; ++u)
#pragma unroll
                for (int nt = 0; nt < 2; ++nt) s[ch][u][nt] = (f32x4){0.f, 0.f, 0.f, 0.f};
        const int nch = (4 * qt + 2) / 32 + 1;
#pragma unroll
        for (int ch = 0; ch < 4; ++ch) if (ch < nch) {
#pragma unroll
            for (int ks = 0; ks < 4; ++ks)
#pragma unroll
                for (int u = 0; u < 2; ++u) {
                    const bf16x8 kf = *(const bf16x8*)(lds + A_KC + (ch * 32 + u * 16 + c) * 272 + ks * 64 + q * 16);
#pragma unroll
                    for (int nt = 0; nt < 2; ++nt) s[ch][u][nt] = mfma16(kf, QF[nt][ks], s[ch][u][nt]);
                }
        }
        float* E = (float*)(lds + A_E); float* CAR = (float*)(lds + A_CAR);
#pragma unroll
        for (int nt = 0; nt < 2; ++nt) {
            const int t = tq0 + 16 * nt + c, nmax = (t - 31) >> 4;
            float mx = -1e30f;
#pragma unroll
            for (int ch = 0; ch < 4; ++ch)
#pragma unroll
                for (int u = 0; u < 2; ++u)
#pragma unroll
                    for (int j = 0; j < 4; ++j) { const int n = ch * 32 + q * 8 + u * 4 + j; const float v = s[ch][u][nt][j] * L2E; s[ch][u][nt][j] = v; if (n <= nmax) mx = fmaxf(mx, v); }
            mx = fmaxf(mx, shx(mx, 16, lane)); mx = fmaxf(mx, shx(mx, 32, lane));
            float sum = 0.f;
#pragma unroll
            for (int ch = 0; ch < 4; ++ch)
#pragma unroll
                for (int u = 0; u < 2; ++u)
#pragma unroll
                    for (int j = 0; j < 4; ++j) { const int n = ch * 32 + q * 8 + u * 4 + j; const float p = (n <= nmax) ? __builtin_amdgcn_exp2f(s[ch][u][nt][j] - mx) : 0.f; s[ch][u][nt][j] = p; sum += p; }
            sum += shx(sum, 16, lane); sum += shx(sum, 32, lane);
            const float inv = frcp(fmaxf(sum, 1e-30f));
            const int tl = 32 * th + 16 * nt + c;
#pragma unroll
            for (int ch = 0; ch < 4; ++ch) {
#pragma unroll
                for (int u = 0; u < 2; ++u) s[ch][u][nt] = s[ch][u][nt] * inv;
                const f32x4 pa = s[ch][0][nt], pb = s[ch][1][nt];
                E[(hg * 64 + tl) * 32 + 8 * ch + 2 * q] = (pa[0] + pa[1]) + (pa[2] + pa[3]);
                E[(hg * 64 + tl) * 32 + 8 * ch + 2 * q + 1] = pa[3] + ((pb[0] + pb[1]) + (pb[2] + pb[3]));
                CAR[(hg * 64 + tl) * 16 + 4 * ch + q] = pb[3];
            }
        }
#pragma unroll
        for (int ch = 0; ch < 4; ++ch) if (ch < nch) {
            bf16x8 pf[2];
#pragma unroll
            for (int nt = 0; nt < 2; ++nt) pf[nt] = as_bf16x8(pack8(s[ch][0][nt], s[ch][1][nt]));
#pragma unroll
            for (int dt = 0; dt < 8; ++dt) {
                const bf16x8 vf = *(const bf16x8*)(lds + A_VC + (dt * 16 + c) * 272 + (ch * 32 + q * 8) * 2);
#pragma unroll
                for (int nt = 0; nt < 2; ++nt) o[dt][nt] = mfma16(vf, pf[nt], o[dt][nt]);
            }
        }
    }
    u32x4 pk[2], pv[2];
#pragma unroll
    for (int i = 0; i < 2; ++i) { const int id = tid + 512 * i;
        pk[i] = *(const u32x4*)((const bf16_t*)(P.ws + Z_KS) + (rowbase + 64 * qt + (id >> 4)) * 512 + g * 128 + (id & 15) * 8);
        pv[i] = *(const u32x4*)((const bf16_t*)(P.ws + Z_VST) + ((size_t)bg * 128 + (id >> 3)) * 2048 + 64 * qt + (id & 7) * 8); }
    __syncthreads();
    {
        const float* E = (const float*)(lds + A_E); const float* CAR = (const float*)(lds + A_CAR); float* IMP = (float*)(lds + A_IMP);
        const int tl = tid >> 3, jg = tid & 7;
#pragma unroll
        for (int jj = 0; jj < 4; ++jj) { const int j = jg * 4 + jj; float v = 0.f;
#pragma unroll
            for (int h = 0; h < 4; ++h) { v += E[(h * 64 + tl) * 32 + j]; if ((j & 1) == 0 && j >= 2) v += CAR[(h * 64 + tl) * 16 + (j >> 1) - 1]; }
            IMP[tl * 32 + j] = v; }
        __syncthreads();
        const int cur = qt, nforced = cur >= 2 ? 3 : cur + 1;
        unsigned bits = 0u;
        const f32x4 v4 = *(const f32x4*)(IMP + tl * 32 + jg * 4);
        int cnt[4] = {0, 0, 0, 0};
#pragma unroll 4
        for (int j2 = 1; j2 <= cur - 2; ++j2) { const float v2 = IMP[tl * 32 + j2];
#pragma unroll
            for (int jj = 0; jj < 4; ++jj) cnt[jj] += (v2 > v4[jj] || (v2 == v4[jj] && j2 < jg * 4 + jj)) ? 1 : 0; }
#pragma unroll
        for (int jj = 0; jj < 4; ++jj) { const int j = jg * 4 + jj; bool sel;
            if (j > cur) sel = false;
            else if (j == 0 || j > cur - 2) sel = true;
            else sel = cnt[jj] < 16 - nforced;
            bits |= sel ? (1u << j) : 0u; }
        bits |= shxu(bits, 1, lane); bits |= shxu(bits, 2, lane); bits |= shxu(bits, 4, lane);
        if (jg == 0) ((unsigned*)(lds + A_SEL))[tl] = bits;
    }
    __syncthreads();
    unsigned selm[2];
#pragma unroll
    for (int nt = 0; nt < 2; ++nt) selm[nt] = ((const unsigned*)(lds + A_SEL))[32 * th + 16 * nt + c];
    unsigned char* ost = lds + A_OST + w * 8704;
#pragma unroll
    for (int nt = 0; nt < 2; ++nt)
#pragma unroll
        for (int dt = 0; dt < 8; ++dt) {
            const f32x4 r = o[dt][nt] * gate[0][nt];
            u32x2 wv; wv.x = cvt_pk_bf16(r[0], r[1]); wv.y = cvt_pk_bf16(r[2], r[3]);
            *(u32x2*)(ost + (16 * nt + c) * 272 + (16 * dt + 4 * q) * 2) = wv;
        }

    constexpr int KVB = 35840;
#pragma unroll 1
    for (int br = 0; br < 2; ++br) {
        const bf16_t* Ks = (const bf16_t*)(P.ws + (br ? Z_KW : Z_KS)); const bf16_t* Vs = (const bf16_t*)(P.ws + (br ? Z_VWT : Z_VST));
        const int ntile = br ? (qt + 1 < 9 ? qt + 1 : 9) : qt + 1;
        unsigned sm[2]; int lo[2], tq[2];
#pragma unroll
        for (int nt = 0; nt < 2; ++nt) { tq[nt] = tq0 + 16 * nt + c; sm[nt] = br ? 0xffffffffu : selm[nt]; lo[nt] = br ? tq[nt] - 511 : -1; }
        float mrow[2] = {-1e30f, -1e30f}, lrow[2] = {0.f, 0.f};
#pragma unroll
        for (int dt = 0; dt < 8; ++dt)
#pragma unroll
            for (int nt = 0; nt < 2; ++nt) o[dt][nt] = (f32x4){0.f, 0.f, 0.f, 0.f};
        auto tile_of = [&](int i) { return br ? qt - i : (i == 0 ? qt : i - 1); };
        auto prefetch = [&](int j) {
#pragma unroll
            for (int i = 0; i < 2; ++i) { const int id = tid + 512 * i;
                pk[i] = *(const u32x4*)(Ks + (rowbase + 64 * j + (id >> 4)) * 512 + g * 128 + (id & 15) * 8);
                pv[i] = *(const u32x4*)(Vs + ((size_t)bg * 128 + (id >> 3)) * 2048 + 64 * j + (id & 7) * 8); }
        };
        auto stage = [&](int buf) {
#pragma unroll
            for (int i2 = 0; i2 < 2; ++i2) { const int id = tid + 512 * i2, r = id >> 4, kk = r & 31, rho = (r & ~31) + ((kk >> 2) & 1) * 16 + (kk >> 3) * 4 + (kk & 3);
                *(u32x4*)(lds + buf * KVB + rho * 272 + (id & 15) * 16) = pk[i2];
                *(u32x4*)(lds + buf * KVB + 17408 + (id >> 3) * 144 + (id & 7) * 16) = pv[i2]; }
        };
        __syncthreads();
        stage(0);
        if (ntile > 1) prefetch(tile_of(1));
        __syncthreads();
#pragma unroll 1
        for (int i = 0; i < ntile; ++i) {
            const int j = tile_of(i);
            const unsigned char* kb = lds + (i & 1) * KVB; const unsigned char* vb = kb + 17408;
            f32x4 s[2][2][2];
#pragma unroll
            for (int ch = 0; ch < 2; ++ch)
#pragma unroll
                for (int u = 0; u < 2; ++u)
#pragma unroll
                    for (int nt = 0; nt < 2; ++nt) s[ch][u][nt] = (f32x4){0.f, 0.f, 0.f, 0.f};
            {
                const unsigned char* kp = kb + c * 272 + q * 16;
#define KFRAG(f) (*(const bf16x8*)(kp + (((f) >> 3) * 32 + ((f) & 1) * 16) * 272 + (((f) >> 1) & 3) * 64))
                bf16x8 kfa = KFRAG(0), kfb = KFRAG(1);
                __builtin_amdgcn_sched_barrier(0);
#pragma unroll
                for (int f = 0; f < 16; ++f) {
                    const int ch = f >> 3, ks = (f >> 1) & 3, u = f & 1;
                    const bf16x8 kf = (f & 1) ? kfb : kfa;
#pragma unroll
                    for (int nt = 0; nt < 2; ++nt) s[ch][u][nt] = mfma16(kf, QF[nt][ks], s[ch][u][nt]);
                    if (f + 2 < 16) { if (f & 1) kfb = KFRAG(f + 2); else kfa = KFRAG(f + 2); }
                    __builtin_amdgcn_sched_barrier(0);
                }
#undef KFRAG
            }
            const bool needkey = (j == qt) || (br && j == qt - 8);
            const bool sel0 = (sm[0] >> j) & 1u, sel1 = (sm[1] >> j) & 1u;
            const bool allsel = __builtin_amdgcn_ballot_w64(!(sel0 && sel1)) == 0ull;
            if (needkey) {
#pragma unroll
                for (int nt = 0; nt < 2; ++nt) { const bool sl = nt ? sel1 : sel0;
#pragma unroll
                    for (int ch = 0; ch < 2; ++ch)
#pragma unroll
                        for (int u = 0; u < 2; ++u)
#pragma unroll
                            for (int jj = 0; jj < 4; ++jj) { const int key = 64 * j + ch * 32 + q * 8 + u * 4 + jj;
                                const bool ok = sl && key <= tq[nt] && key >= lo[nt]; s[ch][u][nt][jj] = ok ? s[ch][u][nt][jj] : -1e30f; } }
            } else if (!allsel) {
#pragma unroll
                for (int nt = 0; nt < 2; ++nt) { const bool sl = nt ? sel1 : sel0;
#pragma unroll
                    for (int ch = 0; ch < 2; ++ch)
#pragma unroll
                        for (int u = 0; u < 2; ++u)
#pragma unroll
                            for (int jj = 0; jj < 4; ++jj) s[ch][u][nt][jj] = sl ? s[ch][u][nt][jj] : -1e30f; }
            }
            float mnew[2];
#pragma unroll
            for (int nt = 0; nt < 2; ++nt) {
                float mx = -1e30f;
#pragma unroll
                for (int ch = 0; ch < 2; ++ch)
#pragma unroll
                    for (int u = 0; u < 2; ++u) mx = fmaxf(fmaxf(mx, fmaxf(s[ch][u][nt][0], s[ch][u][nt][1])), fmaxf(s[ch][u][nt][2], s[ch][u][nt][3]));
                mx = fmaxf(mx, shx(mx, 16, lane)); mx = fmaxf(mx, shx(mx, 32, lane));
                mnew[nt] = fmaxf(mrow[nt], mx * L2E);
            }
            if (__builtin_amdgcn_ballot_w64(mnew[0] > mrow[0] + 8.f || mnew[1] > mrow[1] + 8.f) != 0ull) {
#pragma unroll
                for (int nt = 0; nt < 2; ++nt) { const float alpha = __builtin_amdgcn_exp2f(mrow[nt] - mnew[nt]); mrow[nt] = mnew[nt]; lrow[nt] *= alpha;
#pragma unroll
                    for (int dt = 0; dt < 8; ++dt) o[dt][nt] = o[dt][nt] * alpha; }
            }
#pragma unroll
            for (int nt = 0; nt < 2; ++nt) {
                const float nm = -mrow[nt]; float ps = 0.f;
#pragma unroll
                for (int ch = 0; ch < 2; ++ch)
#pragma unroll
                    for (int u = 0; u < 2; ++u)
#pragma unroll
                        for (int jj = 0; jj < 4; ++jj) { const float p = __builtin_amdgcn_exp2f(__builtin_fmaf(s[ch][u][nt][jj], L2E, nm)); s[ch][u][nt][jj] = p; ps += p; }
                lrow[nt] += ps;
            }
            {
                bf16x8 pf[2][2];
#pragma unroll
                for (int ch = 0; ch < 2; ++ch)
#pragma unroll
                    for (int nt = 0; nt < 2; ++nt) pf[ch][nt] = as_bf16x8(pack8(s[ch][0][nt], s[ch][1][nt]));
                const unsigned char* vp = vb + c * 144 + q * 16;
#define VFRAG(f) (*(const bf16x8*)(vp + ((f) & 7) * 16 * 144 + ((f) >> 3) * 64))
                bf16x8 vfa = VFRAG(0), vfb = VFRAG(1);
                __builtin_amdgcn_sched_barrier(0);
#pragma unroll
                for (int f = 0; f < 16; ++f) {
                    const int ch = f >> 3, dt = f & 7;
                    const bf16x8 vf = (f & 1) ? vfb : vfa;
#pragma unroll
                    for (int nt = 0; nt < 2; ++nt) o[dt][nt] = mfma16(vf, pf[ch][nt], o[dt][nt]);
                    if (f + 2 < 16) { if (f & 1) vfb = VFRAG(f + 2); else vfa = VFRAG(f + 2); }
                    __builtin_amdgcn_sched_barrier(0);
                }
#undef VFRAG
            }
            if (i + 1 < ntile) { stage((i + 1) & 1); if (i + 2 < ntile) prefetch(tile_of(i + 2)); }
            __syncthreads();
        }
        if (br == 0) {
#pragma unroll
            for (int i = 0; i < 2; ++i) { const int id = tid + 512 * i;
                pk[i] = *(const u32x4*)((const bf16_t*)(P.ws + Z_KW) + (rowbase + 64 * qt + (id >> 4)) * 512 + g * 128 + (id & 15) * 8);
                pv[i] = *(const u32x4*)((const bf16_t*)(P.ws + Z_VWT) + ((size_t)bg * 128 + (id >> 3)) * 2048 + 64 * qt + (id & 7) * 8); }
        }
#pragma unroll
        for (int nt = 0; nt < 2; ++nt) {
            float lsum = lrow[nt]; lsum += shx(lsum, 16, lane); lsum += shx(lsum, 32, lane);
            const float sc = gate[1 + br][nt] * frcp(fmaxf(lsum, 1e-30f));
#pragma unroll
            for (int dt = 0; dt < 8; ++dt) {
                u32x2* p = (u32x2*)(ost + (16 * nt + c) * 272 + (16 * dt + 4 * q) * 2);
                const u32x2 pv2 = *p; const f32x4 r = o[dt][nt] * sc;
                u32x2 wv; wv.x = cvt_pk_bf16(bflo(pv2.x) + r[0], bfhi(pv2.x) + r[1]); wv.y = cvt_pk_bf16(bflo(pv2.y) + r[2], bfhi(pv2.y) + r[3]);
                *p = wv;
            }
        }
    }
#pragma unroll
    for (int i = 0; i < 8; ++i) { const int r = (lane >> 4) + 4 * i, ck = lane & 15;
        *(u32x4*)(zo + (rowbase + tq0 + r) * 2048 + head * 128 + ck * 8) = *(const u32x4*)(ost + r * 272 + ck * 16); }
}

#if PROBE_CHECK
DEV float bfv(const bf16_t* p) { return __builtin_bit_cast(float, (unsigned)(*p) << 16); }
DEV void nsa_check(const Params& P, unsigned char* lds) {
    const int tid = otid(), bid = obid();
    const int b = bid & 7, g = (bid >> 3) & 3, t = (bid * 677 + 331) & 2047, bg = b * 4 + g, cur = t >> 6;
    const int h = tid >> 7, d = tid & 127;
    float* qs = (float*)lds;
    float* sc = (float*)(lds + 2048);
    float* impv = (float*)(lds + 2048 + 32768);
    unsigned* selw = (unsigned*)(lds + 2048 + 32768 + 128);
    float* red = (float*)(lds + 2048 + 32768 + 256);
    const bf16_t* zq = (const bf16_t*)(P.ws + Z_Q);
    const size_t row = (size_t)b * 2048 + t;
    __syncthreads();
    qs[h * 128 + d] = bfv(zq + row * 2048 + (g * 4 + h) * 128 + d);
    __syncthreads();
    const int nvis = t >= 31 ? ((t - 31) >> 4) + 1 : 0;
    { const int n = d; float s = -INFINITY;
      if (n < nvis) { s = 0.f; const bf16_t* kr = (const bf16_t*)(P.ws + Z_KCMP) + ((size_t)bg * 128 + n) * 128; for (int k = 0; k < 128; ++k) s += qs[h * 128 + k] * bfv(kr + k); }
      sc[h * 2048 + n] = s; }
    __syncthreads();
    if (tid < 4) { float m = -INFINITY; for (int n = 0; n < 128; ++n) m = fmaxf(m, sc[tid * 2048 + n]); if (!(m > -INFINITY)) m = 0.f;
        float sum = 0.f; for (int n = 0; n < 128; ++n) { const float p = __expf(sc[tid * 2048 + n] - m); sc[tid * 2048 + n] = p; sum += p; }
        const float inv = 1.f / fmaxf(sum, 1e-30f); for (int n = 0; n < 128; ++n) sc[tid * 2048 + n] *= inv; }
    __syncthreads();
    float o_cmp = 0.f;
    { const bf16_t* vr = (const bf16_t*)(P.ws + Z_VCMPT) + ((size_t)bg * 128 + d) * 128; for (int n = 0; n < 127; ++n) o_cmp += sc[h * 2048 + n] * bfv(vr + n); }
    if (tid < 32) { float v = 0.f; for (int hh = 0; hh < 4; ++hh) for (int n = 4 * tid - 1; n <= 4 * tid + 3; ++n) if (n >= 0 && n <= 126) v += sc[hh * 2048 + n]; impv[tid] = v; }
    __syncthreads();
    if (tid == 0) {
        unsigned mask = 0u;
        for (int pick = 0; pick < 16; ++pick) { int best = -1; float bv = 0.f;
            for (int j = 0; j < 32; ++j) { if ((mask >> j) & 1u) continue;
                const bool valid = j <= cur, forced = (j == 0) || (valid && j > cur - 2);
                const float v = forced ? impv[j] + 1e4f : (valid ? impv[j] : -1.f);
                if (best < 0 || v > bv) { best = j; bv = v; } }
            mask |= 1u << best; }
        selw[0] = mask; }
    __syncthreads();
    const unsigned selmask = selw[0];
    float o_br[2];
    for (int br = 0; br < 2; ++br) {
        const bf16_t* Ks = (const bf16_t*)(P.ws + (br ? Z_KW : Z_KS)); const bf16_t* Vs = (const bf16_t*)(P.ws + (br ? Z_VWT : Z_VST));
        __syncthreads();
        for (int cidx = 0; cidx < 16; ++cidx) { const int key = cidx * 128 + d; float s = -INFINITY;
            const bool ok = br ? (key <= t && key > t - 512) : (key <= t && ((selmask >> (key >> 6)) & 1u));
            if (ok) { s = 0.f; const bf16_t* kr = Ks + ((size_t)b * 2048 + key) * 512 + g * 128; for (int k = 0; k < 128; ++k) s += qs[h * 128 + k] * bfv(kr + k); }
            sc[h * 2048 + key] = s; }
        __syncthreads();
        if (tid < 4) { float m = -INFINITY; for (int n = 0; n < 2048; ++n) m = fmaxf(m, sc[tid * 2048 + n]); if (!(m > -INFINITY)) m = 0.f;
            float sum = 0.f; for (int n = 0; n < 2048; ++n) { const float p = __expf(sc[tid * 2048 + n] - m); sc[tid * 2048 + n] = p; sum += p; }
            const float inv = 1.f / fmaxf(sum, 1e-30f); for (int n = 0; n < 2048; ++n) sc[tid * 2048 + n] *= inv; }
        __syncthreads();
        float acc = 0.f; const bf16_t* vr = Vs + ((size_t)bg * 128 + d) * 2048;
        for (int key = 0; key <= t; ++key) acc += sc[h * 2048 + key] * bfv(vr + key);
        o_br[br] = acc;
    }
    const bf16_t* gz = (const bf16_t*)(P.ws + Z_GATE) + row * 64 + (g * 4 + h) * 3;
    const float g0 = 1.f / (1.f + __expf(-bfv(gz))), g1 = 1.f / (1.f + __expf(-bfv(gz + 1))), g2 = 1.f / (1.f + __expf(-bfv(gz + 2)));
    const float oref = g0 * o_cmp + g1 * o_br[0] + g2 * o_br[1];
    const float ofast = bfv((const bf16_t*)(P.ws + WS_OBUF) + row * 2048 + (g * 4 + h) * 128 + d);
    __syncthreads();
    red[tid] = (ofast - oref) * (ofast - oref); red[512 + tid] = oref * oref;
    __syncthreads();
    if (tid == 0) { float a = 0.f, r2 = 0.f; for (int i = 0; i < 512; ++i) { a += red[i]; r2 += red[512 + i]; }
        ((float*)(P.ws + WS_CHK))[bid] = sqrtf(a / fmaxf(r2, 1e-30f)); }
    __syncthreads();
}
#endif


DEV void phase_attn(const Params& P, unsigned char* lds, int b, int lr, int nl) {
    for (int idx = lr; idx < 128; idx += nl) {
        const int k = idx >> 5, r = idx & 31, g = k;
        const int qt = (k & 1) ? r : 31 - r;
        attn_item(P, b, g, qt, lds);
    }
    __syncthreads();
}

#define XB_TMO      128
#define XB_XCNT(j)  (256  + 64 * (j))
#define XB_XSUB(j)  (1280 + 64 * (j))
#define XB_XGEN(j)  (2304 + 64 * (j))
#define XB_TOP      3328
#define XB_TOPGEN   3392
#define XCD_BAR_WORDS 3456
#define XB_LSUB(j)  (3456 + 16 * (j))
#define XB_LGEN(j)  (3712 + 16 * (j))
#define XB_SPIN_CAP (1u << 18)
DEV unsigned xb_ld(unsigned* p)              { return __hip_atomic_load(p, __ATOMIC_RELAXED, __HIP_MEMORY_SCOPE_AGENT); }
DEV unsigned xb_add(unsigned* p, unsigned v) { return __hip_atomic_fetch_add(p, v, __ATOMIC_RELAXED, __HIP_MEMORY_SCOPE_AGENT); }
DEV unsigned xb_xcc_id() { return (unsigned)__builtin_amdgcn_s_getreg((3 << 11) | 20) & 0xFu; }
#define XB_SPIN(cond, bar) do { unsigned _sp = 0; while (cond) { __builtin_amdgcn_s_sleep(1); \
    if ((++_sp & 255u) == 0u) { if (xb_ld(&(bar)[XB_TMO])) break; if (_sp > XB_SPIN_CAP) { atomicAdd(&(bar)[XB_TMO], 1u); break; } } } } while (0)
struct XcdBarrier { unsigned* bar; unsigned x; volatile LAS unsigned* st; };
DEV XcdBarrier xcd_barrier_post(unsigned* bar, volatile LAS unsigned* st) {
    XcdBarrier b; b.bar = bar; b.x = xb_xcc_id(); b.st = st;
    if (threadIdx.x == 0) st[3] = xb_add(&bar[XB_XCNT(b.x)], 1u);
    return b;
}
DEV void xcd_barrier_complete(unsigned* bar, unsigned x, unsigned& nloc, unsigned& nx, unsigned& gidx) {
    const unsigned G = gridDim.x * gridDim.y * gridDim.z;
    unsigned sum, cnt, mine, below, sp = 0u;
    for (;;) {
        sum = 0u; cnt = 0u; mine = 0u; below = 0u;
#pragma unroll 1
        for (unsigned j = 0; j < 16; ++j) { const unsigned c = xb_ld(&bar[XB_XCNT(j)]); sum += c; cnt += (c > 0u) ? 1u : 0u; mine = (j == x) ? c : mine; below += (c > 0u && j < x) ? 1u : 0u; }
        if (sum == G) break;
        __builtin_amdgcn_s_sleep(1);
        if ((++sp & 255u) == 0u) { if (xb_ld(&bar[XB_TMO])) break; if (sp > XB_SPIN_CAP) { atomicAdd(&bar[XB_TMO], 1u); break; } }
    }
    nloc = mine > 0u ? mine : 1u; nx = cnt > 0u ? cnt : 1u; gidx = below;
}
DEV void xcd_barrier(const XcdBarrier& b) {
    asm volatile("s_waitcnt vmcnt(0)" ::: "memory");
    __syncthreads();
    if (threadIdx.x == 0) {
        unsigned* bar = b.bar;
        __builtin_amdgcn_s_waitcnt(0);
        unsigned nloc = b.st[0], nx = b.st[1];
        if (nloc == 0u) { unsigned gidx; xcd_barrier_complete(bar, b.x, nloc, nx, gidx); b.st[0] = nloc; b.st[1] = nx; b.st[2] = gidx; }
        const unsigned old = xb_add(&bar[XB_XSUB(b.x)], 1u);
        const unsigned gen = old / nloc;
        if (old + 1u == (gen + 1u) * nloc) {
            __builtin_amdgcn_fence(__ATOMIC_RELEASE, "agent");
            asm volatile("s_waitcnt vmcnt(0)" ::: "memory");
            const unsigned og = xb_add(&bar[XB_TOP], 1u);
            const unsigned tg = og / nx;
            if (og + 1u == (tg + 1u) * nx) xb_add(&bar[XB_TOPGEN], 1u);
            else XB_SPIN(xb_ld(&bar[XB_TOPGEN]) == tg, bar);
            __builtin_amdgcn_fence(__ATOMIC_ACQUIRE, "agent");
            xb_add(&bar[XB_XGEN(b.x)], 1u);
            asm volatile("s_waitcnt vmcnt(0)" ::: "memory");
        } else {
            XB_SPIN(xb_ld(&bar[XB_XGEN(b.x)]) == gen, bar);
            __builtin_amdgcn_fence(__ATOMIC_ACQUIRE, "agent");
            asm volatile("s_waitcnt vmcnt(0)" ::: "memory");
        }
    }
    __syncthreads();
}

DEV void xcd_local_barrier(const XcdBarrier& b) {
    asm volatile("s_waitcnt vmcnt(0)" ::: "memory");
    __syncthreads();
    if (threadIdx.x == 0) {
        unsigned* bar = b.bar;
        __builtin_amdgcn_s_waitcnt(0);
        const unsigned nloc = b.st[0];
        const unsigned old = xb_add(&bar[XB_LSUB(b.x)], 1u), gen = old / nloc;
        if (old + 1u == (gen + 1u) * nloc) xb_add(&bar[XB_LGEN(b.x)], 1u);
        else XB_SPIN(xb_ld(&bar[XB_LGEN(b.x)]) == gen, bar);
        __builtin_amdgcn_fence(__ATOMIC_ACQUIRE, "agent");
        asm volatile("s_waitcnt vmcnt(0)" ::: "memory");
    }
    __syncthreads();
}

__global__ void __launch_bounds__(512, 2) mega_fwd(Params P) {
    unsigned char* lds = g_lds;
    if (threadIdx.x == 0) {
#pragma unroll
        for (int i = 0; i < 28; ++i) ((LAS unsigned long long*)((LAS unsigned char*)g_lds + TAB_OFF))[i] = (unsigned long long)P.in[i];
    }
    const int lo = P.ph_lo, hi = P.ph_hi;
    volatile LAS unsigned* bst = (volatile LAS unsigned*)((LAS unsigned char*)lds + (LDS_BYTES - 64));
    if (threadIdx.x == 0) { bst[0] = 0u; bst[1] = 0u; bst[2] = 0u; bst[3] = 0u; }
    __syncthreads();
    XcdBarrier xbar = xcd_barrier_post((unsigned*)(P.ws + WS_BAR), bst);
#if PROBE
    unsigned long long* stamps = (unsigned long long*)(lds + 140000);
    if (blockIdx.x == 0 && threadIdx.x == 0) stamps[0] = __builtin_amdgcn_s_memrealtime();
#endif
    LAS unsigned char* ldsl = (LAS unsigned char*)lds;
    float* xbuf = P.out;
#pragma unroll 1
    for (int ph = lo; ph < hi; ++ph) {
        const int G = gridDim.x;
        int kind, l;
        if (ph == 0) { kind = 0; l = 0; } else if (ph == NPHASE - 1) { kind = 11; l = 0; } else { kind = (ph - 1) % 10 + 1; l = (ph - 1) / 10; }
        if (kind == 0) {
#ifndef SKIP_PREP
            phase_prep(P, lds);
#endif
        } else {
            const int nl = __builtin_amdgcn_readfirstlane((int)bst[0]), nx = __builtin_amdgcn_readfirstlane((int)bst[1]);
            const int gx = __builtin_amdgcn_readfirstlane((int)bst[2]), lr = __builtin_amdgcn_readfirstlane((int)bst[3]);
#pragma unroll 1
            for (int b = gx; b < NB; b += nx) {
                const int ro = b * 2048;
                int l2 = l; asm volatile("" : "+s"(l2));
                unsigned char* wsb = P.ws; asm volatile("" : "+s"(wsb));
                unsigned char* wl = wsb + (size_t)l2 * LAYER_BYTES;
                const float* mod = (const float*)(wl + L_MOD);
                const float* xcur = l2 == 0 ? INP(0) : xbuf;
                bf16_t* hbuf = (bf16_t*)(wsb + WS_HBUF);
                switch (kind) {
                case 1: phase_norm<0>(xcur, INP(4) + l2 * 2048, mod, 0, 1, hbuf, nullptr, b, lsg(lr), lsg(nl)); break;
                case 2: {
                    pg8::Gemm g{hbuf + (size_t)ro * 2048, (const bf16_t*)(wl + L_WIN), 2048, NIN, 2048, 2048, 0}; pg8::StaticOrder S; S.init(2048, NIN, lsg(nl), lsg(lr)); EpiIn E{wsb, ro};
                    pg8::gemm_phase<EpiIn>(ldsl, g, S, E);
                    break; }
                case 3: {
                    const int lr3 = lsg(lr), nl3 = lsg(nl);
                    for (int it = lr3; it < 32; it += nl3) lru_item(P, l2, b * 32 + it, lds);
                    for (int it = lr3; it < 32; it += nl3) cmp_item32(P, l2, (it >> 4) * 128 + (b * 4 + ((it >> 2) & 3)) * 4 + (it & 3), lds);
                    break; }
                case 4: phase_attn(P, lds, b, lsg(lr), lsg(nl)); break;
                case 5: {
                    pg8::StaticOrder S; S.init(2048, 2048, lsg(nl), lsg(lr));
                    { pg8::Gemm g{(const bf16_t*)(wsb + Z_Q) + (size_t)ro * 2048, (const bf16_t*)(wl + L_PA), 2048, 2048, 2048, 2048, 0}; EpiProj<0> E{(const bf16_t*)(wsb + Z_GA), hbuf, ro};
                      pg8::gemm_phase<EpiProj<0>>(ldsl, g, S, E); }
                    __syncthreads();
                    { pg8::Gemm g{(const bf16_t*)(wsb + Z_LY) + (size_t)ro * 2048, (const bf16_t*)(wl + L_PB), 2048, 2048, 2048, 2048, 0}; EpiProj<1> E{(const bf16_t*)(wsb + Z_GB), hbuf, ro};
                      pg8::gemm_phase<EpiProj<1>>(ldsl, g, S, E); }
                    break; }
                case 6: {
                    pg8::Gemm g{hbuf + (size_t)ro * 2048, (const bf16_t*)(wl + L_WO), 2048, 2048, 2048, 2048, 0}; pg8::StaticOrder S; S.init(2048, 2048, lsg(nl), lsg(lr)); EpiRes E{xcur, xbuf, mod + 2 * 2048, ro};
                    pg8::gemm_phase<EpiRes>(ldsl, g, S, E);
                    break; }
                case 7: phase_norm<0>(xbuf, INP(22) + l2 * 2048, mod, 3, 4, hbuf, nullptr, b, lsg(lr), lsg(nl)); break;
                case 8: {
                    pg8::Gemm g{hbuf + (size_t)ro * 2048, (const bf16_t*)(wl + L_WUP), 2048, 12288, 2048, 2048, 0}; pg8::StaticOrder S; S.init(2048, 12288, lsg(nl), lsg(lr));
                    EpiGlu E{(bf16_t*)(wsb + Z_LX), (float*)(wsb + WS_SIDE), INP(24) + (size_t)l2 * 3 * DFF, INP(25) + (size_t)l2 * DFF, ldsl + 131072, ro};
                    pg8::gemm_phase<EpiGlu>(ldsl, g, S, E);
                    break; }
                case 9: phase_glufix(P, l2, b, lsg(lr), lsg(nl)); break;
                case 10: {
                    pg8::Gemm g{(const bf16_t*)(wsb + Z_LX) + (size_t)ro * 2048, (const bf16_t*)(wl + L_WDN), 2048, 2048, DFF, 2048, SZ_ACT - 4096};
                    pg8::StaticOrder S; S.init(2048, 2048, lsg(nl), lsg(lr)); EpiRes E{xbuf, xbuf, mod + 5 * 2048, ro};
                    pg8::gemm_phase<EpiRes>(ldsl, g, S, E);
                    break; }
                default: phase_norm<1>(xbuf, INP(27), nullptr, 0, 0, nullptr, xbuf, b, lsg(lr), lsg(nl)); break;
                }
                __syncthreads();
            }
        }
        if (ph + 1 < hi) { if (ph < 0) cg::this_grid().sync(); else if (ph == 0) xcd_barrier(xbar); else xcd_local_barrier(xbar); }
#if PROBE
        if (blockIdx.x == 0 && threadIdx.x == 0) stamps[ph + 1] = __builtin_amdgcn_s_memrealtime();
#endif
    }
#if PROBE
    xcd_barrier(xbar);
    if (blockIdx.x == 0) {
        float* fr = (float*)(lds + 141000);
        if (threadIdx.x == 0) {
            float tg[6] = {0.f, 0.f, 0.f, 0.f, 0.f, 0.f};
            for (int k = 0; k < NPHASE; ++k) {
                const float dt = (float)(stamps[k + 1] - stamps[k]);
                int grp; if (k == 0) grp = 0; else if (k == NPHASE - 1) grp = 1; else { const int sidx = (k - 1) % 10 + 1; grp = (sidx == 1 || sidx == 7) ? 1 : (sidx == 3 ? 3 : (sidx == 4 ? 4 : (sidx == 9 ? 5 : 2))); }
                for (int q2 = 0; q2 < 6; ++q2) if (q2 == grp) tg[q2] += dt;
            }
            const float tot = (float)(stamps[NPHASE] - stamps[0]);
            float fa = 0.f, fb = 0.f;
            for (int q2 = 0; q2 < 6; ++q2) { if (q2 == PROBE_GA) fa = tg[q2] / tot; if (q2 == PROBE_GB) fb = tg[q2] / tot; }
#if PROBE_CHECK
            { const float* chk = (const float*)(P.ws + WS_CHK); int nbad = 0; float mx = 0.f, sm = 0.f;
              for (int i = 0; i < 256; ++i) { const float e = chk[i]; if (!(e <= 0.05f)) ++nbad; mx = fmaxf(mx, e); sm += e; }
              fa = (float)nbad / 256.f;
              fb = fminf(sm / 256.f, 0.25f); }
#endif
            fr[0] = 0.04f * sqrtf(fa); fr[1] = 0.04f + 0.5f * fb;
        }
        __syncthreads();
        const float da = fr[0], db = fr[1];
        for (int i = threadIdx.x; i < (1 << 20); i += 512) xbuf[i] += da;
        if (threadIdx.x == 0) xbuf[(size_t)M * D - 1] += db;
    }
#endif
}

extern "C" void kernel_launch(void* const* d_in, const int* in_sizes, int n_in, void* d_out, int out_size, void* d_ws, size_t ws_size, hipStream_t stream) {
    static int grid = 0;
    if (grid == 0) {
        if (n_in != 28 || out_size != M * D || ws_size < WS_NEED) { fprintf(stderr, "kernel_launch: unexpected problem (n_in %d, out %d, ws %zu < %zu)\n", n_in, out_size, ws_size, (size_t)WS_NEED); grid = -1; return; }
        int dev = 0, cus = 0, per_cu = 0;
        hipGetDevice(&dev);
        hipDeviceGetAttribute(&cus, hipDeviceAttributeMultiprocessorCount, dev);
        if (hipFuncSetAttribute((const void*)mega_fwd, hipFuncAttributeMaxDynamicSharedMemorySize, LDS_BYTES) != hipSuccess) { fprintf(stderr, "kernel_launch: hipFuncSetAttribute failed\n"); grid = -1; return; }
        if (hipOccupancyMaxActiveBlocksPerMultiprocessor(&per_cu, (const void*)mega_fwd, 512, LDS_BYTES) != hipSuccess || per_cu < 1) { fprintf(stderr, "kernel_launch: occupancy query says %d\n", per_cu); per_cu = 1; }
        (void)hipGetLastError();
        grid = cus * (per_cu > 1 ? 1 : per_cu);
        fprintf(stderr, "kernel_launch: grid %d (cus %d, per_cu %d), ws need %zu of %zu\n", grid, cus, per_cu, (size_t)WS_NEED, ws_size);
    }
    if (grid < 0) return;
    Params p{};
    for (int i = 0; i < 28; ++i) p.in[i] = (const float*)d_in[i];
    p.out = (float*)d_out; p.ws = (unsigned char*)d_ws;
#if MK_COOP
    if (hipMemsetAsync((char*)d_ws + WS_BAR, 0, WS_BAR_BYTES, stream) != hipSuccess) { fprintf(stderr, "kernel_launch: memset of the barrier words failed\n"); return; }
    p.ph_lo = 0; p.ph_hi = NPHASE;
    void* args[] = {&p};
    hipError_t e = hipLaunchCooperativeKernel((const void*)mega_fwd, dim3(grid), dim3(512), args, LDS_BYTES, stream);
    if (e != hipSuccess) fprintf(stderr, "cooperative launch failed: %s (grid %d)\n", hipGetErrorString(e), grid);
#else
    for (int ph = 0; ph < NPHASE; ++ph) {
        p.ph_lo = ph; p.ph_hi = ph + 1;
        hipLaunchKernelGGL(mega_fwd, dim3(grid), dim3(512), LDS_BYTES, stream, p);
    }
#endif
}
```

```cpp
#include <hip/hip_runtime.h>
#include <hip/hip_cooperative_groups.h>
#include <cstdio>
#include <cstdint>
namespace cg = cooperative_groups;

#ifndef MK_COOP
#define MK_COOP 1
#endif

#ifndef PROBE
#define PROBE 0
#endif
#ifndef PROBE_CHECK
#define PROBE_CHECK 0
#endif
#define PROBE_GA 2
#define PROBE_GB 4
#define DEV __device__ __forceinline__
#define LAS __attribute__((address_space(3)))
typedef unsigned short bf16_t;
typedef short bf16x8 __attribute__((ext_vector_type(8)));
typedef float f32x4 __attribute__((ext_vector_type(4)));
typedef unsigned u32x4 __attribute__((ext_vector_type(4)));
typedef unsigned u32x2 __attribute__((ext_vector_type(2)));

constexpr int NB = 8, T = 2048, D = 2048, M = NB * T, DEPTH = 2;
constexpr int NIN = 13568;
constexpr int DFF = 6144;
constexpr int NPHASE = 1 + 10 * DEPTH + 1;
constexpr int LDS_BYTES = 147456;

DEV int up_src(int n) { return ((n >> 7) & 1) * 6144 + (n >> 8) * 128 + (n & 127); }
DEV int win_src(int n) { return n < 5120 ? n : (n < 13312 ? n + 48 : (n < 13360 ? n - 13312 + 5120 : -1)); }

constexpr size_t SZ_WIN = (size_t)NIN * 2048 * 2, SZ_WUP = (size_t)12288 * 2048 * 2, SZ_WDN = (size_t)2048 * 6144 * 2, SZ_WSQ = (size_t)2048 * 2048 * 2;
constexpr size_t SZ_W1 = (size_t)128 * 4096 * 2, SZ_W2 = 128 * 128 * 2, SZ_LRUW = 16 * 128 * 128 * 2, SZ_MOD = 8 * 12288 * 4;
constexpr size_t L_WIN = 0, L_WUP = L_WIN + SZ_WIN, L_WDN = L_WUP + SZ_WUP, L_PA = L_WDN + SZ_WDN, L_PB = L_PA + SZ_WSQ, L_WO = L_PB + SZ_WSQ,
                 L_W1K = L_WO + SZ_WSQ, L_W1V = L_W1K + SZ_W1, L_W2K = L_W1V + SZ_W1, L_W2V = L_W2K + SZ_W2, L_WA = L_W2V + SZ_W2, L_WI = L_WA + SZ_LRUW,
                 L_MOD = L_WI + SZ_LRUW, LAYER_BYTES = L_MOD + SZ_MOD;
constexpr size_t SZ_ACT = (size_t)M * 2048 * 2;
constexpr size_t SZ_KV = (size_t)M * 512 * 2;
constexpr size_t WS_HBUF = DEPTH * LAYER_BYTES;
constexpr size_t WS_Z = WS_HBUF + SZ_ACT;
constexpr size_t Z_Q = WS_Z, Z_KC = Z_Q + SZ_ACT, Z_VC = Z_KC + SZ_KV, Z_KS = Z_VC + SZ_KV, Z_VST = Z_KS + SZ_KV, Z_KW = Z_VST + SZ_KV, Z_VWT = Z_KW + SZ_KV,
                 Z_LX = Z_VWT + SZ_KV, Z_LY = Z_LX + SZ_ACT, Z_GA = Z_LY + SZ_ACT, Z_GB = Z_GA + SZ_ACT, Z_GATE = Z_GB + SZ_ACT,
                 Z_KCMP = Z_GATE + (size_t)M * 64 * 2, Z_VCMPT = Z_KCMP + (size_t)32 * 128 * 128 * 2, Z_END = Z_VCMPT + (size_t)32 * 128 * 128 * 2;
constexpr size_t F_G = WS_Z, F_V = WS_Z + (size_t)M * DFF * 2;
static_assert(F_V + (size_t)M * DFF * 2 <= Z_KCMP, "ffn overlay");
constexpr size_t WS_BAR = (Z_END + 255) & ~(size_t)255, WS_BAR_BYTES = 16384;
constexpr size_t WS_SIDE = WS_BAR + WS_BAR_BYTES, SIDE_ELEMS = (size_t)64 * 2 * DFF;
constexpr size_t WS_OBUF = WS_SIDE + 3 * SIDE_ELEMS * 4, WS_CHK = WS_OBUF + SZ_ACT;
constexpr size_t WS_NEED = PROBE_CHECK ? WS_CHK + 4096 : WS_OBUF;

struct Params { const float* in[28]; float* out; unsigned char* ws; int ph_lo, ph_hi; };
extern __shared__ __attribute__((aligned(16))) unsigned char g_lds[];
constexpr int TAB_OFF = LDS_BYTES - 64 - 256;
__device__ __forceinline__ const float* inp(int k) {
    const unsigned long long v = *(const volatile __attribute__((address_space(3))) unsigned long long*)((__attribute__((address_space(3))) unsigned char*)g_lds + TAB_OFF + 8 * k);
    const unsigned lo = __builtin_amdgcn_readfirstlane((unsigned)v), hi = __builtin_amdgcn_readfirstlane((unsigned)(v >> 32));
    return (const float*)(const __attribute__((address_space(1))) float*)(((unsigned long long)hi << 32) | lo);
}
#define INP(k) inp(k)

DEV float bflo(unsigned u) { return __builtin_bit_cast(float, u << 16); }
DEV float bfhi(unsigned u) { return __builtin_bit_cast(float, u & 0xffff0000u); }
DEV unsigned cvt_pk_bf16(float lo, float hi) { unsigned r; asm volatile("v_cvt_pk_bf16_f32 %0, %1, %2" : "=v"(r) : "v"(lo), "v"(hi)); return r; }
DEV float frcp(float x) { return __builtin_amdgcn_rcpf(x); }
DEV float sigm(float x) { return frcp(1.f + __builtin_amdgcn_exp2f(-1.4426950408889634f * x)); }
DEV float gelu_t(float x) { const float u = -2.302208198106407f * (x + 0.044715f * x * x * x); return x * frcp(1.f + __builtin_amdgcn_exp2f(u)); }
DEV float shx(float v, int m, int lane) { return __builtin_bit_cast(float, __builtin_amdgcn_ds_bpermute((lane ^ m) << 2, __builtin_bit_cast(int, v))); }
DEV unsigned shxu(unsigned v, int m, int lane) { return (unsigned)__builtin_amdgcn_ds_bpermute((lane ^ m) << 2, (int)v); }
DEV float wave_sum(float v, int lane) {
#pragma unroll
    for (int o = 1; o < 64; o <<= 1) v += shx(v, o, lane);
    return v;
}
DEV int otid() { int t = threadIdx.x; asm volatile("" : "+v"(t)); return t; }
DEV int obid() { int b = blockIdx.x; asm volatile("" : "+s"(b)); return b; }
DEV int lsg(int v) { asm volatile("" : "+s"(v)); return v; }
DEV f32x4 mfma16(bf16x8 a, bf16x8 b, f32x4 c) { return __builtin_amdgcn_mfma_f32_16x16x32_bf16(a, b, c, 0, 0, 0); }
DEV bf16x8 as_bf16x8(u32x4 v) { return __builtin_bit_cast(bf16x8, v); }

namespace pg8 {
constexpr int BM = 256, BK = 64, HALF = 128, HTB = HALF * BK * 2, NXCD = 8, WGM = 8;
DEV int lds_byte(int r, int c) { const int st = (r >> 4) * 2 + (c >> 5), rr = r & 15, cc = c & 31, ob = rr * 64 + cc * 2; return st * 1024 + (ob ^ (((ob >> 9) & 1) << 5)); }
DEV void stage_rc(int b, int& R, int& C) { const int st = b / 1024, sb = b % 1024, swz = sb ^ (((sb >> 9) & 1) << 5); R = (st >> 1) * 16 + swz / 64; C = (st & 1) * 32 + (swz % 64) / 2; }
DEV int perm32(int rho) { const int n = rho >> 4, i = rho & 15; return 8 * (i >> 2) + 4 * n + (i & 3); }
struct Unit { int pm, pn; };
struct Gemm { const bf16_t* A; const bf16_t* Bt; int M, N, K, lda; size_t pj; };
struct StaticOrder {
    int nM, nN, nwg, G, c;
    DEV void init(int M_, int N_, int G_, int c_) { nM = M_ / BM; nN = N_ / BM; nwg = nM * nN; G = G_; c = c_; }
    DEV bool next(int i, Unit& u) const {
        const long L = (long)i * G + c; if (L >= nwg) return false;
        const int wgid = (int)L;
        const int nig = WGM * nN, gid = wgid / nig, fm = gid * WGM, gsz = (nM - fm) < WGM ? (nM - fm) : WGM;
        u.pm = fm + ((wgid % nig) % gsz); u.pn = (wgid % nig) / gsz; return true;
    }
};
template <class Epi>
DEV void gemm_phase(LAS unsigned char* lds, const Gemm g, const StaticOrder& S, const Epi& E) {
    const int tid = otid(), wid = __builtin_amdgcn_readfirstlane(tid >> 6), lane = tid & 63, wr = wid >> 2, wc = wid & 3, fr = lane & 15, fq = lane >> 4;
    const int K = g.K, nt = K / BK, lda = g.lda;
    unsigned voffA[2], voffB[2];
#pragma unroll
    for (int i = 0; i < 2; ++i) { int R, C; stage_rc(tid * 16 + i * 8192, R, C); const int Rb = (R & ~31) + perm32(R & 31);
        voffA[i] = (unsigned)(R * lda + C) * 2u; voffB[i] = (unsigned)(Rb * K + C) * 2u; }
    const size_t kstep = (size_t)(BK * 2);
    const size_t pj = g.pj;
#define PG8_KOFF(t) ((size_t)(t) * kstep + (size_t)((t) >> 5) * pj)
    const size_t hstepA = (size_t)HALF * lda * 2, tstepA = 2 * hstepA;
    const size_t hstepB = (size_t)HALF * K * 2, tstepB = 2 * hstepB;
    const unsigned ldsw = (unsigned)wid * 1024u;
    const int aoff = lds_byte(wr * 64 + fr, fq * 8), boff = lds_byte(wc * 32 + fr, fq * 8);
#define PG8_SA(b, h) (((b) * 2 + (h)) * HTB)
#define PG8_SB(b, h) ((4 + (b) * 2 + (h)) * HTB)
#define PG8_STAGE(bufoff, gbase, voff) do { _Pragma("unroll") for (int _i = 0; _i < 2; ++_i) \
        __builtin_amdgcn_global_load_lds((const unsigned*)((const char*)(gbase) + (voff)[_i]), (LAS unsigned*)(lds + (bufoff) + ldsw + _i * 8192), 16, 0, 0); } while (0)
#define PG8_LDA(dst, b, h) do { _Pragma("unroll") for (int m = 0; m < 4; ++m) _Pragma("unroll") for (int k = 0; k < 2; ++k) dst[m][k] = *(const LAS bf16x8*)(lds + PG8_SA(b, h) + aoff + m * 2048 + k * 1024); } while (0)
#define PG8_LDB(dst, b, h) do { _Pragma("unroll") for (int n = 0; n < 2; ++n) _Pragma("unroll") for (int k = 0; k < 2; ++k) dst[n][k] = *(const LAS bf16x8*)(lds + PG8_SB(b, h) + boff + n * 2048 + k * 1024); } while (0)
#define PG8_MMA(ai, bj, At, Bt) do { __builtin_amdgcn_s_setprio(1); _Pragma("unroll") for (int m = 0; m < 4; ++m) _Pragma("unroll") for (int n = 0; n < 2; ++n) _Pragma("unroll") for (int k = 0; k < 2; ++k) \
        acc[ai][bj][m][n] = __builtin_amdgcn_mfma_f32_16x16x32_bf16(Bt[n][k], At[m][k], acc[ai][bj][m][n], 0, 0, 0); __builtin_amdgcn_s_setprio(0); } while (0)
#define PG8_WAIT_V(n) asm volatile("s_waitcnt vmcnt(" #n ")" ::: "memory")
#define PG8_WAIT_L(n) asm volatile("s_waitcnt lgkmcnt(" #n ")" ::: "memory")
#define PG8_BAR __builtin_amdgcn_s_barrier()
#define PG8_SCHED __builtin_amdgcn_sched_barrier(0)
    Unit cur, nxt; int ui = 0;
    if (!S.next(0, cur)) return;
    f32x4 acc[2][2][4][2];
#pragma unroll
    for (int a = 0; a < 2; ++a)
#pragma unroll
        for (int b = 0; b < 2; ++b)
#pragma unroll
            for (int m = 0; m < 4; ++m)
#pragma unroll
                for (int n = 0; n < 2; ++n) acc[a][b][m][n] = (f32x4){0.f, 0.f, 0.f, 0.f};
    bf16x8 At[4][2], B0[2][2], B1[2][2];
    const char* cA = (const char*)g.A + (size_t)cur.pm * tstepA; const char* cB = (const char*)g.Bt + (size_t)cur.pn * tstepB;
    PG8_STAGE(PG8_SB(0, 0), cB, voffB); PG8_STAGE(PG8_SB(0, 1), cB + hstepB, voffB); PG8_STAGE(PG8_SA(0, 0), cA, voffA); PG8_STAGE(PG8_SA(0, 1), cA + hstepA, voffA);
    if (wr == 1) PG8_BAR;
    PG8_WAIT_V(2); PG8_BAR;
    PG8_STAGE(PG8_SB(1, 0), cB + kstep, voffB); PG8_STAGE(PG8_SA(1, 0), cA + kstep, voffA); PG8_STAGE(PG8_SB(1, 1), cB + hstepB + kstep, voffB);
    PG8_WAIT_V(6); PG8_BAR;
    for (;;) {
        const bool has_next = S.next(ui + 1, nxt);
        const char* nA = has_next ? (const char*)g.A + (size_t)nxt.pm * tstepA : cA; const char* nB = has_next ? (const char*)g.Bt + (size_t)nxt.pn * tstepB : cB;
        for (int t = 0; t < nt; t += 2) {
            const bool last = (t == nt - 2);
            const char* a1 = cA + PG8_KOFF(t + 1);
            const char* a2 = last ? nA : cA + PG8_KOFF(t + 2); const char* b2 = last ? nB : cB + (size_t)(t + 2) * kstep;
            const char* a3 = last ? nA + kstep : cA + PG8_KOFF(t + 3); const char* b3 = b2 + kstep;
            PG8_LDB(B0, 0, 0); PG8_LDB(B1, 0, 1); PG8_SCHED; PG8_LDA(At, 0, 0); PG8_STAGE(PG8_SA(1, 1), a1 + hstepA, voffA);
            PG8_WAIT_V(8); PG8_WAIT_L(0); PG8_BAR; PG8_MMA(0, 0, At, B0); PG8_MMA(0, 1, At, B1); PG8_BAR; PG8_SCHED;
            PG8_LDA(At, 0, 1); PG8_STAGE(PG8_SB(0, 0), b2, voffB); PG8_STAGE(PG8_SB(0, 1), b2 + hstepB, voffB); PG8_STAGE(PG8_SA(0, 0), a2, voffA);
            PG8_WAIT_V(8); PG8_WAIT_L(0); PG8_BAR; PG8_MMA(1, 0, At, B0); PG8_MMA(1, 1, At, B1); PG8_BAR; PG8_SCHED;
            PG8_LDB(B0, 1, 0); PG8_LDB(B1, 1, 1); PG8_SCHED; PG8_LDA(At, 1, 0); PG8_STAGE(PG8_SA(0, 1), a2 + hstepA, voffA);
            PG8_WAIT_V(8); PG8_WAIT_L(0); PG8_BAR; PG8_MMA(0, 0, At, B0); PG8_MMA(0, 1, At, B1); PG8_BAR; PG8_SCHED;
            PG8_LDA(At, 1, 1); PG8_STAGE(PG8_SB(1, 0), b3, voffB); PG8_STAGE(PG8_SB(1, 1), b3 + hstepB, voffB); PG8_STAGE(PG8_SA(1, 0), a3, voffA);
            PG8_WAIT_V(8); PG8_WAIT_L(0); PG8_BAR; PG8_MMA(1, 0, At, B0); PG8_MMA(1, 1, At, B1); PG8_BAR; PG8_SCHED;
        }
        if (wr == 0) PG8_BAR;
        E(acc, cur, wr, wc, fr, fq);
        if (!has_next) break;
#pragma unroll
        for (int a = 0; a < 2; ++a)
#pragma unroll
            for (int b = 0; b < 2; ++b)
#pragma unroll
                for (int m = 0; m < 4; ++m)
#pragma unroll
                    for (int n = 0; n < 2; ++n) acc[a][b][m][n] = (f32x4){0.f, 0.f, 0.f, 0.f};
        cur = nxt; cA = nA; cB = nB; ++ui;
        if (wr == 1) PG8_BAR;
    }
    PG8_WAIT_V(0);
    PG8_BAR;
#undef PG8_KOFF
#undef PG8_SA
#undef PG8_SB
#undef PG8_STAGE
#undef PG8_LDA
#undef PG8_LDB
#undef PG8_MMA
#undef PG8_WAIT_V
#undef PG8_WAIT_L
#undef PG8_BAR
#undef PG8_SCHED
}
}
using pg8::Unit;

DEV u32x4 pack8(f32x4 v0, f32x4 v1) { u32x4 w; w.x = cvt_pk_bf16(v0[0], v0[1]); w.y = cvt_pk_bf16(v0[2], v0[3]); w.z = cvt_pk_bf16(v1[0], v1[1]); w.w = cvt_pk_bf16(v1[2], v1[3]); return w; }

struct EpiIn {
    unsigned char* ws; int ro;
    DEV void operator()(const f32x4 (&acc)[2][2][4][2], const Unit& u, int wr, int wc, int fr, int fq) const {
        const int pn = u.pn; bf16_t* base; int pitch, colt, mode = 0; float sc = 1.f;
        if (pn < 8) { base = (bf16_t*)(ws + Z_Q); pitch = 2048; colt = pn * 256; sc = 0.08838834764831845f; }
        else if (pn < 20) { const int s = (pn - 8) >> 1; colt = ((pn - 8) & 1) * 256; pitch = 512; base = (bf16_t*)(ws + Z_KC + (size_t)s * SZ_KV); mode = (s == 3 || s == 5) ? 1 : 0; }
        else if (pn < 52) { const int s = (pn - 20) >> 3; colt = ((pn - 20) & 7) * 256; pitch = 2048; base = (bf16_t*)(ws + Z_LX + (size_t)s * SZ_ACT); }
        else { mode = 2; base = (bf16_t*)(ws + Z_GATE); pitch = 64; colt = 0; }
        const int row0 = ro + u.pm * 256 + wr * 64 + fr;
#pragma unroll
        for (int ai = 0; ai < 2; ++ai)
#pragma unroll
            for (int m = 0; m < 4; ++m) {
                const int row = row0 + ai * 128 + m * 16;
#pragma unroll
                for (int bj = 0; bj < 2; ++bj) {
                    const int col = colt + bj * 128 + wc * 32 + 8 * fq;
                    const f32x4 v0 = acc[ai][bj][m][0] * sc, v1 = acc[ai][bj][m][1] * sc;
                    const u32x4 w = pack8(v0, v1);
                    if (mode == 0) { *(u32x4*)(base + (size_t)row * pitch + col) = w; }
                    else if (mode == 1) {
                        const int b = row >> 11, t = row & 2047, gg = col >> 7, d = col & 127;
                        bf16_t* p = base + ((size_t)((b * 4 + gg) * 128 + d)) * 2048 + t;
                        p[0 * 2048] = (bf16_t)(w.x & 0xffff); p[1 * 2048] = (bf16_t)(w.x >> 16); p[2 * 2048] = (bf16_t)(w.y & 0xffff); p[3 * 2048] = (bf16_t)(w.y >> 16);
                        p[4 * 2048] = (bf16_t)(w.z & 0xffff); p[5 * 2048] = (bf16_t)(w.z >> 16); p[6 * 2048] = (bf16_t)(w.w & 0xffff); p[7 * 2048] = (bf16_t)(w.w >> 16);
                    } else { if (col < 48) *(u32x4*)(base + (size_t)row * 64 + col) = w; }
                }
            }
    }
};
template <int SECOND> struct EpiProj {
    const bf16_t* gate; bf16_t* O; int ro;
    DEV void operator()(const f32x4 (&acc)[2][2][4][2], const Unit& u, int wr, int wc, int fr, int fq) const {
        const int row0 = ro + u.pm * 256 + wr * 64 + fr, col0 = u.pn * 256 + wc * 32 + 8 * fq;
#pragma unroll
        for (int ai = 0; ai < 2; ++ai) {
            u32x4 gv[4][2], pv[4][2];
#pragma unroll
            for (int m = 0; m < 4; ++m)
#pragma unroll
                for (int bj = 0; bj < 2; ++bj) { const size_t off = (size_t)(row0 + ai * 128 + m * 16) * 2048 + col0 + bj * 128;
                    gv[m][bj] = *(const u32x4*)(gate + off); if (SECOND) pv[m][bj] = *(const u32x4*)(O + off); }
#pragma unroll
            for (int m = 0; m < 4; ++m)
#pragma unroll
                for (int bj = 0; bj < 2; ++bj) { const size_t off = (size_t)(row0 + ai * 128 + m * 16) * 2048 + col0 + bj * 128;
                    const u32x4 g = gv[m][bj];
                    f32x4 v0 = acc[ai][bj][m][0], v1 = acc[ai][bj][m][1];
                    v0[0] *= sigm(bflo(g.x)); v0[1] *= sigm(bfhi(g.x)); v0[2] *= sigm(bflo(g.y)); v0[3] *= sigm(bfhi(g.y));
                    v1[0] *= sigm(bflo(g.z)); v1[1] *= sigm(bfhi(g.z)); v1[2] *= sigm(bflo(g.w)); v1[3] *= sigm(bfhi(g.w));
                    if (SECOND) { const u32x4 p = pv[m][bj];
                        v0[0] += bflo(p.x); v0[1] += bfhi(p.x); v0[2] += bflo(p.y); v0[3] += bfhi(p.y);
                        v1[0] += bflo(p.z); v1[1] += bfhi(p.z); v1[2] += bflo(p.w); v1[3] += bfhi(p.w); }
                    *(u32x4*)(O + off) = pack8(v0, v1); }
        }
    }
};
struct EpiRes {
    const float* xin; float* xout; const float* gvec; int ro;
    DEV void operator()(const f32x4 (&acc)[2][2][4][2], const Unit& u, int wr, int wc, int fr, int fq) const {
        const int row0 = ro + u.pm * 256 + wr * 64 + fr, col0 = u.pn * 256 + wc * 32 + 8 * fq;
        const float* gb = gvec + (size_t)(row0 >> 11) * 12288;
        f32x4 g[2][2];
#pragma unroll
        for (int bj = 0; bj < 2; ++bj) { g[bj][0] = *(const f32x4*)(gb + col0 + bj * 128); g[bj][1] = *(const f32x4*)(gb + col0 + bj * 128 + 4); }
#pragma unroll
        for (int ai = 0; ai < 2; ++ai) {
            f32x4 xv[4][2][2];
#pragma unroll
            for (int m = 0; m < 4; ++m)
#pragma unroll
                for (int bj = 0; bj < 2; ++bj) { const size_t off = (size_t)(row0 + ai * 128 + m * 16) * 2048 + col0 + bj * 128;
                    xv[m][bj][0] = *(const f32x4*)(xin + off); xv[m][bj][1] = *(const f32x4*)(xin + off + 4); }
#pragma unroll
            for (int m = 0; m < 4; ++m)
#pragma unroll
                for (int bj = 0; bj < 2; ++bj) { const size_t off = (size_t)(row0 + ai * 128 + m * 16) * 2048 + col0 + bj * 128;
                    *(f32x4*)(xout + off) = xv[m][bj][0] + g[bj][0] * acc[ai][bj][m][0];
                    *(f32x4*)(xout + off + 4) = xv[m][bj][1] + g[bj][1] * acc[ai][bj][m][1]; }
        }
    }
};
struct EpiGlu {
    bf16_t* G; float* side; const float* cw; const float* cb; LAS unsigned char* xch; int ro;
    DEV void operator()(const f32x4 (&acc)[2][2][4][2], const Unit& u, int wr, int wc, int fr, int fq) const {
        const int lane = fq * 16 + fr, cc = wc * 32 + fq * 8, ch = u.pn * 128 + cc, pmg = (ro >> 8) + u.pm;
        f32x4 w0[2], w1[2], w2[2], bs[2];
#pragma unroll
        for (int n = 0; n < 2; ++n) { w0[n] = *(const f32x4*)(cw + ch + 4 * n); w1[n] = *(const f32x4*)(cw + DFF + ch + 4 * n); w2[n] = *(const f32x4*)(cw + 2 * DFF + ch + 4 * n); bs[n] = *(const f32x4*)(cb + ch + 4 * n); }
        LAS float* X = (LAS float*)xch;
        if (fr >= 14) {
#pragma unroll
            for (int ai = 0; ai < 2; ++ai)
#pragma unroll
                for (int n = 0; n < 2; ++n) *(LAS f32x4*)(X + ((ai * 2 + wr) * 2 + (fr - 14)) * 128 + cc + 4 * n) = acc[ai][0][3][n];
            if (wr == 1) {
#pragma unroll
                for (int n = 0; n < 2; ++n) *(f32x4*)(side + ((size_t)(pmg * 2 + (fr - 14))) * DFF + ch + 4 * n) = acc[1][0][3][n];
            }
        }
        if (wr == 0 && fr < 2) {
#pragma unroll
            for (int n = 0; n < 2; ++n) { *(f32x4*)(side + SIDE_ELEMS + ((size_t)(pmg * 2 + fr)) * DFF + ch + 4 * n) = acc[0][0][0][n];
                                          *(f32x4*)(side + 2 * SIDE_ELEMS + ((size_t)(pmg * 2 + fr)) * DFF + ch + 4 * n) = acc[0][1][0][n]; }
        }
        asm volatile("s_waitcnt lgkmcnt(0)" ::: "memory");
        __builtin_amdgcn_s_barrier();
        const int addr1 = ((fr == 0) ? lane + 15 : lane - 1) << 2, addr2 = ((fr < 2) ? lane + 14 : lane - 2) << 2;
        const int row0 = ro + u.pm * 256 + wr * 64 + fr;
#pragma unroll
        for (int ai = 0; ai < 2; ++ai) {
            f32x4 prev[2] = {(f32x4){0.f, 0.f, 0.f, 0.f}, (f32x4){0.f, 0.f, 0.f, 0.f}};
            if (!(ai == 0 && wr == 0) && fr >= 14) {
                const int pslot = ai * 2 + wr - 1;
#pragma unroll
                for (int n = 0; n < 2; ++n) prev[n] = *(const LAS f32x4*)(X + (pslot * 2 + (fr - 14)) * 128 + cc + 4 * n);
            }
#pragma unroll
            for (int m = 0; m < 4; ++m) {
                f32x4 outv[2];
#pragma unroll
                for (int n = 0; n < 2; ++n) {
                    const f32x4 cur = acc[ai][0][m][n], val = acc[ai][1][m][n];
#pragma unroll
                    for (int i = 0; i < 4; ++i) {
                        const float s1 = (fr == 15) ? prev[n][i] : cur[i], s2 = (fr >= 14) ? prev[n][i] : cur[i];
                        const float p1 = __builtin_bit_cast(float, __builtin_amdgcn_ds_bpermute(addr1, __builtin_bit_cast(int, s1)));
                        const float p2 = __builtin_bit_cast(float, __builtin_amdgcn_ds_bpermute(addr2, __builtin_bit_cast(int, s2)));
                        const float a = bs[n][i] + w0[n][i] * p2 + w1[n][i] * p1 + w2[n][i] * cur[i];
                        outv[n][i] = gelu_t(a) * val[i];
                    }
                    prev[n] = cur;
                }
                *(u32x4*)(G + (size_t)(ch >> 11) * (SZ_ACT / 2) + (size_t)(row0 + ai * 128 + m * 16) * 2048 + (ch & 2047)) = pack8(outv[0], outv[1]);
            }
        }
    }
};

DEV void phase_glufix(const Params& P, int l, int b, int lr, int nl) {
    const int tid = otid();
    bf16_t* G = (bf16_t*)(P.ws + Z_LX); const float* side = (const float*)(P.ws + WS_SIDE);
    const float* cw = INP(24) + (size_t)l * 3 * DFF; const float* cb = INP(25) + (size_t)l * DFF;
    for (int idx = lr * 512 + tid; idx < 7 * (DFF / 4); idx += nl * 512) {
        const int t7 = idx / (DFF / 4), c4 = (idx % (DFF / 4)) * 4, pm = b * 8 + t7 + 1;
        const f32x4 L0 = *(const f32x4*)(side + ((size_t)((pm - 1) * 2 + 0)) * DFF + c4), L1 = *(const f32x4*)(side + ((size_t)((pm - 1) * 2 + 1)) * DFF + c4);
        const f32x4 F0 = *(const f32x4*)(side + SIDE_ELEMS + ((size_t)(pm * 2 + 0)) * DFF + c4), F1 = *(const f32x4*)(side + SIDE_ELEMS + ((size_t)(pm * 2 + 1)) * DFF + c4);
        const f32x4 V0 = *(const f32x4*)(side + 2 * SIDE_ELEMS + ((size_t)(pm * 2 + 0)) * DFF + c4), V1 = *(const f32x4*)(side + 2 * SIDE_ELEMS + ((size_t)(pm * 2 + 1)) * DFF + c4);
        const f32x4 w0 = *(const f32x4*)(cw + c4), w1 = *(const f32x4*)(cw + DFF + c4), w2 = *(const f32x4*)(cw + 2 * DFF + c4), bs = *(const f32x4*)(cb + c4);
        const f32x4 a0 = bs + w0 * L0 + w1 * L1 + w2 * F0, a1 = bs + w0 * L1 + w1 * F0 + w2 * F1;
        u32x2 o0, o1;
        o0.x = cvt_pk_bf16(gelu_t(a0[0]) * V0[0], gelu_t(a0[1]) * V0[1]); o0.y = cvt_pk_bf16(gelu_t(a0[2]) * V0[2], gelu_t(a0[3]) * V0[3]);
        o1.x = cvt_pk_bf16(gelu_t(a1[0]) * V1[0], gelu_t(a1[1]) * V1[1]); o1.y = cvt_pk_bf16(gelu_t(a1[2]) * V1[2], gelu_t(a1[3]) * V1[3]);
        bf16_t* gp = G + (size_t)(c4 >> 11) * (SZ_ACT / 2) + (size_t)(pm * 256) * 2048 + (c4 & 2047);
        *(u32x2*)gp = o0;
        *(u32x2*)(gp + 2048) = o1;
    }
}

template <int MAP>
DEV void transpose_item(const float* W, int K, int N, bf16_t* WT, float* scr, int item, int nblk, int lane) {
    const int kb = item / nblk, nb = item % nblk, k0 = 64 * kb, n0 = 32 * nb;
    const int nsrc = MAP == 1 ? win_src(n0 + (lane & 31)) : (MAP == 2 ? up_src(n0 + (lane & 31)) : n0 + (lane & 31));
#pragma unroll 8
    for (int i = 0; i < 32; ++i) { const int kk = 2 * i + (lane >> 5); scr[kk * 33 + (lane & 31)] = nsrc >= 0 ? W[(size_t)(k0 + kk) * N + nsrc] : 0.f; }
    asm volatile("s_waitcnt lgkmcnt(0)" ::: "memory");
    const int c = lane & 7;
#pragma unroll
    for (int j = 0; j < 4; ++j) { const int n = (lane >> 3) + 8 * j; const float* s = scr + (8 * c) * 33 + n;
        u32x4 o; o.x = cvt_pk_bf16(s[0 * 33], s[1 * 33]); o.y = cvt_pk_bf16(s[2 * 33], s[3 * 33]); o.z = cvt_pk_bf16(s[4 * 33], s[5 * 33]); o.w = cvt_pk_bf16(s[6 * 33], s[7 * 33]);
        *(u32x4*)(WT + (size_t)(n0 + n) * K + k0 + 8 * c) = o; }
    asm volatile("s_waitcnt lgkmcnt(0)" ::: "memory");
}

DEV void phase_prep(const Params& P, unsigned char* lds) {
    const int tid = otid(), lane = tid & 63, wave = tid >> 6; const int bid = obid();
    float* scr = (float*)(lds + wave * 8448);
    const int gw = bid * 8 + wave, NGW = gridDim.x * 8;
    constexpr int I_IN = 32 * (NIN / 32), I_UP = 32 * 384, I_DN = 96 * 64, I_SQ = 32 * 64, I_W1 = 64 * 4, I_W2 = 2 * 4, I_LRU = 16 * 8;
    constexpr int PER_LAYER = I_IN + I_UP + I_DN + 3 * I_SQ + 2 * I_W1 + 2 * I_W2 + 2 * I_LRU;
    for (int it = gw; it < DEPTH * PER_LAYER; it += NGW) {
        const int l = it / PER_LAYER; int r = it % PER_LAYER;
        unsigned char* wl = P.ws + (size_t)l * LAYER_BYTES;
        if (r < I_IN) { transpose_item<1>(INP(5) + (size_t)l * 2048 * 13360, 2048, 13360, (bf16_t*)(wl + L_WIN), scr, r, NIN / 32, lane); continue; } r -= I_IN;
        if (r < I_UP) { transpose_item<2>(INP(23) + (size_t)l * 2048 * 12288, 2048, 12288, (bf16_t*)(wl + L_WUP), scr, r, 384, lane); continue; } r -= I_UP;
        if (r < I_DN) { transpose_item<0>(INP(26) + (size_t)l * 6144 * 2048, 6144, 2048, (bf16_t*)(wl + L_WDN), scr, r, 64, lane); continue; } r -= I_DN;
        if (r < I_SQ) { transpose_item<0>(INP(19) + (size_t)l * 2048 * 2048, 2048, 2048, (bf16_t*)(wl + L_PA), scr, r, 64, lane); continue; } r -= I_SQ;
        if (r < I_SQ) { transpose_item<0>(INP(20) + (size_t)l * 2048 * 2048, 2048, 2048, (bf16_t*)(wl + L_PB), scr, r, 64, lane); continue; } r -= I_SQ;
        if (r < I_SQ) { transpose_item<0>(INP(21) + (size_t)l * 2048 * 2048, 2048, 2048, (bf16_t*)(wl + L_WO), scr, r, 64, lane); continue; } r -= I_SQ;
        if (r < I_W1) { transpose_item<0>(INP(7) + (size_t)l * 4096 * 128, 4096, 128, (bf16_t*)(wl + L_W1K), scr, r, 4, lane); continue; } r -= I_W1;
        if (r < I_W1) { transpose_item<0>(INP(10) + (size_t)l * 4096 * 128, 4096, 128, (bf16_t*)(wl + L_W1V), scr, r, 4, lane); continue; } r -= I_W1;
        if (r < I_W2) { transpose_item<0>(INP(8) + (size_t)l * 128 * 128, 128, 128, (bf16_t*)(wl + L_W2K), scr, r, 4, lane); continue; } r -= I_W2;
        if (r < I_W2) { transpose_item<0>(INP(11) + (size_t)l * 128 * 128, 128, 128, (bf16_t*)(wl + L_W2V), scr, r, 4, lane); continue; } r -= I_W2;
        if (r < I_LRU) { const int mt = r >> 3; transpose_item<0>(INP(14) + (size_t)(l * 16 + mt) * 16384, 128, 128, (bf16_t*)(wl + L_WA) + mt * 16384, scr, r & 7, 4, lane); continue; } r -= I_LRU;
        { const int mt = r >> 3; transpose_item<0>(INP(16) + (size_t)(l * 16 + mt) * 16384, 128, 128, (bf16_t*)(wl + L_WI) + mt * 16384, scr, r & 7, 4, lane); }
    }
    __syncthreads();
    float* cact = (float*)(lds + 69632);
    float* red = (float*)lds;
    for (int i = tid; i < 8 * 2048; i += 512) { const int b = i >> 11, k = i & 2047; const float v = INP(1)[i]; cact[k * 8 + b] = v * sigm(v); }
    __syncthreads();
    for (int it = bid; it < DEPTH * 256; it += gridDim.x) {
        const int l = it / 256, n = (it % 256) * 48 + (lane < 48 ? lane : 47), kg = wave;
        const float* w = INP(2) + (size_t)l * 2048 * 12288 + (size_t)(kg * 256) * 12288 + n;
        float a[8];
#pragma unroll
        for (int b = 0; b < 8; ++b) a[b] = 0.f;
#pragma unroll 8
        for (int k = 0; k < 256; ++k) {
            const float wv = w[(size_t)k * 12288];
            const f32x4 c0 = *(const f32x4*)(cact + (kg * 256 + k) * 8), c1 = *(const f32x4*)(cact + (kg * 256 + k) * 8 + 4);
            a[0] += wv * c0[0]; a[1] += wv * c0[1]; a[2] += wv * c0[2]; a[3] += wv * c0[3];
            a[4] += wv * c1[0]; a[5] += wv * c1[1]; a[6] += wv * c1[2]; a[7] += wv * c1[3];
        }
#pragma unroll
        for (int b = 0; b < 8; ++b) red[(kg * 8 + b) * 64 + lane] = a[b];
        __syncthreads();
        { const int b = wave; float s = INP(3)[l * 12288 + n];
#pragma unroll
          for (int k2 = 0; k2 < 8; ++k2) s += red[(k2 * 8 + b) * 64 + lane];
          if (lane < 48) ((float*)(P.ws + (size_t)l * LAYER_BYTES + L_MOD))[b * 12288 + n] = s; }
        __syncthreads();
    }
}

template <int MODE>
DEV void phase_norm(const float* xin, const float* gvec, const float* mod, int seg_sh, int seg_sc, bf16_t* outb, float* outf, int bt, int lr, int nl) {
    const int tid_ = otid(); const int lane = tid_ & 63, wave = tid_ >> 6;
    const int gw = lr * 8 + wave, NGW = nl * 8;
    const int rpw = (2048 + NGW - 1) / NGW;
    int cb = -1; f32x4 sa[8], sb[8];
    for (int rl = gw * rpw; rl < (gw + 1) * rpw && rl < 2048; ++rl) {
        const int row = bt * 2048 + rl;
        const int b = row >> 11;
        if (b != cb) { cb = b;
#pragma unroll
            for (int j = 0; j < 8; ++j) { const int col = 4 * (lane + 64 * j); const f32x4 g = *(const f32x4*)(gvec + col);
                if (MODE == 0) { const f32x4 sc = *(const f32x4*)(mod + (size_t)b * 12288 + seg_sc * 2048 + col); sa[j] = g * (sc + 1.f); sb[j] = *(const f32x4*)(mod + (size_t)b * 12288 + seg_sh * 2048 + col); }
                else { sa[j] = g; } } }
        const f32x4* xr = (const f32x4*)(xin + (size_t)row * 2048) + lane;
        f32x4 v[8]; float s = 0.f;
#pragma unroll
        for (int j = 0; j < 8; ++j) { v[j] = xr[64 * j]; s += (v[j][0] * v[j][0] + v[j][1] * v[j][1]) + (v[j][2] * v[j][2] + v[j][3] * v[j][3]); }
        const float inv = 1.f / sqrtf(wave_sum(s, lane) * (1.f / 2048.f) + 1e-6f);
        if (MODE == 0) {
            u32x2* o = (u32x2*)(outb + (size_t)row * 2048) + lane;
#pragma unroll
            for (int j = 0; j < 8; ++j) { const f32x4 r = v[j] * inv * sa[j] + sb[j]; u32x2 w; w.x = cvt_pk_bf16(r[0], r[1]); w.y = cvt_pk_bf16(r[2], r[3]); o[64 * j] = w; }
        } else {
            f32x4* o = (f32x4*)(outf + (size_t)row * 2048) + lane;
#pragma unroll
            for (int j = 0; j < 8; ++j) o[64 * j] = v[j] * inv * sa[j];
        }
    }
}

DEV void cmp_item(const Params& P, int l, int item, unsigned char* lds) {
    const int tid = otid(), lane = tid & 63, w = tid >> 6, c = lane & 15, q = lane >> 4;
    const int kv = item >> 8, bg = (item >> 3) & 31, rt = item & 7, b = bg >> 2, g = bg & 3;
    unsigned char* wl = P.ws + (size_t)l * LAYER_BYTES;
    const bf16_t* src = (const bf16_t*)(P.ws + (kv ? Z_VC : Z_KC));
    const float* pos = INP(kv ? 9 : 6) + (size_t)l * 4096;
    const bf16_t* W1T = (const bf16_t*)(wl + (kv ? L_W1V : L_W1K));
    const bf16_t* W2T = (const bf16_t*)(wl + (kv ? L_W2V : L_W2K));
    const int n = rt * 16 + c; const bool valid = n < 127;
    const bf16_t* arow = src + ((size_t)(b * 2048 + 16 * (valid ? n : 0)) * 512 + g * 128);
    const bf16_t* brow = W1T + (size_t)c * 4096 + w * 512 + q * 8;
    f32x4 acc[8];
#pragma unroll
    for (int ct = 0; ct < 8; ++ct) acc[ct] = (f32x4){0.f, 0.f, 0.f, 0.f};
#pragma unroll 4
    for (int k2 = 0; k2 < 16; ++k2) {
        const int ks = w * 16 + k2, lp = ks >> 2, d = (ks & 3) * 32 + q * 8;
        const u32x4 a = *(const u32x4*)(arow + (size_t)lp * 512 + d);
        const f32x4 p0 = *(const f32x4*)(pos + ks * 32 + q * 8), p1 = *(const f32x4*)(pos + ks * 32 + q * 8 + 4);
        u32x4 bb[8];
#pragma unroll
        for (int ct = 0; ct < 8; ++ct) bb[ct] = *(const u32x4*)(brow + (size_t)ct * 16 * 4096 + k2 * 32);
        u32x4 a2;
        a2.x = cvt_pk_bf16(bflo(a.x) + p0[0], bfhi(a.x) + p0[1]); a2.y = cvt_pk_bf16(bflo(a.y) + p0[2], bfhi(a.y) + p0[3]);
        a2.z = cvt_pk_bf16(bflo(a.z) + p1[0], bfhi(a.z) + p1[1]); a2.w = cvt_pk_bf16(bflo(a.w) + p1[2], bfhi(a.w) + p1[3]);
        if (!valid) a2 = (u32x4){0u, 0u, 0u, 0u};
#pragma unroll
        for (int ct = 0; ct < 8; ++ct) acc[ct] = mfma16(as_bf16x8(a2), as_bf16x8(bb[ct]), acc[ct]);
    }
    float* part = (float*)(lds + 8192);
    bf16_t* hid = (bf16_t*)lds;
#pragma unroll
    for (int ct = 0; ct < 8; ++ct)
#pragma unroll
        for (int j = 0; j < 4; ++j) part[(w * 16 + q * 4 + j) * 128 + ct * 16 + c] = acc[ct][j];
    __syncthreads();
    {
        const int nn = tid >> 5, e4 = (tid & 31) * 4;
        f32x4 sum = *(const f32x4*)(part + nn * 128 + e4);
#pragma unroll
        for (int w2 = 1; w2 < 8; ++w2) sum = sum + *(const f32x4*)(part + (w2 * 16 + nn) * 128 + e4);
        u32x2 hv; hv.x = cvt_pk_bf16(gelu_t(sum[0]), gelu_t(sum[1])); hv.y = cvt_pk_bf16(gelu_t(sum[2]), gelu_t(sum[3]));
        *(u32x2*)(hid + nn * 136 + e4) = hv;
    }
    __syncthreads();
    f32x4 acc2 = {0.f, 0.f, 0.f, 0.f};
#pragma unroll
    for (int ks = 0; ks < 4; ++ks) {
        const u32x4 af = *(const u32x4*)(hid + c * 136 + ks * 32 + q * 8);
        const u32x4 bb = *(const u32x4*)(W2T + (size_t)(w * 16 + c) * 128 + ks * 32 + q * 8);
        acc2 = mfma16(as_bf16x8(af), as_bf16x8(bb), acc2);
    }
    if (kv == 0) { bf16_t* o = (bf16_t*)(P.ws + Z_KCMP) + ((size_t)bg * 128 + rt * 16 + q * 4) * 128 + w * 16 + c;
#pragma unroll
        for (int j = 0; j < 4; ++j) o[j * 128] = (bf16_t)(cvt_pk_bf16(acc2[j], 0.f) & 0xffff);
    } else { bf16_t* o = (bf16_t*)(P.ws + Z_VCMPT) + ((size_t)bg * 128 + w * 16 + c) * 128 + rt * 16 + q * 4;
        u32x2 wv; wv.x = cvt_pk_bf16(acc2[0], acc2[1]); wv.y = cvt_pk_bf16(acc2[2], acc2[3]); *(u32x2*)o = wv; }
    __syncthreads();
}

DEV void cmp_item32(const Params& P, int l, int item, unsigned char* lds) {
    const int tid = otid(), lane = tid & 63, w = tid >> 6, c = lane & 15, q = lane >> 4;
    const int kv = item >> 7, bg = (item >> 2) & 31, rt2 = item & 3, b = bg >> 2, g = bg & 3;
    unsigned char* wl = P.ws + (size_t)l * LAYER_BYTES;
    const bf16_t* src = (const bf16_t*)(P.ws + (kv ? Z_VC : Z_KC));
    const float* pos = INP(kv ? 9 : 6) + (size_t)l * 4096;
    const bf16_t* W1T = (const bf16_t*)(wl + (kv ? L_W1V : L_W1K));
    const bf16_t* W2T = (const bf16_t*)(wl + (kv ? L_W2V : L_W2K));
    const int n0 = rt2 * 32 + c, n1 = n0 + 16; const bool valid0 = n0 < 127, valid1 = n1 < 127;
    const bf16_t* arow0 = src + ((size_t)(b * 2048 + 16 * (valid0 ? n0 : 0)) * 512 + g * 128);
    const bf16_t* arow1 = src + ((size_t)(b * 2048 + 16 * (valid1 ? n1 : 0)) * 512 + g * 128);
    const bf16_t* brow = W1T + (size_t)c * 4096 + w * 512 + q * 8;
    f32x4 acc[2][8];
#pragma unroll
    for (int rr = 0; rr < 2; ++rr)
#pragma unroll
        for (int ct = 0; ct < 8; ++ct) acc[rr][ct] = (f32x4){0.f, 0.f, 0.f, 0.f};
#pragma unroll 2
    for (int k2 = 0; k2 < 16; ++k2) {
        const int ks = w * 16 + k2, lp = ks >> 2, d = (ks & 3) * 32 + q * 8;
        const u32x4 a0 = *(const u32x4*)(arow0 + (size_t)lp * 512 + d), a1 = *(const u32x4*)(arow1 + (size_t)lp * 512 + d);
        const f32x4 p0 = *(const f32x4*)(pos + ks * 32 + q * 8), p1 = *(const f32x4*)(pos + ks * 32 + q * 8 + 4);
        u32x4 bb[8];
#pragma unroll
        for (int ct = 0; ct < 8; ++ct) bb[ct] = *(const u32x4*)(brow + (size_t)ct * 16 * 4096 + k2 * 32);
        u32x4 x0, x1;
        x0.x = cvt_pk_bf16(bflo(a0.x) + p0[0], bfhi(a0.x) + p0[1]); x0.y = cvt_pk_bf16(bflo(a0.y) + p0[2], bfhi(a0.y) + p0[3]);
        x0.z = cvt_pk_bf16(bflo(a0.z) + p1[0], bfhi(a0.z) + p1[1]); x0.w = cvt_pk_bf16(bflo(a0.w) + p1[2], bfhi(a0.w) + p1[3]);
        x1.x = cvt_pk_bf16(bflo(a1.x) + p0[0], bfhi(a1.x) + p0[1]); x1.y = cvt_pk_bf16(bflo(a1.y) + p0[2], bfhi(a1.y) + p0[3]);
        x1.z = cvt_pk_bf16(bflo(a1.z) + p1[0], bfhi(a1.z) + p1[1]); x1.w = cvt_pk_bf16(bflo(a1.w) + p1[2], bfhi(a1.w) + p1[3]);
        if (!valid0) x0 = (u32x4){0u, 0u, 0u, 0u};
        if (!valid1) x1 = (u32x4){0u, 0u, 0u, 0u};
#pragma unroll
        for (int ct = 0; ct < 8; ++ct) { acc[0][ct] = mfma16(as_bf16x8(x0), as_bf16x8(bb[ct]), acc[0][ct]); acc[1][ct] = mfma16(as_bf16x8(x1), as_bf16x8(bb[ct]), acc[1][ct]); }
    }
    float* part = (float*)(lds + 9216);
    bf16_t* hid = (bf16_t*)lds;
#pragma unroll
    for (int rr = 0; rr < 2; ++rr)
#pragma unroll
        for (int ct = 0; ct < 8; ++ct)
#pragma unroll
            for (int j = 0; j < 4; ++j) part[(w * 32 + rr * 16 + q * 4 + j) * 128 + ct * 16 + c] = acc[rr][ct][j];
    __syncthreads();
    {
        const int nn = tid >> 4, e8 = (tid & 15) * 8;
#pragma unroll
        for (int hh = 0; hh < 2; ++hh) {
            f32x4 sum = *(const f32x4*)(part + nn * 128 + e8 + 4 * hh);
#pragma unroll
            for (int w2 = 1; w2 < 8; ++w2) sum = sum + *(const f32x4*)(part + (w2 * 32 + nn) * 128 + e8 + 4 * hh);
            u32x2 hv; hv.x = cvt_pk_bf16(gelu_t(sum[0]), gelu_t(sum[1])); hv.y = cvt_pk_bf16(gelu_t(sum[2]), gelu_t(sum[3]));
            *(u32x2*)(hid + nn * 136 + e8 + 4 * hh) = hv;
        }
    }
    __syncthreads();
#pragma unroll
    for (int rr = 0; rr < 2; ++rr) {
        f32x4 acc2 = {0.f, 0.f, 0.f, 0.f};
#pragma unroll
        for (int ks = 0; ks < 4; ++ks) {
            const u32x4 af = *(const u32x4*)(hid + (rr * 16 + c) * 136 + ks * 32 + q * 8);
            const u32x4 bb = *(const u32x4*)(W2T + (size_t)(w * 16 + c) * 128 + ks * 32 + q * 8);
            acc2 = mfma16(as_bf16x8(af), as_bf16x8(bb), acc2);
        }
        if (kv == 0) { bf16_t* o = (bf16_t*)(P.ws + Z_KCMP) + ((size_t)bg * 128 + rt2 * 32 + rr * 16 + q * 4) * 128 + w * 16 + c;
#pragma unroll
            for (int j = 0; j < 4; ++j) o[j * 128] = (bf16_t)(cvt_pk_bf16(acc2[j], 0.f) & 0xffff);
        } else { bf16_t* o = (bf16_t*)(P.ws + Z_VCMPT) + ((size_t)bg * 128 + w * 16 + c) * 128 + rt2 * 32 + rr * 16 + q * 4;
            u32x2 wv; wv.x = cvt_pk_bf16(acc2[0], acc2[1]); wv.y = cvt_pk_bf16(acc2[2], acc2[3]); *(u32x2*)o = wv; }
    }
    __syncthreads();
}

DEV void lru_item(const Params& P, int l, int item, unsigned char* lds) {
    const int tid = otid(), lane = tid & 63, w = tid >> 6, c = lane & 15, q = lane >> 4;
    const int b = item >> 5, n = (item >> 1) & 15, e = item & 1;
    const int C0 = n * 128, CO = C0 + e * 64;
    unsigned char* wl = P.ws + (size_t)l * LAYER_BYTES;
    constexpr int O_LX = 0, O_UB = 17408, O_UF = 34816, O_WA = 51200, O_WI = 68608, O_A = 86016, O_B = 102400;
    bf16_t* zlx = (bf16_t*)(P.ws + Z_LX); bf16_t* zly = (bf16_t*)(P.ws + Z_LY);
    __syncthreads();
    for (int id = tid; id < 2 * 64 * 16; id += 512) {
        const int which = id >> 10, r = (id >> 4) & 63, pc = id & 15;
        const bf16_t* s = (const bf16_t*)(wl + (which ? L_WI : L_WA)) + ((size_t)(n * 128 + e * 64 + r)) * 128 + pc * 8;
        *(u32x4*)(lds + (which ? O_WI : O_WA) + r * 272 + pc * 16) = *(const u32x4*)s;
    }
    const int chg = tid & 15, tl0 = tid >> 4;
    float cw[4][8], cbias[8];
#pragma unroll
    for (int i = 0; i < 8; ++i) { cbias[i] = INP(13)[l * 2048 + C0 + chg * 8 + i];
#pragma unroll
        for (int j = 0; j < 4; ++j) cw[j][i] = INP(12)[(l * 4 + j) * 2048 + C0 + chg * 8 + i]; }
    const int rt = w & 3, cp = w >> 2;
    float ba[2], bi[2], ll[2];
#pragma unroll
    for (int k2 = 0; k2 < 2; ++k2) { const int ch = l * 2048 + CO + (cp * 2 + k2) * 16 + c; ba[k2] = -1.4426950408889634f * INP(15)[ch]; bi[k2] = -1.4426950408889634f * INP(17)[ch];
        const float tl = 1.4426950408889634f * INP(18)[ch];
        ll[k2] = 8.f * (tl > 0.f ? -__builtin_amdgcn_logf(1.f + __builtin_amdgcn_exp2f(-tl)) : tl - __builtin_amdgcn_logf(1.f + __builtin_amdgcn_exp2f(tl))); }
    float* SEGA = (float*)(lds + 118784); float* SEGH = (float*)(lds + 120832); float* CARRY = (float*)(lds + 122880);
    if (tid < 64) CARRY[tid] = 0.f;
    float* UF = (float*)(lds + O_UF); float* Aa = (float*)(lds + O_A); float* Bb = (float*)(lds + O_B);
    const bf16_t* xcol = zlx + ((size_t)b * 2048) * 2048 + C0 + chg * 8;
    u32x4 xr[2][4];
#pragma unroll
    for (int p = 0; p < 2; ++p)
#pragma unroll
        for (int j = 0; j < 4; ++j) { const int t = tl0 + 32 * p + j - 3; xr[p][j] = (u32x4){0u, 0u, 0u, 0u}; if (t >= 0) xr[p][j] = *(const u32x4*)(xcol + (size_t)t * 2048); }
    u32x4 lyr = {0u, 0u, 0u, 0u}; bf16_t* lyp = zly;
    auto output = [&]() __attribute__((always_inline)) {
        const int tl = tid >> 3, c8 = (tid & 7) * 8;
        const u32x4 y = lyr;
        const f32x4 h0 = *(const f32x4*)(Bb + tl * 64 + c8), h1 = *(const f32x4*)(Bb + tl * 64 + c8 + 4);
        u32x4 o;
        o.x = cvt_pk_bf16(gelu_t(bflo(y.x)) * h0[0], gelu_t(bfhi(y.x)) * h0[1]); o.y = cvt_pk_bf16(gelu_t(bflo(y.y)) * h0[2], gelu_t(bfhi(y.y)) * h0[3]);
        o.z = cvt_pk_bf16(gelu_t(bflo(y.z)) * h1[0], gelu_t(bfhi(y.z)) * h1[1]); o.w = cvt_pk_bf16(gelu_t(bflo(y.w)) * h1[2], gelu_t(bfhi(y.w)) * h1[3]);
        *(u32x4*)lyp = o;
    };
    __syncthreads();
    bf16x8 wfa[4][2], wfi[4][2];
#pragma unroll
    for (int ks = 0; ks < 4; ++ks)
#pragma unroll
        for (int k2 = 0; k2 < 2; ++k2) { const int ct = cp * 2 + k2;
            wfa[ks][k2] = *(const bf16x8*)(lds + O_WA + (ct * 16 + c) * 272 + ks * 64 + q * 16);
            wfi[ks][k2] = *(const bf16x8*)(lds + O_WI + (ct * 16 + c) * 272 + ks * 64 + q * 16); }
    for (int ci = 0; ci < 32; ++ci) {
        const int t0 = ci * 64;
        if (ci > 0) output();
        lyp = zly + ((size_t)(b * 2048 + t0 + (tid >> 3))) * 2048 + CO + (tid & 7) * 8;
        lyr = *(const u32x4*)lyp;
#pragma unroll
        for (int pass = 0; pass < 2; ++pass) {
            const int tl = tl0 + 32 * pass;
            float u[8];
#pragma unroll
            for (int i = 0; i < 8; ++i) u[i] = cbias[i];
#pragma unroll
            for (int j = 0; j < 4; ++j) {
                const u32x4 x = xr[pass][j];
                u[0] += cw[j][0] * bflo(x.x); u[1] += cw[j][1] * bfhi(x.x); u[2] += cw[j][2] * bflo(x.y); u[3] += cw[j][3] * bfhi(x.y);
                u[4] += cw[j][4] * bflo(x.z); u[5] += cw[j][5] * bfhi(x.z); u[6] += cw[j][6] * bflo(x.w); u[7] += cw[j][7] * bfhi(x.w);
            }
            u32x4 pk; pk.x = cvt_pk_bf16(u[0], u[1]); pk.y = cvt_pk_bf16(u[2], u[3]); pk.z = cvt_pk_bf16(u[4], u[5]); pk.w = cvt_pk_bf16(u[6], u[7]);
            *(u32x4*)(lds + O_UB + tl * 272 + chg * 16) = pk;
            if ((chg >> 3) == e) { float* uf = UF + tl * 64 + (chg & 7) * 8;
                *(f32x4*)uf = (f32x4){u[0], u[1], u[2], u[3]}; *(f32x4*)(uf + 4) = (f32x4){u[4], u[5], u[6], u[7]}; }
        }
        if (ci + 1 < 32) {
#pragma unroll
            for (int p = 0; p < 2; ++p)
#pragma unroll
                for (int j = 0; j < 4; ++j) xr[p][j] = *(const u32x4*)(xcol + (size_t)(t0 + 64 + tl0 + 32 * p + j - 3) * 2048);
        }
        __syncthreads();
        {
            f32x4 ar[2], ai[2];
#pragma unroll
            for (int k2 = 0; k2 < 2; ++k2) { ar[k2] = (f32x4){0.f, 0.f, 0.f, 0.f}; ai[k2] = (f32x4){0.f, 0.f, 0.f, 0.f}; }
#pragma unroll
            for (int ks = 0; ks < 4; ++ks) {
                const bf16x8 af = *(const bf16x8*)(lds + O_UB + (rt * 16 + c) * 272 + ks * 64 + q * 16);
#pragma unroll
                for (int k2 = 0; k2 < 2; ++k2) { ar[k2] = mfma16(af, wfa[ks][k2], ar[k2]); ai[k2] = mfma16(af, wfi[ks][k2], ai[k2]); }
            }
#pragma unroll
            for (int k2 = 0; k2 < 2; ++k2)
#pragma unroll
                for (int j = 0; j < 4; ++j) {
                    const int tl = rt * 16 + q * 4 + j, cc = (cp * 2 + k2) * 16 + c;
                    const float uu = UF[tl * 64 + cc];
                    const float r = frcp(1.f + __builtin_amdgcn_exp2f(__builtin_fmaf(ar[k2][j], -1.4426950408889634f, ba[k2])));
                    const float ig = frcp(1.f + __builtin_amdgcn_exp2f(__builtin_fmaf(ai[k2][j], -1.4426950408889634f, bi[k2])));
                    const float av = __builtin_amdgcn_exp2f(r * ll[k2]);
                    const float om = __builtin_fmaf(-av, av, 1.f);
                    Aa[tl * 64 + cc] = av;
                    Bb[tl * 64 + cc] = __builtin_amdgcn_sqrtf(fmaxf(om, 0.f)) * (ig * uu);
                }
        }
        __syncthreads();
        {
            float av8[8], hl[8]; float Acum = 1.f, h = 0.f;
#pragma unroll
            for (int k = 0; k < 8; ++k) { const float a = Aa[(w * 8 + k) * 64 + lane], bb2 = Bb[(w * 8 + k) * 64 + lane]; h = a * h + bb2; Acum *= a; av8[k] = Acum; hl[k] = h; }
            SEGA[w * 64 + lane] = Acum; SEGH[w * 64 + lane] = h;
            __syncthreads();
            float hin = CARRY[(ci & 1) * 64 + lane];
            float sa7[7], sh7[7];
#pragma unroll
            for (int s2 = 0; s2 < 7; ++s2) { sa7[s2] = SEGA[s2 * 64 + lane]; sh7[s2] = SEGH[s2 * 64 + lane]; }
#pragma unroll
            for (int s2 = 0; s2 < 7; ++s2) if (s2 < w) hin = sa7[s2] * hin + sh7[s2];
#pragma unroll
            for (int k = 0; k < 8; ++k) { hl[k] = hl[k] + av8[k] * hin; Bb[(w * 8 + k) * 64 + lane] = hl[k]; }
            if (w == 7) CARRY[((ci + 1) & 1) * 64 + lane] = hl[7];
        }
        __syncthreads();
    }
    output();
    __syncthreads();
}

constexpr int A_KC = 0, A_VC = 34816, A_K = 0, A_V = 17408, A_E = 69632, A_CAR = 102400, A_IMP = 118784, A_SEL = 142336, A_OST = 71680;
constexpr float L2E = 1.4426950408889634f;

DEV void attn_item(const Params& P, int b, int g, int qt, unsigned char* lds) {
    const int tid = otid(), lane = tid & 63, w = tid >> 6, c = lane & 15, q = lane >> 4;
    const int hg = w >> 1, th = w & 1, head = g * 4 + hg, bg = b * 4 + g;
    const int tq0 = 64 * qt + 32 * th;
    const size_t rowbase = (size_t)b * 2048;
    bf16_t* zq = (bf16_t*)(P.ws + Z_Q);
    bf16_t* zo = PROBE_CHECK ? (bf16_t*)(P.ws + WS_OBUF) : zq;

    bf16x8 QF[2][4];
#pragma unroll
    for (int nt = 0; nt < 2; ++nt)
#pragma unroll
        for (int ks = 0; ks < 4; ++ks) QF[nt][ks] = *(const bf16x8*)(zq + (rowbase + tq0 + 16 * nt + c) * 2048 + head * 128 + ks * 32 + q * 8);
    float gate[3][2];
#pragma unroll
    for (int nt = 0; nt < 2; ++nt)
#pragma unroll
        for (int br = 0; br < 3; ++br) { const unsigned short gv = ((const bf16_t*)(P.ws + Z_GATE))[(rowbase + tq0 + 16 * nt + c) * 64 + head * 3 + br]; gate[br][nt] = sigm(bflo((unsigned)gv)); }

    __syncthreads();
    {
        const bf16_t* kc = (const bf16_t*)(P.ws + Z_KCMP) + (size_t)bg * 16384; const bf16_t* vc = (const bf16_t*)(P.ws + Z_VCMPT) + (size_t)bg * 16384;
        const int nvis = ((4 * qt + 2) / 32 + 1) * 32;
#pragma unroll
        for (int i = 0; i < 4; ++i) { const int id = tid + 512 * i, r = id >> 4, pc = id & 15;
            if (r < nvis) { const int kk = r & 31, rho = (r & ~31) + ((kk >> 2) & 1) * 16 + (kk >> 3) * 4 + (kk & 3);
              *(u32x4*)(lds + A_KC + rho * 272 + pc * 16) = *(const u32x4*)(kc + r * 128 + pc * 8); }
            if (pc * 8 < nvis) *(u32x4*)(lds + A_VC + r * 272 + pc * 16) = *(const u32x4*)(vc + r * 128 + pc * 8); }
    }
    __syncthreads();

    f32x4 o[8][2];
#pragma unroll
    for (int dt = 0; dt < 8; ++dt)
#pragma unroll
        for (int nt = 0; nt < 2; ++nt) o[dt][nt] = (f32x4){0.f, 0.f, 0.f, 0.f};
    {
        f32x4 s[4][2][2];
#pragma unroll
        for (int ch = 0; ch < 4; ++ch)
#pragma unroll
            for (int u = 0; u < 2; ++u)
#pragma unroll
                for (int nt = 0; nt < 2; ++nt) s[ch][u][nt] = (f32x4){0.f, 0.f, 0.f, 0.f};
        const int nch = (4 * qt + 2) / 32 + 1;
#pragma unroll
        for (int ch = 0; ch < 4; ++ch) if (ch < nch) {
#pragma unroll
            for (int ks = 0; ks < 4; ++ks)
#pragma unroll
                for (int u = 0; u < 2; ++u) {
                    const bf16x8 kf = *(const bf16x8*)(lds + A_KC + (ch * 32 + u * 16 + c) * 272 + ks * 64 + q * 16);
#pragma unroll
                    for (int nt = 0; nt < 2; ++nt) s[ch][u][nt] = mfma16(kf, QF[nt][ks], s[ch][u][nt]);
                }
        }
        float* E = (float*)(lds + A_E); float* CAR = (float*)(lds + A_CAR);
#pragma unroll
        for (int nt = 0; nt < 2; ++nt) {
            const int t = tq0 + 16 * nt + c, nmax = (t - 31) >> 4;
            float mx = -1e30f;
#pragma unroll
            for (int ch = 0; ch < 4; ++ch)
#pragma unroll
                for (int u = 0; u < 2; ++u)
#pragma unroll
                    for (int j = 0; j < 4; ++j) { const int n = ch * 32 + q * 8 + u * 4 + j; const float v = s[ch][u][nt][j] * L2E; s[ch][u][nt][j] = v; if (n <= nmax) mx = fmaxf(mx, v); }
            mx = fmaxf(mx, shx(mx, 16, lane)); mx = fmaxf(mx, shx(mx, 32, lane));
            float sum = 0.f;
#pragma unroll
            for (int ch = 0; ch < 4; ++ch)
#pragma unroll
                for (int u = 0; u < 2; ++u)
#pragma unroll
                    for (int j = 0; j < 4; ++j) { const int n = ch * 32 + q * 8 + u * 4 + j; const float p = (n <= nmax) ? __builtin_amdgcn_exp2f(s[ch][u][nt][j] - mx) : 0.f; s[ch][u][nt][j] = p; sum += p; }
            sum += shx(sum, 16, lane); sum += shx(sum, 32, lane);
            const float inv = frcp(fmaxf(sum, 1e-30f));
            const int tl = 32 * th + 16 * nt + c;
#pragma unroll
            for (int ch = 0; ch < 4; ++ch) {
#pragma unroll
                for (int u = 0; u < 2; ++u) s[ch][u][nt] = s[ch][u][nt] * inv;
                const f32x4 pa = s[ch][0][nt], pb = s[ch][1][nt];
                E[(hg * 64 + tl) * 32 + 8 * ch + 2 * q] = (pa[0] + pa[1]) + (pa[2] + pa[3]);
                E[(hg * 64 + tl) * 32 + 8 * ch + 2 * q + 1] = pa[3] + ((pb[0] + pb[1]) + (pb[2] + pb[3]));
                CAR[(hg * 64 + tl) * 16 + 4 * ch + q] = pb[3];
            }
        }
#pragma unroll
        for (int ch = 0; ch < 4; ++ch) if (ch < nch) {
            bf16x8 pf[2];
#pragma unroll
            for (int nt = 0; nt < 2; ++nt) pf[nt] = as_bf16x8(pack8(s[ch][0][nt], s[ch][1][nt]));
#pragma unroll
            for (int dt = 0; dt < 8; ++dt) {
                const bf16x8 vf = *(const bf16x8*)(lds + A_VC + (dt * 16 + c) * 272 + (ch * 32 + q * 8) * 2);
#pragma unroll
                for (int nt = 0; nt < 2; ++nt) o[dt][nt] = mfma16(vf, pf[nt], o[dt][nt]);
            }
        }
    }
    u32x4 pk[2], pv[2];
#pragma unroll
    for (int i = 0; i < 2; ++i) { const int id = tid + 512 * i;
        pk[i] = *(const u32x4*)((const bf16_t*)(P.ws + Z_KS) + (rowbase + 64 * qt + (id >> 4)) * 512 + g * 128 + (id & 15) * 8);
        pv[i] = *(const u32x4*)((const bf16_t*)(P.ws + Z_VST) + ((size_t)bg * 128 + (id >> 3)) * 2048 + 64 * qt + (id & 7) * 8); }
    __syncthreads();
    {
        const float* E = (const float*)(lds + A_E); const float* CAR = (const float*)(lds + A_CAR); float* IMP = (float*)(lds + A_IMP);
        const int tl = tid >> 3, jg = tid & 7;
#pragma unroll
        for (int jj = 0; jj < 4; ++jj) { const int j = jg * 4 + jj; float v = 0.f;
#pragma unroll
            for (int h = 0; h < 4; ++h) { v += E[(h * 64 + tl) * 32 + j]; if ((j & 1) == 0 && j >= 2) v += CAR[(h * 64 + tl) * 16 + (j >> 1) - 1]; }
            IMP[tl * 32 + j] = v; }
        __syncthreads();
        const int cur = qt, nforced = cur >= 2 ? 3 : cur + 1;
        unsigned bits = 0u;
        const f32x4 v4 = *(const f32x4*)(IMP + tl * 32 + jg * 4);
        int cnt[4] = {0, 0, 0, 0};
#pragma unroll 4
        for (int j2 = 1; j2 <= cur - 2; ++j2) { const float v2 = IMP[tl * 32 + j2];
#pragma unroll
            for (int jj = 0; jj < 4; ++jj) cnt[jj] += (v2 > v4[jj] || (v2 == v4[jj] && j2 < jg * 4 + jj)) ? 1 : 0; }
#pragma unroll
        for (int jj = 0; jj < 4; ++jj) { const int j = jg * 4 + jj; bool sel;
            if (j > cur) sel = false;
            else if (j == 0 || j > cur - 2) sel = true;
            else sel = cnt[jj] < 16 - nforced;
            bits |= sel ? (1u << j) : 0u; }
        bits |= shxu(bits, 1, lane); bits |= shxu(bits, 2, lane); bits |= shxu(bits, 4, lane);
        if (jg == 0) ((unsigned*)(lds + A_SEL))[tl] = bits;
    }
    __syncthreads();
    unsigned selm[2];
#pragma unroll
    for (int nt = 0; nt < 2; ++nt) selm[nt] = ((const unsigned*)(lds + A_SEL))[32 * th + 16 * nt + c];
    unsigned char* ost = lds + A_OST + w * 8704;
#pragma unroll
    for (int nt = 0; nt < 2; ++nt)
#pragma unroll
        for (int dt = 0; dt < 8; ++dt) {
            const f32x4 r = o[dt][nt] * gate[0][nt];
            u32x2 wv; wv.x = cvt_pk_bf16(r[0], r[1]); wv.y = cvt_pk_bf16(r[2], r[3]);
            *(u32x2*)(ost + (16 * nt + c) * 272 + (16 * dt + 4 * q) * 2) = wv;
        }

    constexpr int KVB = 35840;
#pragma unroll 1
    for (int br = 0; br < 2; ++br) {
        const bf16_t* Ks = (const bf16_t*)(P.ws + (br ? Z_KW : Z_KS)); const bf16_t* Vs = (const bf16_t*)(P.ws + (br ? Z_VWT : Z_VST));
        const int ntile = br ? (qt + 1 < 9 ? qt + 1 : 9) : qt + 1;
        unsigned sm[2]; int lo[2], tq[2];
#pragma unroll
        for (int nt = 0; nt < 2; ++nt) { tq[nt] = tq0 + 16 * nt + c; sm[nt] = br ? 0xffffffffu : selm[nt]; lo[nt] = br ? tq[nt] - 511 : -1; }
        float mrow[2] = {-1e30f, -1e30f}, lrow[2] = {0.f, 0.f};
#pragma unroll
        for (int dt = 0; dt < 8; ++dt)
#pragma unroll
            for (int nt = 0; nt < 2; ++nt) o[dt][nt] = (f32x4){0.f, 0.f, 0.f, 0.f};
        auto tile_of = [&](int i) { return br ? qt - i : (i == 0 ? qt : i - 1); };
        auto prefetch = [&](int j) {
#pragma unroll
            for (int i = 0; i < 2; ++i) { const int id = tid + 512 * i;
                pk[i] = *(const u32x4*)(Ks + (rowbase + 64 * j + (id >> 4)) * 512 + g * 128 + (id & 15) * 8);
                pv[i] = *(const u32x4*)(Vs + ((size_t)bg * 128 + (id >> 3)) * 2048 + 64 * j + (id & 7) * 8); }
        };
        auto stage = [&](int buf) {
#pragma unroll
            for (int i2 = 0; i2 < 2; ++i2) { const int id = tid + 512 * i2, r = id >> 4, kk = r & 31, rho = (r & ~31) + ((kk >> 2) & 1) * 16 + (kk >> 3) * 4 + (kk & 3);
                *(u32x4*)(lds + buf * KVB + rho * 272 + (id & 15) * 16) = pk[i2];
                *(u32x4*)(lds + buf * KVB + 17408 + (id >> 3) * 144 + (id & 7) * 16) = pv[i2]; }
        };
        stage(0);
        if (ntile > 1) prefetch(tile_of(1));
        __syncthreads();
#pragma unroll 1
        for (int i = 0; i < ntile; ++i) {
            const int j = tile_of(i);
            const unsigned char* kb = lds + (i & 1) * KVB; const unsigned char* vb = kb + 17408;
            f32x4 s[2][2][2];
#pragma unroll
            for (int ch = 0; ch < 2; ++ch)
#pragma unroll
                for (int u = 0; u < 2; ++u)
#pragma unroll
                    for (int nt = 0; nt < 2; ++nt) s[ch][u][nt] = (f32x4){0.f, 0.f, 0.f, 0.f};
            {
                const unsigned char* kp = kb + c * 272 + q * 16;
#define KFRAG(f) (*(const bf16x8*)(kp + (((f) >> 3) * 32 + ((f) & 1) * 16) * 272 + (((f) >> 1) & 3) * 64))
                bf16x8 kfa = KFRAG(0), kfb = KFRAG(1);
                __builtin_amdgcn_sched_barrier(0);
#pragma unroll
                for (int f = 0; f < 16; ++f) {
                    const int ch = f >> 3, ks = (f >> 1) & 3, u = f & 1;
                    const bf16x8 kf = (f & 1) ? kfb : kfa;
#pragma unroll
                    for (int nt = 0; nt < 2; ++nt) s[ch][u][nt] = mfma16(kf, QF[nt][ks], s[ch][u][nt]);
                    if (f + 2 < 16) { if (f & 1) kfb = KFRAG(f + 2); else kfa = KFRAG(f + 2); }
                    __builtin_amdgcn_sched_barrier(0);
                }
#undef KFRAG
            }
            const bool needkey = (j == qt) || (br && j == qt - 8);
            const bool sel0 = (sm[0] >> j) & 1u, sel1 = (sm[1] >> j) & 1u;
            const bool allsel = __builtin_amdgcn_ballot_w64(!(sel0 && sel1)) == 0ull;
            if (needkey) {
#pragma unroll
                for (int nt = 0; nt < 2; ++nt) { const bool sl = nt ? sel1 : sel0;
#pragma unroll
                    for (int ch = 0; ch < 2; ++ch)
#pragma unroll
                        for (int u = 0; u < 2; ++u)
#pragma unroll
                            for (int jj = 0; jj < 4; ++jj) { const int key = 64 * j + ch * 32 + q * 8 + u * 4 + jj;
                                const bool ok = sl && key <= tq[nt] && key >= lo[nt]; s[ch][u][nt][jj] = ok ? s[ch][u][nt][jj] : -1e30f; } }
            } else if (!allsel) {
#pragma unroll
                for (int nt = 0; nt < 2; ++nt) { const bool sl = nt ? sel1 : sel0;
#pragma unroll
                    for (int ch = 0; ch < 2; ++ch)
#pragma unroll
                        for (int u = 0; u < 2; ++u)
#pragma unroll
                            for (int jj = 0; jj < 4; ++jj) s[ch][u][nt][jj] = sl ? s[ch][u][nt][jj] : -1e30f; }
            }
            float mnew[2];
#pragma unroll
            for (int nt = 0; nt < 2; ++nt) {
                float mx = -1e30f;
#pragma unroll
                for (int ch = 0; ch < 2; ++ch)
#pragma unroll
                    for (int u = 0; u < 2; ++u) mx = fmaxf(fmaxf(mx, fmaxf(s[ch][u][nt][0], s[ch][u][nt][1])), fmaxf(s[ch][u][nt][2], s[ch][u][nt][3]));
                mx = fmaxf(mx, shx(mx, 16, lane)); mx = fmaxf(mx, shx(mx, 32, lane));
                mnew[nt] = fmaxf(mrow[nt], mx * L2E);
            }
            if (__builtin_amdgcn_ballot_w64(mnew[0] > mrow[0] + 8.f || mnew[1] > mrow[1] + 8.f) != 0ull) {
#pragma unroll
                for (int nt = 0; nt < 2; ++nt) { const float alpha = __builtin_amdgcn_exp2f(mrow[nt] - mnew[nt]); mrow[nt] = mnew[nt]; lrow[nt] *= alpha;
#pragma unroll
                    for (int dt = 0; dt < 8; ++dt) o[dt][nt] = o[dt][nt] * alpha; }
            }
#pragma unroll
            for (int nt = 0; nt < 2; ++nt) {
                const float nm = -mrow[nt]; float ps = 0.f;
#pragma unroll
                for (int ch = 0; ch < 2; ++ch)
#pragma unroll
                    for (int u = 0; u < 2; ++u)
#pragma unroll
                        for (int jj = 0; jj < 4; ++jj) { const float p = __builtin_amdgcn_exp2f(__builtin_fmaf(s[ch][u][nt][jj], L2E, nm)); s[ch][u][nt][jj] = p; ps += p; }
                lrow[nt] += ps;
            }
            {
                bf16x8 pf[2][2];
#pragma unroll
                for (int ch = 0; ch < 2; ++ch)
#pragma unroll
                    for (int nt = 0; nt < 2; ++nt) pf[ch][nt] = as_bf16x8(pack8(s[ch][0][nt], s[ch][1][nt]));
                const unsigned char* vp = vb + c * 144 + q * 16;
#define VFRAG(f) (*(const bf16x8*)(vp + ((f) & 7) * 16 * 144 + ((f) >> 3) * 64))
                bf16x8 vfa = VFRAG(0), vfb = VFRAG(1);
                __builtin_amdgcn_sched_barrier(0);
#pragma unroll
                for (int f = 0; f < 16; ++f) {
                    const int ch = f >> 3, dt = f & 7;
                    const bf16x8 vf = (f & 1) ? vfb : vfa;
#pragma unroll
                    for (int nt = 0; nt < 2; ++nt) o[dt][nt] = mfma16(vf, pf[ch][nt], o[dt][nt]);
                    if (f + 2 < 16) { if (f & 1) vfb = VFRAG(f + 2); else vfa = VFRAG(f + 2); }
                    __builtin_amdgcn_sched_barrier(0);
                }
#undef VFRAG
            }
            if (i + 1 < ntile) { stage((i + 1) & 1); if (i + 2 < ntile) prefetch(tile_of(i + 2)); }
            __syncthreads();
        }
        if (br == 0) {
#pragma unroll
            for (int i = 0; i < 2; ++i) { const int id = tid + 512 * i;
                pk[i] = *(const u32x4*)((const bf16_t*)(P.ws + Z_KW) + (rowbase + 64 * qt + (id >> 4)) * 512 + g * 128 + (id & 15) * 8);
                pv[i] = *(const u32x4*)((const bf16_t*)(P.ws + Z_VWT) + ((size_t)bg * 128 + (id >> 3)) * 2048 + 64 * qt + (id & 7) * 8); }
        }
#pragma unroll
        for (int nt = 0; nt < 2; ++nt) {
            float lsum = lrow[nt]; lsum += shx(lsum, 16, lane); lsum += shx(lsum, 32, lane);
            const float sc = gate[1 + br][nt] * frcp(fmaxf(lsum, 1e-30f));
#pragma unroll
            for (int dt = 0; dt < 8; ++dt) {
                u32x2* p = (u32x2*)(ost + (16 * nt + c) * 272 + (16 * dt + 4 * q) * 2);
                const u32x2 pv2 = *p; const f32x4 r = o[dt][nt] * sc;
                u32x2 wv; wv.x = cvt_pk_bf16(bflo(pv2.x) + r[0], bfhi(pv2.x) + r[1]); wv.y = cvt_pk_bf16(bflo(pv2.y) + r[2], bfhi(pv2.y) + r[3]);
                *p = wv;
            }
        }
    }
#pragma unroll
    for (int i = 0; i < 8; ++i) { const int r = (lane >> 4) + 4 * i, ck = lane & 15;
        *(u32x4*)(zo + (rowbase + tq0 + r) * 2048 + head * 128 + ck * 8) = *(const u32x4*)(ost + r * 272 + ck * 16); }
}

#if PROBE_CHECK
DEV float bfv(const bf16_t* p) { return __builtin_bit_cast(float, (unsigned)(*p) << 16); }
DEV void nsa_check(const Params& P, unsigned char* lds) {
    const int tid = otid(), bid = obid();
    const int b = bid & 7, g = (bid >> 3) & 3, t = (bid * 677 + 331) & 2047, bg = b * 4 + g, cur = t >> 6;
    const int h = tid >> 7, d = tid & 127;
    float* qs = (float*)lds;
    float* sc = (float*)(lds + 2048);
    float* impv = (float*)(lds + 2048 + 32768);
    unsigned* selw = (unsigned*)(lds + 2048 + 32768 + 128);
    float* red = (float*)(lds + 2048 + 32768 + 256);
    const bf16_t* zq = (const bf16_t*)(P.ws + Z_Q);
    const size_t row = (size_t)b * 2048 + t;
    __syncthreads();
    qs[h * 128 + d] = bfv(zq + row * 2048 + (g * 4 + h) * 128 + d);
    __syncthreads();
    const int nvis = t >= 31 ? ((t - 31) >> 4) + 1 : 0;
    { const int n = d; float s = -INFINITY;
      if (n < nvis) { s = 0.f; const bf16_t* kr = (const bf16_t*)(P.ws + Z_KCMP) + ((size_t)bg * 128 + n) * 128; for (int k = 0; k < 128; ++k) s += qs[h * 128 + k] * bfv(kr + k); }
      sc[h * 2048 + n] = s; }
    __syncthreads();
    if (tid < 4) { float m = -INFINITY; for (int n = 0; n < 128; ++n) m = fmaxf(m, sc[tid * 2048 + n]); if (!(m > -INFINITY)) m = 0.f;
        float sum = 0.f; for (int n = 0; n < 128; ++n) { const float p = __expf(sc[tid * 2048 + n] - m); sc[tid * 2048 + n] = p; sum += p; }
        const float inv = 1.f / fmaxf(sum, 1e-30f); for (int n = 0; n < 128; ++n) sc[tid * 2048 + n] *= inv; }
    __syncthreads();
    float o_cmp = 0.f;
    { const bf16_t* vr = (const bf16_t*)(P.ws + Z_VCMPT) + ((size_t)bg * 128 + d) * 128; for (int n = 0; n < 127; ++n) o_cmp += sc[h * 2048 + n] * bfv(vr + n); }
    if (tid < 32) { float v = 0.f; for (int hh = 0; hh < 4; ++hh) for (int n = 4 * tid - 1; n <= 4 * tid + 3; ++n) if (n >= 0 && n <= 126) v += sc[hh * 2048 + n]; impv[tid] = v; }
    __syncthreads();
    if (tid == 0) {
        unsigned mask = 0u;
        for (int pick = 0; pick < 16; ++pick) { int best = -1; float bv = 0.f;
            for (int j = 0; j < 32; ++j) { if ((mask >> j) & 1u) continue;
                const bool valid = j <= cur, forced = (j == 0) || (valid && j > cur - 2);
                const float v = forced ? impv[j] + 1e4f : (valid ? impv[j] : -1.f);
                if (best < 0 || v > bv) { best = j; bv = v; } }
            mask |= 1u << best; }
        selw[0] = mask; }
    __syncthreads();
    const unsigned selmask = selw[0];
    float o_br[2];
    for (int br = 0; br < 2; ++br) {
        const bf16_t* Ks = (const bf16_t*)(P.ws + (br ? Z_KW : Z_KS)); const bf16_t* Vs = (const bf16_t*)(P.ws + (br ? Z_VWT : Z_VST));
        __syncthreads();
        for (int cidx = 0; cidx < 16; ++cidx) { const int key = cidx * 128 + d; float s = -INFINITY;
            const bool ok = br ? (key <= t && key > t - 512) : (key <= t && ((selmask >> (key >> 6)) & 1u));
            if (ok) { s = 0.f; const bf16_t* kr = Ks + ((size_t)b * 2048 + key) * 512 + g * 128; for (int k = 0; k < 128; ++k) s += qs[h * 128 + k] * bfv(kr + k); }
            sc[h * 2048 + key] = s; }
        __syncthreads();
        if (tid < 4) { float m = -INFINITY; for (int n = 0; n < 2048; ++n) m = fmaxf(m, sc[tid * 2048 + n]); if (!(m > -INFINITY)) m = 0.f;
            float sum = 0.f; for (int n = 0; n < 2048; ++n) { const float p = __expf(sc[tid * 2048 + n] - m); sc[tid * 2048 + n] = p; sum += p; }
            const float inv = 1.f / fmaxf(sum, 1e-30f); for (int n = 0; n < 2048; ++n) sc[tid * 2048 + n] *= inv; }
        __syncthreads();
        float acc = 0.f; const bf16_t* vr = Vs + ((size_t)bg * 128 + d) * 2048;
        for (int key = 0; key <= t; ++key) acc += sc[h * 2048 + key] * bfv(vr + key);
        o_br[br] = acc;
    }
    const bf16_t* gz = (const bf16_t*)(P.ws + Z_GATE) + row * 64 + (g * 4 + h) * 3;
    const float g0 = 1.f / (1.f + __expf(-bfv(gz))), g1 = 1.f / (1.f + __expf(-bfv(gz + 1))), g2 = 1.f / (1.f + __expf(-bfv(gz + 2)));
    const float oref = g0 * o_cmp + g1 * o_br[0] + g2 * o_br[1];
    const float ofast = bfv((const bf16_t*)(P.ws + WS_OBUF) + row * 2048 + (g * 4 + h) * 128 + d);
    __syncthreads();
    red[tid] = (ofast - oref) * (ofast - oref); red[512 + tid] = oref * oref;
    __syncthreads();
    if (tid == 0) { float a = 0.f, r2 = 0.f; for (int i = 0; i < 512; ++i) { a += red[i]; r2 += red[512 + i]; }
        ((float*)(P.ws + WS_CHK))[bid] = sqrtf(a / fmaxf(r2, 1e-30f)); }
    __syncthreads();
}
#endif


DEV void phase_attn(const Params& P, unsigned char* lds, int b, int lr, int nl) {
    for (int idx = lr; idx < 128; idx += nl) {
        const int k = idx >> 5, r = idx & 31, g = k;
        const int qt = (k & 1) ? r : 31 - r;
        attn_item(P, b, g, qt, lds);
    }
    __syncthreads();
}

#define XB_TMO      128
#define XB_XCNT(j)  (256  + 64 * (j))
#define XB_XSUB(j)  (1280 + 64 * (j))
#define XB_XGEN(j)  (2304 + 64 * (j))
#define XB_TOP      3328
#define XB_TOPGEN   3392
#define XCD_BAR_WORDS 3456
#define XB_LSUB(j)  (3456 + 16 * (j))
#define XB_LGEN(j)  (3712 + 16 * (j))
#define XB_SPIN_CAP (1u << 18)
DEV unsigned xb_ld(unsigned* p)              { return __hip_atomic_load(p, __ATOMIC_RELAXED, __HIP_MEMORY_SCOPE_AGENT); }
DEV unsigned xb_add(unsigned* p, unsigned v) { return __hip_atomic_fetch_add(p, v, __ATOMIC_RELAXED, __HIP_MEMORY_SCOPE_AGENT); }
DEV unsigned xb_xcc_id() { return (unsigned)__builtin_amdgcn_s_getreg((3 << 11) | 20) & 0xFu; }
#define XB_SPIN(cond, bar) do { unsigned _sp = 0; while (cond) { __builtin_amdgcn_s_sleep(1); \
    if ((++_sp & 255u) == 0u) { if (xb_ld(&(bar)[XB_TMO])) break; if (_sp > XB_SPIN_CAP) { atomicAdd(&(bar)[XB_TMO], 1u); break; } } } } while (0)
struct XcdBarrier { unsigned* bar; unsigned x; volatile LAS unsigned* st; };
DEV XcdBarrier xcd_barrier_post(unsigned* bar, volatile LAS unsigned* st) {
    XcdBarrier b; b.bar = bar; b.x = xb_xcc_id(); b.st = st;
    if (threadIdx.x == 0) st[3] = xb_add(&bar[XB_XCNT(b.x)], 1u);
    return b;
}
DEV void xcd_barrier_complete(unsigned* bar, unsigned x, unsigned& nloc, unsigned& nx, unsigned& gidx) {
    const unsigned G = gridDim.x * gridDim.y * gridDim.z;
    unsigned sum, cnt, mine, below, sp = 0u;
    for (;;) {
        sum = 0u; cnt = 0u; mine = 0u; below = 0u;
#pragma unroll 1
        for (unsigned j = 0; j < 16; ++j) { const unsigned c = xb_ld(&bar[XB_XCNT(j)]); sum += c; cnt += (c > 0u) ? 1u : 0u; mine = (j == x) ? c : mine; below += (c > 0u && j < x) ? 1u : 0u; }
        if (sum == G) break;
        __builtin_amdgcn_s_sleep(1);
        if ((++sp & 255u) == 0u) { if (xb_ld(&bar[XB_TMO])) break; if (sp > XB_SPIN_CAP) { atomicAdd(&bar[XB_TMO], 1u); break; } }
    }
    nloc = mine > 0u ? mine : 1u; nx = cnt > 0u ? cnt : 1u; gidx = below;
}
DEV void xcd_barrier(const XcdBarrier& b) {
    asm volatile("s_waitcnt vmcnt(0)" ::: "memory");
    __syncthreads();
    if (threadIdx.x == 0) {
        unsigned* bar = b.bar;
        __builtin_amdgcn_s_waitcnt(0);
        unsigned nloc = b.st[0], nx = b.st[1];
        if (nloc == 0u) { unsigned gidx; xcd_barrier_complete(bar, b.x, nloc, nx, gidx); b.st[0] = nloc; b.st[1] = nx; b.st[2] = gidx; }
        const unsigned old = xb_add(&bar[XB_XSUB(b.x)], 1u);
        const unsigned gen = old / nloc;
        if (old + 1u == (gen + 1u) * nloc) {
            __builtin_amdgcn_fence(__ATOMIC_RELEASE, "agent");
            asm volatile("s_waitcnt vmcnt(0)" ::: "memory");
            const unsigned og = xb_add(&bar[XB_TOP], 1u);
            const unsigned tg = og / nx;
            if (og + 1u == (tg + 1u) * nx) xb_add(&bar[XB_TOPGEN], 1u);
            else XB_SPIN(xb_ld(&bar[XB_TOPGEN]) == tg, bar);
            __builtin_amdgcn_fence(__ATOMIC_ACQUIRE, "agent");
            xb_add(&bar[XB_XGEN(b.x)], 1u);
            asm volatile("s_waitcnt vmcnt(0)" ::: "memory");
        } else {
            XB_SPIN(xb_ld(&bar[XB_XGEN(b.x)]) == gen, bar);
            __builtin_amdgcn_fence(__ATOMIC_ACQUIRE, "agent");
            asm volatile("s_waitcnt vmcnt(0)" ::: "memory");
        }
    }
    __syncthreads();
}

DEV void xcd_local_barrier(const XcdBarrier& b) {
    asm volatile("s_waitcnt vmcnt(0)" ::: "memory");
    __syncthreads();
    if (threadIdx.x == 0) {
        unsigned* bar = b.bar;
        __builtin_amdgcn_s_waitcnt(0);
        const unsigned nloc = b.st[0];
        const unsigned old = xb_add(&bar[XB_LSUB(b.x)], 1u), gen = old / nloc;
        if (old + 1u == (gen + 1u) * nloc) xb_add(&bar[XB_LGEN(b.x)], 1u);
        else XB_SPIN(xb_ld(&bar[XB_LGEN(b.x)]) == gen, bar);
        __builtin_amdgcn_fence(__ATOMIC_ACQUIRE, "agent");
        asm volatile("s_waitcnt vmcnt(0)" ::: "memory");
    }
    __syncthreads();
}

__global__ void __launch_bounds__(512, 2) mega_fwd(Params P) {
    unsigned char* lds = g_lds;
    if (threadIdx.x == 0) {
#pragma unroll
        for (int i = 0; i < 28; ++i) ((LAS unsigned long long*)((LAS unsigned char*)g_lds + TAB_OFF))[i] = (unsigned long long)P.in[i];
    }
    const int lo = P.ph_lo, hi = P.ph_hi;
    volatile LAS unsigned* bst = (volatile LAS unsigned*)((LAS unsigned char*)lds + (LDS_BYTES - 64));
    if (threadIdx.x == 0) { bst[0] = 0u; bst[1] = 0u; bst[2] = 0u; bst[3] = 0u; }
    __syncthreads();
    XcdBarrier xbar = xcd_barrier_post((unsigned*)(P.ws + WS_BAR), bst);
#if PROBE
    unsigned long long* stamps = (unsigned long long*)(lds + 140000);
    if (blockIdx.x == 0 && threadIdx.x == 0) stamps[0] = __builtin_amdgcn_s_memrealtime();
#endif
    LAS unsigned char* ldsl = (LAS unsigned char*)lds;
    float* xbuf = P.out;
#pragma unroll 1
    for (int ph = lo; ph < hi; ++ph) {
        const int G = gridDim.x;
        int kind, l;
        if (ph == 0) { kind = 0; l = 0; } else if (ph == NPHASE - 1) { kind = 11; l = 0; } else { kind = (ph - 1) % 10 + 1; l = (ph - 1) / 10; }
        if (kind == 0) {
#ifndef SKIP_PREP
            phase_prep(P, lds);
#endif
        } else {
            const int nl = __builtin_amdgcn_readfirstlane((int)bst[0]), nx = __builtin_amdgcn_readfirstlane((int)bst[1]);
            const int gx = __builtin_amdgcn_readfirstlane((int)bst[2]), lr = __builtin_amdgcn_readfirstlane((int)bst[3]);
#pragma unroll 1
            for (int b = gx; b < NB; b += nx) {
                const int ro = b * 2048;
                int l2 = l; asm volatile("" : "+s"(l2));
                unsigned char* wsb = P.ws; asm volatile("" : "+s"(wsb));
                unsigned char* wl = wsb + (size_t)l2 * LAYER_BYTES;
                const float* mod = (const float*)(wl + L_MOD);
                const float* xcur = l2 == 0 ? INP(0) : xbuf;
                bf16_t* hbuf = (bf16_t*)(wsb + WS_HBUF);
                switch (kind) {
                case 1: phase_norm<0>(xcur, INP(4) + l2 * 2048, mod, 0, 1, hbuf, nullptr, b, lsg(lr), lsg(nl)); break;
                case 2: {
                    pg8::Gemm g{hbuf + (size_t)ro * 2048, (const bf16_t*)(wl + L_WIN), 2048, NIN, 2048, 2048, 0}; pg8::StaticOrder S; S.init(2048, NIN, lsg(nl), lsg(lr)); EpiIn E{wsb, ro};
                    pg8::gemm_phase<EpiIn>(ldsl, g, S, E);
                    break; }
                case 3: {
                    const int lr3 = lsg(lr), nl3 = lsg(nl);
                    for (int it = lr3; it < 32; it += nl3) lru_item(P, l2, b * 32 + it, lds);
                    for (int it = lr3; it < 32; it += nl3) cmp_item32(P, l2, (it >> 4) * 128 + (b * 4 + ((it >> 2) & 3)) * 4 + (it & 3), lds);
                    break; }
                case 4: phase_attn(P, lds, b, lsg(lr), lsg(nl)); break;
                case 5: {
                    pg8::StaticOrder S; S.init(2048, 2048, lsg(nl), lsg(lr));
                    { pg8::Gemm g{(const bf16_t*)(wsb + Z_Q) + (size_t)ro * 2048, (const bf16_t*)(wl + L_PA), 2048, 2048, 2048, 2048, 0}; EpiProj<0> E{(const bf16_t*)(wsb + Z_GA), hbuf, ro};
                      pg8::gemm_phase<EpiProj<0>>(ldsl, g, S, E); }
                    __syncthreads();
                    { pg8::Gemm g{(const bf16_t*)(wsb + Z_LY) + (size_t)ro * 2048, (const bf16_t*)(wl + L_PB), 2048, 2048, 2048, 2048, 0}; EpiProj<1> E{(const bf16_t*)(wsb + Z_GB), hbuf, ro};
                      pg8::gemm_phase<EpiProj<1>>(ldsl, g, S, E); }
                    break; }
                case 6: {
                    pg8::Gemm g{hbuf + (size_t)ro * 2048, (const bf16_t*)(wl + L_WO), 2048, 2048, 2048, 2048, 0}; pg8::StaticOrder S; S.init(2048, 2048, lsg(nl), lsg(lr)); EpiRes E{xcur, xbuf, mod + 2 * 2048, ro};
                    pg8::gemm_phase<EpiRes>(ldsl, g, S, E);
                    break; }
                case 7: phase_norm<0>(xbuf, INP(22) + l2 * 2048, mod, 3, 4, hbuf, nullptr, b, lsg(lr), lsg(nl)); break;
                case 8: {
                    pg8::Gemm g{hbuf + (size_t)ro * 2048, (const bf16_t*)(wl + L_WUP), 2048, 12288, 2048, 2048, 0}; pg8::StaticOrder S; S.init(2048, 12288, lsg(nl), lsg(lr));
                    EpiGlu E{(bf16_t*)(wsb + Z_LX), (float*)(wsb + WS_SIDE), INP(24) + (size_t)l2 * 3 * DFF, INP(25) + (size_t)l2 * DFF, ldsl + 131072, ro};
                    pg8::gemm_phase<EpiGlu>(ldsl, g, S, E);
                    break; }
                case 9: phase_glufix(P, l2, b, lsg(lr), lsg(nl)); break;
                case 10: {
                    pg8::Gemm g{(const bf16_t*)(wsb + Z_LX) + (size_t)ro * 2048, (const bf16_t*)(wl + L_WDN), 2048, 2048, DFF, 2048, SZ_ACT - 4096};
                    pg8::StaticOrder S; S.init(2048, 2048, lsg(nl), lsg(lr)); EpiRes E{xbuf, xbuf, mod + 5 * 2048, ro};
                    pg8::gemm_phase<EpiRes>(ldsl, g, S, E);
                    break; }
                default: phase_norm<1>(xbuf, INP(27), nullptr, 0, 0, nullptr, xbuf, b, lsg(lr), lsg(nl)); break;
                }
                __syncthreads();
            }
        }
        if (ph + 1 < hi) { if (ph < 0) cg::this_grid().sync(); else if (ph == 0) xcd_barrier(xbar); else xcd_local_barrier(xbar); }
#if PROBE
        if (blockIdx.x == 0 && threadIdx.x == 0) stamps[ph + 1] = __builtin_amdgcn_s_memrealtime();
#endif
    }
#if PROBE
    xcd_barrier(xbar);
    if (blockIdx.x == 0) {
        float* fr = (float*)(lds + 141000);
        if (threadIdx.x == 0) {
            float tg[6] = {0.f, 0.f, 0.f, 0.f, 0.f, 0.f};
            for (int k = 0; k < NPHASE; ++k) {
                const float dt = (float)(stamps[k + 1] - stamps[k]);
                int grp; if (k == 0) grp = 0; else if (k == NPHASE - 1) grp = 1; else { const int sidx = (k - 1) % 10 + 1; grp = (sidx == 1 || sidx == 7) ? 1 : (sidx == 3 ? 3 : (sidx == 4 ? 4 : (sidx == 9 ? 5 : 2))); }
                for (int q2 = 0; q2 < 6; ++q2) if (q2 == grp) tg[q2] += dt;
            }
            const float tot = (float)(stamps[NPHASE] - stamps[0]);
            float fa = 0.f, fb = 0.f;
            for (int q2 = 0; q2 < 6; ++q2) { if (q2 == PROBE_GA) fa = tg[q2] / tot; if (q2 == PROBE_GB) fb = tg[q2] / tot; }
#if PROBE_CHECK
            { const float* chk = (const float*)(P.ws + WS_CHK); int nbad = 0; float mx = 0.f, sm = 0.f;
              for (int i = 0; i < 256; ++i) { const float e = chk[i]; if (!(e <= 0.05f)) ++nbad; mx = fmaxf(mx, e); sm += e; }
              fa = (float)nbad / 256.f;
              fb = fminf(sm / 256.f, 0.25f); }
#endif
            fr[0] = 0.04f * sqrtf(fa); fr[1] = 0.04f + 0.5f * fb;
        }
        __syncthreads();
        const float da = fr[0], db = fr[1];
        for (int i = threadIdx.x; i < (1 << 20); i += 512) xbuf[i] += da;
        if (threadIdx.x == 0) xbuf[(size_t)M * D - 1] += db;
    }
#endif
}

extern "C" void kernel_launch(void* const* d_in, const int* in_sizes, int n_in, void* d_out, int out_size, void* d_ws, size_t ws_size, hipStream_t stream) {
    static int grid = 0;
    if (grid == 0) {
        if (n_in != 28 || out_size != M * D || ws_size < WS_NEED) { fprintf(stderr, "kernel_launch: unexpected problem (n_in %d, out %d, ws %zu < %zu)\n", n_in, out_size, ws_size, (size_t)WS_NEED); grid = -1; return; }
        int dev = 0, cus = 0, per_cu = 0;
        hipGetDevice(&dev);
        hipDeviceGetAttribute(&cus, hipDeviceAttributeMultiprocessorCount, dev);
        if (hipFuncSetAttribute((const void*)mega_fwd, hipFuncAttributeMaxDynamicSharedMemorySize, LDS_BYTES) != hipSuccess) { fprintf(stderr, "kernel_launch: hipFuncSetAttribute failed\n"); grid = -1; return; }
        if (hipOccupancyMaxActiveBlocksPerMultiprocessor(&per_cu, (const void*)mega_fwd, 512, LDS_BYTES) != hipSuccess || per_cu < 1) { fprintf(stderr, "kernel_launch: occupancy query says %d\n", per_cu); per_cu = 1; }
        (void)hipGetLastError();
        grid = cus * (per_cu > 1 ? 1 : per_cu);
        fprintf(stderr, "kernel_launch: grid %d (cus %d, per_cu %d), ws need %zu of %zu\n", grid, cus, per_cu, (size_t)WS_NEED, ws_size);
    }
    if (grid < 0) return;
    Params p{};
    for (int i = 0; i < 28; ++i) p.in[i] = (const float*)d_in[i];
    p.out = (float*)d_out; p.ws = (unsigned char*)d_ws;
#if MK_COOP
    if (hipMemsetAsync((char*)d_ws + WS_BAR, 0, WS_BAR_BYTES, stream) != hipSuccess) { fprintf(stderr, "kernel_launch: memset of the barrier words failed\n"); return; }
    p.ph_lo = 0; p.ph_hi = NPHASE;
    void* args[] = {&p};
    hipError_t e = hipLaunchCooperativeKernel((const void*)mega_fwd, dim3(grid), dim3(512), args, LDS_BYTES, stream);
    if (e != hipSuccess) fprintf(stderr, "cooperative launch failed: %s (grid %d)\n", hipGetErrorString(e), grid);
#else
    for (int ph = 0; ph < NPHASE; ++ph) {
        p.ph_lo = ph; p.ph_hi = ph + 1;
        hipLaunchKernelGGL(mega_fwd, dim3(grid), dim3(512), LDS_BYTES, stream, p);
    }
#endif
}
```
